# Optimizing an MI355X kernel written in HIP

```python
import jax
import jax.numpy as jnp
from jax import lax
import numpy as np

D_MODEL = 1024
BATCH = 8
SEQ = 8192
DEPTH = 2

GRID_W = 64
CTX_LEN = 256
N_EVEN = (DEPTH + 1) // 2
N_ODD = DEPTH // 2

HEAD_DIM = 64
ATTN_HEADS = (D_MODEL // 2) // HEAD_DIM
ATTN_KV_HEADS = ATTN_HEADS // 4
ATTN_GROUP = ATTN_HEADS // ATTN_KV_HEADS
WINDOW = 128
ATTN_BLOCK = 128
ROPE_BASE = 10000.0

HGRN_EXPAND = 128
HGRN_WIDTH = D_MODEL // 2
HGRN_HEADS = HGRN_WIDTH // HGRN_EXPAND
HGRN_DK = HGRN_EXPAND
HGRN_DV = HGRN_EXPAND
CHUNK = 64

RET_HEADS = 4
RET_DK = D_MODEL // RET_HEADS
RET_DV = 2 * RET_DK
RET_BASE = 10000.0

FFN_HIDDEN = -(-8 * D_MODEL // (3 * 256)) * 256

A_Q = ATTN_HEADS * HEAD_DIM
A_KV = ATTN_KV_HEADS * HEAD_DIM
EVEN_PARTS = (('a_q', A_Q), ('a_k', A_KV), ('a_v', A_KV), ('b_q', HGRN_WIDTH), ('b_ff', HGRN_WIDTH),
              ('b_fb', HGRN_WIDTH), ('b_i', HGRN_WIDTH), ('b_g', HGRN_WIDTH))
EVEN_IN = A_Q + 2 * A_KV + 5 * HGRN_WIDTH
EVEN_OUT = A_Q + HGRN_HEADS * HGRN_DV
ODD_PARTS = (('q', RET_HEADS * RET_DK), ('k', RET_HEADS * RET_DK), ('v', RET_HEADS * RET_DV),
             ('g', RET_HEADS * RET_DV))
ODD_IN = 2 * RET_HEADS * RET_DK + 2 * RET_HEADS * RET_DV
ODD_OUT = RET_HEADS * RET_DV
EPS = 1e-6
F32 = jnp.float32

kernel_name = 'hybrid_swa_hgrn2_retention_dit_prefix'


def _offsets(parts):
    out, start = {}, 0
    for name, width in parts:
        out[name] = (start, start + width)
        start += width
    return out


def split_parts(u, parts):
    return {n: u[..., s:e] for n, (s, e) in _offsets(parts).items()}


def project_parts(h, w, parts, names):
    off = _offsets(parts)
    return {n: h @ w[:, off[n][0]:off[n][1]] for n in names}


def rms_norm(x, g=None):
    xf = x.astype(F32)
    y = xf * lax.rsqrt(jnp.mean(xf * xf, axis=-1, keepdims=True) + EPS)
    if g is not None:
        y = y * g.astype(F32)
    return y.astype(x.dtype)


def modulate(h, shift, scale):
    return h * (1.0 + scale) + shift


def to_heads(u, n_heads):
    b, l, _ = u.shape
    return u.reshape(b, l, n_heads, -1).transpose(0, 2, 1, 3)


def from_heads(o):
    return o.transpose(0, 2, 1, 3)


def flip(a):
    return jnp.flip(a, axis=2)


def axial_rope_tables(n_tok):
    t = jnp.arange(n_tok)
    row = (t // GRID_W).astype(F32)
    col = (t % GRID_W).astype(F32)
    n_freq = HEAD_DIM // 4
    inv = ROPE_BASE ** (-jnp.arange(n_freq, dtype=F32) / n_freq)
    ang = jnp.concatenate([row[:, None] * inv, col[:, None] * inv], axis=-1)
    return jnp.cos(ang), jnp.sin(ang)


def retention_rope_tables(n_tok):
    theta = 1.0 / (RET_BASE ** jnp.linspace(0.0, 1.0, RET_DK // 2, dtype=F32))
    ang = jnp.arange(n_tok, dtype=F32)[:, None] * theta
    return jnp.cos(ang), jnp.sin(ang)


def apply_rope(x, cos, sin):
    half = x.shape[-1] // 2
    xf = x.astype(F32)
    x1, x2 = xf[..., :half], xf[..., half:]
    return jnp.concatenate([x1 * cos - x2 * sin, x2 * cos + x1 * sin], axis=-1).astype(x.dtype)


def attn_q_heads(u, g):
    b, l, _ = u.shape
    q = rms_norm(u.reshape(b, l, ATTN_KV_HEADS, ATTN_GROUP, HEAD_DIM), g)
    return q.transpose(0, 2, 3, 1, 4)


def kv_heads(u, g=None):
    b, l, _ = u.shape
    h = u.reshape(b, l, ATTN_KV_HEADS, HEAD_DIM)
    if g is not None:
        h = rms_norm(h, g)
    return h.transpose(0, 2, 1, 3)


def window_attention(q, k, v, k_ctx, v_ctx, sink):
    b, kv, g, l, d = q.shape
    n_blocks = l // ATTN_BLOCK
    span = ATTN_BLOCK + 2 * WINDOW
    pad = ((0, 0), (0, 0), (WINDOW, WINDOW), (0, 0))
    kp, vp = jnp.pad(k, pad), jnp.pad(v, pad)
    scale = d ** -0.5
    sink_col = jnp.broadcast_to(sink[None, :, :, None, None], (b, kv, g, ATTN_BLOCK, 1))

    def block(i):
        start = i * ATTN_BLOCK
        qb = lax.dynamic_slice_in_dim(q, start, ATTN_BLOCK, axis=3)
        kb = lax.dynamic_slice_in_dim(kp, start, span, axis=2)
        vb = lax.dynamic_slice_in_dim(vp, start, span, axis=2)
        q_pos = start + jnp.arange(ATTN_BLOCK)
        k_pos = start - WINDOW + jnp.arange(span)
        valid = ((jnp.abs(k_pos[None, :] - q_pos[:, None]) <= WINDOW)
                 & (k_pos >= 0)[None, :] & (k_pos < l)[None, :])
        s_lat = jnp.einsum('bkgqd,bksd->bkgqs', qb, kb, preferred_element_type=F32) * scale
        s_lat = jnp.where(valid, s_lat, -jnp.inf)
        s_ctx = jnp.einsum('bkgqd,bkcd->bkgqc', qb, k_ctx, preferred_element_type=F32) * scale
        p = jax.nn.softmax(jnp.concatenate([sink_col, s_lat, s_ctx], axis=-1), axis=-1)
        p_lat = p[..., 1:1 + span].astype(v.dtype)
        p_ctx = p[..., 1 + span:].astype(v.dtype)
        return (jnp.einsum('bkgqs,bksd->bkgqd', p_lat, vb)
                + jnp.einsum('bkgqc,bkcd->bkgqd', p_ctx, v_ctx))

    o = lax.map(block, jnp.arange(n_blocks))
    return o.transpose(1, 0, 4, 2, 3, 5).reshape(b, l, kv * g * d)


def context_attention(q, k, v, sink):
    b, kv, g, lc, d = q.shape
    s = jnp.einsum('bkgqd,bkcd->bkgqc', q, k, preferred_element_type=F32) * d ** -0.5
    sink_col = jnp.broadcast_to(sink[None, :, :, None, None], (b, kv, g, lc, 1))
    p = jax.nn.softmax(jnp.concatenate([sink_col, s], axis=-1), axis=-1)[..., 1:].astype(v.dtype)
    o = jnp.einsum('bkgqc,bkcd->bkgqd', p, v)
    return o.transpose(0, 3, 1, 2, 4).reshape(b, lc, kv * g * d)


def chunk_scan(q_in, k_in, v, decay, s0):
    xs = (jnp.moveaxis(q_in, 2, 0), jnp.moveaxis(k_in, 2, 0), jnp.moveaxis(v, 2, 0), decay)

    def step(s, inp):
        q_n, k_n, v_n, a_n = inp
        o_n = jnp.einsum('bhcd,bhde->bhce', q_n, s)
        s = a_n * s + jnp.einsum('bhcd,bhce->bhde', k_n, v_n)
        return s, o_n

    s, o = lax.scan(step, s0, xs)
    return jnp.moveaxis(o, 0, 2), s


def gla_chunked(q, k, v, log_f, s0):
    b, h, l, dk = q.shape
    dv = v.shape[-1]
    n = l // CHUNK
    qc, kc, lc = (a.reshape(b, h, n, CHUNK, dk) for a in (q, k, log_f))
    vc = v.reshape(b, h, n, CHUNK, dv)
    cum = jnp.cumsum(lc, axis=3)
    ref = cum[:, :, :, CHUNK // 2:CHUNK // 2 + 1]
    scores = jnp.einsum('bhntd,bhnsd->bhnts', qc * jnp.exp(cum - ref), kc * jnp.exp(ref - cum))
    lower = jnp.tril(jnp.ones((CHUNK, CHUNK), dtype=bool))
    o_intra = jnp.einsum('bhnts,bhnse->bhnte', jnp.where(lower, scores, 0.0), vc)
    cum_last = cum[:, :, :, -1:]
    decay = jnp.moveaxis(jnp.exp(cum_last[:, :, :, 0]), 2, 0)[..., None]
    o_inter, s = chunk_scan(qc * jnp.exp(cum), kc * jnp.exp(cum_last - cum), vc, decay, s0)
    return (o_intra + o_inter).reshape(b, h, l, dv), s


def gla_final_state(k, v, log_f):
    cum = jnp.cumsum(log_f, axis=2)
    return jnp.einsum('bhld,bhle->bhde', k * jnp.exp(cum[:, :, -1:] - cum), v)


def retention_chunked(q, k, v, log_gamma, s0):
    b, h, l, dk = q.shape
    dv = v.shape[-1]
    n = l // CHUNK
    qc = q.reshape(b, h, n, CHUNK, dk)
    kc = k.reshape(b, h, n, CHUNK, dk)
    vc = v.reshape(b, h, n, CHUNK, dv)
    pos = jnp.arange(CHUNK, dtype=F32)
    rel = pos[:, None] - pos[None, :]
    dmat = jnp.where(rel >= 0, jnp.exp(log_gamma[:, None, None] * jnp.maximum(rel, 0.0)), 0.0)
    scores = jnp.einsum('bhntd,bhnsd->bhnts', qc, kc) * dmat[None, :, None]
    o_intra = jnp.einsum('bhnts,bhnse->bhnte', scores, vc)
    lg = log_gamma[:, None]
    q_in = qc * jnp.exp(lg * (pos + 1.0))[None, :, None, :, None]
    k_in = kc * jnp.exp(lg * (CHUNK - 1.0 - pos))[None, :, None, :, None]
    decay = jnp.broadcast_to(jnp.exp(log_gamma * CHUNK)[None, None, :, None, None], (n, 1, h, 1, 1))
    o_inter, s = chunk_scan(q_in, k_in, vc, decay, s0)
    return (o_intra + o_inter).reshape(b, h, l, dv), s


def retention_final_state(k, v, log_gamma):
    lc = k.shape[2]
    w = jnp.exp(log_gamma[:, None] * (lc - 1.0 - jnp.arange(lc, dtype=F32)))
    return jnp.einsum('bhld,bhle->bhde', k * w[None, :, :, None], v)


def gated_head_norm(o, g_raw, gain=None):
    b, h, l, dv = o.shape
    y = rms_norm(from_heads(o), gain) * jax.nn.silu(g_raw.reshape(b, l, h, dv).astype(F32))
    return y.reshape(b, l, h * dv)


def even_mixer(h_ctx, h_lat, w_in, w_out, qk_g, sink, out_g, lb, cos, sin, need_ctx):
    dt = h_lat.dtype
    n_b = h_ctx.shape[0]
    sink = sink.astype(F32).reshape(ATTN_KV_HEADS, ATTN_GROUP)
    lb = lb.reshape(HGRN_HEADS, 1, HGRN_DK)
    p = split_parts(h_lat @ w_in, EVEN_PARTS)
    names = [n for n, _ in EVEN_PARTS] if need_ctx else ['a_k', 'a_v', 'b_ff', 'b_fb', 'b_i']
    pc = project_parts(h_ctx, w_in, EVEN_PARTS, names)

    def gates(f_raw):
        f = lb + (1.0 - lb) * jax.nn.sigmoid(to_heads(f_raw, HGRN_HEADS).astype(F32))
        return 1.0 - f, jnp.log(f)

    k_ctx = kv_heads(pc['a_k'], qk_g[1])
    v_ctx = kv_heads(pc['a_v'])
    q_lat = apply_rope(attn_q_heads(p['a_q'], qk_g[0]), cos, sin)
    k_lat = apply_rope(kv_heads(p['a_k'], qk_g[1]), cos, sin)
    a_lat = window_attention(q_lat, k_lat, kv_heads(p['a_v']), k_ctx, v_ctx, sink)

    k_fw_c, lf_fw_c = gates(pc['b_ff'])
    k_bw_c, lf_bw_c = gates(pc['b_fb'])
    i_c = to_heads(pc['b_i'], HGRN_HEADS).astype(F32)
    if need_ctx:
        zeros = jnp.zeros((n_b, HGRN_HEADS, HGRN_DK, HGRN_DV), F32)
        q_c = jax.nn.silu(to_heads(pc['b_q'], HGRN_HEADS).astype(F32))
        o_fw_c, s_fw = gla_chunked(q_c, k_fw_c, i_c, lf_fw_c, zeros)
        o_bw_c, s_bw = gla_chunked(flip(q_c), flip(k_bw_c), flip(i_c), flip(lf_bw_c), zeros)
    else:
        s_fw = gla_final_state(k_fw_c, i_c, lf_fw_c)
        s_bw = gla_final_state(flip(k_bw_c), flip(i_c), flip(lf_bw_c))
    k_fw, lf_fw = gates(p['b_ff'])
    k_bw, lf_bw = gates(p['b_fb'])
    q_l = jax.nn.silu(to_heads(p['b_q'], HGRN_HEADS).astype(F32))
    i_l = to_heads(p['b_i'], HGRN_HEADS).astype(F32)
    o_fw, _ = gla_chunked(q_l, k_fw, i_l, lf_fw, s_fw)
    o_bw, _ = gla_chunked(flip(q_l), flip(k_bw), flip(i_l), flip(lf_bw), s_bw)
    b_lat = gated_head_norm(o_fw + flip(o_bw), p['b_g'], out_g)

    y_lat = jnp.concatenate([a_lat.astype(dt), b_lat.astype(dt)], axis=-1) @ w_out
    if not need_ctx:
        return None, y_lat
    a_ctx = context_attention(attn_q_heads(pc['a_q'], qk_g[0]), k_ctx, v_ctx, sink)
    b_ctx = gated_head_norm(o_fw_c + flip(o_bw_c), pc['b_g'], out_g)
    y_ctx = jnp.concatenate([a_ctx.astype(dt), b_ctx.astype(dt)], axis=-1) @ w_out
    return y_ctx, y_lat


def odd_mixer(h_ctx, h_lat, w_in, w_out, cos, sin, need_ctx):
    dt = h_lat.dtype
    n_b = h_ctx.shape[0]
    log_g_fw = jnp.log(1.0 - 2.0 ** (-5.0 - jnp.arange(RET_HEADS, dtype=F32)))
    log_g_bw = log_g_fw[::-1]
    k_scale = RET_DK ** -0.5
    p = split_parts(h_lat @ w_in, ODD_PARTS)
    names = [n for n, _ in ODD_PARTS] if need_ctx else ['k', 'v']
    pc = project_parts(h_ctx, w_in, ODD_PARTS, names)

    k_c = to_heads(pc['k'], RET_HEADS).astype(F32) * k_scale
    v_c = to_heads(pc['v'], RET_HEADS).astype(F32)
    if need_ctx:
        zeros = jnp.zeros((n_b, RET_HEADS, RET_DK, RET_DV), F32)
        q_c = to_heads(pc['q'], RET_HEADS).astype(F32)
        o_fw_c, s_fw = retention_chunked(q_c, k_c, v_c, log_g_fw, zeros)
        o_bw_c, s_bw = retention_chunked(flip(q_c), flip(k_c), flip(v_c), log_g_bw, zeros)
    else:
        s_fw = retention_final_state(k_c, v_c, log_g_fw)
        s_bw = retention_final_state(flip(k_c), flip(v_c), log_g_bw)

    q_l = apply_rope(to_heads(p['q'], RET_HEADS).astype(F32), cos, sin)
    k_l = apply_rope(to_heads(p['k'], RET_HEADS).astype(F32), cos, sin) * k_scale
    v_l = to_heads(p['v'], RET_HEADS).astype(F32)
    o_fw, _ = retention_chunked(q_l, k_l, v_l, log_g_fw, s_fw)
    o_bw, _ = retention_chunked(flip(q_l), flip(k_l), flip(v_l), log_g_bw, s_bw)
    y_lat = gated_head_norm(o_fw + flip(o_bw), p['g']).astype(dt) @ w_out
    if not need_ctx:
        return None, y_lat
    y_ctx = gated_head_norm(o_fw_c + flip(o_bw_c), pc['g']).astype(dt) @ w_out
    return y_ctx, y_lat


def swiglu(h, w_in, w_out):
    gate, up = jnp.split(h @ w_in, 2, axis=-1)
    return (jax.nn.silu(gate) * up) @ w_out


def setup_inputs(seed: int = 0) -> dict:
    key = jax.random.key(seed)
    ks = jax.random.split(key, 17)
    d = D_MODEL

    def nrm(k, shape, scale):
        return jax.random.normal(k, shape, F32) * scale

    return {
        'x': nrm(ks[0], (BATCH, SEQ, d), 1.0),
        'c': nrm(ks[1], (BATCH, d), 1.0),
        'ctx': nrm(ks[2], (BATCH, CTX_LEN, d), 1.0),
        'c_ctx': nrm(ks[3], (d,), 1.0),
        'mod_w': nrm(ks[4], (DEPTH, d, 6 * d), 0.5 * d ** -0.5),
        'mod_b': nrm(ks[5], (DEPTH, 6 * d), 0.02),
        'norm_g': 1.0 + nrm(ks[6], (DEPTH, 2, d), 0.02),
        'ffn_w_in': nrm(ks[7], (DEPTH, d, 2 * FFN_HIDDEN), d ** -0.5),
        'ffn_w_out': nrm(ks[8], (DEPTH, FFN_HIDDEN, d), FFN_HIDDEN ** -0.5),
        'even_w_in': nrm(ks[9], (N_EVEN, d, EVEN_IN), d ** -0.5),
        'even_w_out': nrm(ks[10], (N_EVEN, EVEN_OUT, d), EVEN_OUT ** -0.5),
        'attn_qk_norm_g': 1.0 + nrm(ks[11], (N_EVEN, 2, HEAD_DIM), 0.02),
        'attn_sink': nrm(ks[12], (N_EVEN, ATTN_HEADS), 0.5),
        'hgrn_out_norm_g': 1.0 + nrm(ks[13], (N_EVEN, HGRN_DV), 0.02),
        'hgrn_lb': nrm(ks[14], (N_EVEN + 1, HGRN_WIDTH), 0.1),
        'odd_w_in': nrm(ks[15], (N_ODD, d, ODD_IN), d ** -0.5),
        'odd_w_out': nrm(ks[16], (N_ODD, ODD_OUT, d), ODD_OUT ** -0.5),
    }


def reference(x, c, ctx, c_ctx, mod_w, mod_b, norm_g, ffn_w_in, ffn_w_out, even_w_in, even_w_out,
              attn_qk_norm_g, attn_sink, hgrn_out_norm_g, hgrn_lb, odd_w_in, odd_w_out):
    n_tok = x.shape[1]
    rope_cos, rope_sin = axial_rope_tables(n_tok)
    ret_cos, ret_sin = retention_rope_tables(n_tok)
    lower_bounds = jnp.cumsum(jax.nn.softmax(hgrn_lb.astype(F32), axis=0), axis=0)
    cond_lat = jax.nn.silu(c)
    cond_ctx = jax.nn.silu(c_ctx)
    for layer in range(DEPTH):
        last = layer == DEPTH - 1
        j = layer // 2
        m_lat = jnp.split((cond_lat @ mod_w[layer] + mod_b[layer])[:, None, :], 6, axis=-1)
        m_ctx = jnp.split((cond_ctx @ mod_w[layer] + mod_b[layer])[None, None, :], 6, axis=-1)
        h_lat = modulate(rms_norm(x, norm_g[layer, 0]), m_lat[0], m_lat[1])
        h_ctx = modulate(rms_norm(ctx, norm_g[layer, 0]), m_ctx[0], m_ctx[1])
        if layer % 2 == 0:
            y_ctx, y_lat = even_mixer(h_ctx, h_lat, even_w_in[j], even_w_out[j], attn_qk_norm_g[j],
                                      attn_sink[j], hgrn_out_norm_g[j], lower_bounds[j],
                                      rope_cos, rope_sin, not last)
        else:
            y_ctx, y_lat = odd_mixer(h_ctx, h_lat, odd_w_in[j], odd_w_out[j], ret_cos, ret_sin, not last)
        x = x + m_lat[2] * y_lat
        x = x + m_lat[5] * swiglu(modulate(rms_norm(x, norm_g[layer, 1]), m_lat[3], m_lat[4]),
                                  ffn_w_in[layer], ffn_w_out[layer])
        if not last:
            ctx = ctx + m_ctx[2] * y_ctx
            ctx = ctx + m_ctx[5] * swiglu(modulate(rms_norm(ctx, norm_g[layer, 1]), m_ctx[3], m_ctx[4]),
                                          ffn_w_in[layer], ffn_w_out[layer])
    return x
```

```cpp
#include <hip/hip_runtime.h>
#include <hip/hip_cooperative_groups.h>
#include <cstdio>
namespace cg = cooperative_groups;

#define DI __device__ __forceinline__
#define LAS __attribute__((address_space(3)))
namespace pg8 {
#define PG8_LAS __attribute__((address_space(3)))
typedef unsigned short bf16_t;
typedef short bf16x8 __attribute__((ext_vector_type(8)));
typedef float f32x4 __attribute__((ext_vector_type(4)));
typedef unsigned u32x4 __attribute__((ext_vector_type(4)));
constexpr int BM = 256, BK = 64, HALF = 128, HTB = HALF * BK * 2  , STAGE_BYTES = 8 * HTB, NXCD = 8, WGM = 8;

__host__ __device__ __forceinline__ int lds_byte(int r, int c) { const int st = (r >> 4) * 2 + (c >> 5), rr = r & 15, cc = c & 31, ob = rr * 64 + cc * 2; return st * 1024 + (ob ^ (((ob >> 9) & 1) << 5)); }
__host__ __device__ __forceinline__ void stage_rc(int b, int& R, int& C) { const int st = b / 1024, sb = b % 1024, swz = sb ^ (((sb >> 9) & 1) << 5); R = (st >> 1) * 16 + swz / 64; C = (st & 1) * 32 + (swz % 64) / 2; }
__host__ __device__ __forceinline__ int perm32(int rho) { const int n = rho >> 4, i = rho & 15; return 8 * (i >> 2) + 4 * n + (i & 3); }

struct Unit { int pm, pn; };
struct Gemm { const bf16_t* A; const bf16_t* Bt; int M, N, K; };

struct StaticOrder {
    int nM, nN, nwg, G, c;
    __host__ __device__ void init(int M, int N, int G_, int c_) { nM = M / BM; nN = N / BM; nwg = nM * nN; G = G_; c = c_; }
    __host__ __device__ bool next(int i, Unit& u) const {
        const long L = (long)i * G + c; if (L >= nwg) return false;
        int wgid = (int)L; { const int q = nwg / NXCD, r = nwg % NXCD, xcd = wgid % NXCD, off = wgid / NXCD; wgid = (xcd < r ? xcd * (q + 1) : r * (q + 1) + (xcd - r) * q) + off; }
        const int nig = WGM * nN, gid = wgid / nig, fm = gid * WGM, gsz = (nM - fm) < WGM ? (nM - fm) : WGM;
        u.pm = fm + ((wgid % nig) % gsz); u.pn = (wgid % nig) / gsz; return true;
    }
    __device__ __forceinline__ void a_ready(const Unit&) const {}
    __device__ __forceinline__ void done(const Unit&) const {}
};

__device__ __forceinline__ int pg8_opaque_tid() { int t = threadIdx.x; asm volatile("" : "+v"(t)); return t; }
__device__ __forceinline__ unsigned cvt_pk_bf16(float lo, float hi) { unsigned r; asm volatile("v_cvt_pk_bf16_f32 %0, %1, %2" : "=v"(r) : "v"(lo), "v"(hi)); return r; }

struct EpiStoreBf16 {
    static constexpr bool PERM = true, AFTER_DRAIN = false;
    bf16_t* O; int ldc;
    __device__ __forceinline__ void operator()(const f32x4 (&acc)[2][2][4][2], const Unit& u, int wr, int wc, int fr, int fq) const {
        const int row0 = u.pm * BM + wr * 64 + fr; const int col0 = u.pn * BM + wc * 32 + 8 * fq;
#pragma unroll
        for (int ai = 0; ai < 2; ++ai)
#pragma unroll
            for (int m = 0; m < 4; ++m) { bf16_t* rowp = O + (size_t)(row0 + ai * HALF + m * 16) * ldc + col0;
#pragma unroll
                for (int bj = 0; bj < 2; ++bj) { const f32x4 v0 = acc[ai][bj][m][0], v1 = acc[ai][bj][m][1];
                    u32x4 w; w.x = cvt_pk_bf16(v0[0], v0[1]); w.y = cvt_pk_bf16(v0[2], v0[3]); w.z = cvt_pk_bf16(v1[0], v1[1]); w.w = cvt_pk_bf16(v1[2], v1[3]);
                    *(u32x4*)(rowp + bj * HALF) = w; } }
    }
};
struct EpiSwiglu {
    static constexpr bool PERM = true, AFTER_DRAIN = false;
    bf16_t* O; int ldc;
    __device__ __forceinline__ void operator()(const f32x4 (&acc)[2][2][4][2], const Unit& u, int wr, int wc, int fr, int fq) const {
        const int row0 = u.pm * BM + wr * 64 + fr; const int col0 = u.pn * HALF + wc * 32 + 8 * fq;
#pragma unroll
        for (int ai = 0; ai < 2; ++ai)
#pragma unroll
            for (int m = 0; m < 4; ++m) { bf16_t* rowp = O + (size_t)(row0 + ai * HALF + m * 16) * ldc + col0;
                float h[8];
#pragma unroll
                for (int n = 0; n < 2; ++n)
#pragma unroll
                    for (int j = 0; j < 4; ++j) { const float g = acc[ai][0][m][n][j], up = acc[ai][1][m][n][j]; h[4 * n + j] = g / (1.0f + __expf(-g)) * up; }
                u32x4 w; w.x = cvt_pk_bf16(h[0], h[1]); w.y = cvt_pk_bf16(h[2], h[3]); w.z = cvt_pk_bf16(h[4], h[5]); w.w = cvt_pk_bf16(h[6], h[7]);
                *(u32x4*)rowp = w; }
    }
};
struct EpiResid {
    static constexpr bool PERM = false, AFTER_DRAIN = false;
    const float* resL; float* outL; const float* resC; float* outC; const float* gate; int b0, nlat;
    __device__ __forceinline__ void operator()(const f32x4 (&acc)[2][2][4][2], const Unit& u, int wr, int wc, int fr, int fq) const {
        const int lr0 = u.pm * BM; const bool is_ctx = lr0 >= nlat;
        const int col0 = u.pn * BM + wc * 32 + 4 * fq;
        size_t grow0; int mrow; const float* rp0; float* op0;
        if (!is_ctx) { grow0 = (size_t)b0 * 8192 + lr0; mrow = (int)(grow0 >> 13); rp0 = resL; op0 = outL; }
        else { grow0 = (size_t)b0 * 256 + (lr0 - nlat); mrow = 8; rp0 = resC; op0 = outC; }
        const float* gp = gate + (size_t)mrow * 6144 + col0;
        f32x4 gv[2][2];
#pragma unroll
        for (int bj = 0; bj < 2; ++bj)
#pragma unroll
            for (int n = 0; n < 2; ++n) gv[bj][n] = *(const f32x4*)(gp + bj * HALF + n * 16);
#pragma unroll
        for (int ai = 0; ai < 2; ++ai)
#pragma unroll
            for (int m = 0; m < 4; ++m) { const size_t off = (grow0 + wr * 64 + fr + ai * HALF + m * 16) * 1024 + col0;
#pragma unroll
                for (int bj = 0; bj < 2; ++bj)
#pragma unroll
                    for (int n = 0; n < 2; ++n) { const f32x4 r4 = *(const f32x4*)(rp0 + off + bj * HALF + n * 16);
                        *(f32x4*)(op0 + off + bj * HALF + n * 16) = r4 + gv[bj][n] * acc[ai][bj][m][n]; } }
    }
};

template <class Epi, class Sched, bool STAMP = false>
__device__ __forceinline__ void gemm_phase(PG8_LAS unsigned char* lds, const Gemm g, const Sched& S, const Epi& E, unsigned long long* stamps) {
    const int tid = pg8_opaque_tid(), wid = __builtin_amdgcn_readfirstlane(tid >> 6), lane = tid & 63, wr = wid >> 2, wc = wid & 3, fr = lane & 15, fq = lane >> 4;
    const int K = g.K, nt = K / BK;
    int ts_lo = 0, ts_hi = 0, nts = 0; const unsigned long long rt_entry = STAMP ? (unsigned long long)wall_clock64() : 0ull;
#define PG8_STAMP() do { if (STAMP && wid == 0 && nts < 64) { const unsigned long long _c = (unsigned long long)clock64(); \
        ts_lo = (lane == nts) ? (int)(unsigned)_c : ts_lo; ts_hi = (lane == nts) ? (int)(unsigned)(_c >> 32) : ts_hi; ++nts; } } while (0)
    PG8_STAMP();
    unsigned voffA[2], voffB[2];
#pragma unroll
    for (int i = 0; i < 2; ++i) { int R, C; stage_rc(tid * 16 + i * 8192, R, C); const int Rb = Epi::PERM ? ((R & ~31) + perm32(R & 31)) : R;
        voffA[i] = (unsigned)(R * K + C) * 2u; voffB[i] = (unsigned)(Rb * K + C) * 2u; }
    const size_t kstep = (size_t)(BK * 2);
    const size_t hstep = (size_t)HALF * K * 2;
    const size_t tstep = 2 * hstep;
    const unsigned ldsw = (unsigned)wid * 1024u;
    const int aoff = lds_byte(wr * 64 + fr, fq * 8), boff = lds_byte(wc * 32 + fr, fq * 8);
#define PG8_SA(b, h) (((b) * 2 + (h)) * HTB)
#define PG8_SB(b, h) ((4 + (b) * 2 + (h)) * HTB)
#define PG8_STAGE(bufoff, gbase, voff) do { _Pragma("unroll") for (int _i = 0; _i < 2; ++_i) \
        __builtin_amdgcn_global_load_lds((const unsigned*)((const char*)(gbase) + (voff)[_i]), (PG8_LAS unsigned*)(lds + (bufoff) + ldsw + _i * 8192), 16, 0, 0); } while (0)
#define PG8_LDA(dst, b, h) do { _Pragma("unroll") for (int m = 0; m < 4; ++m) _Pragma("unroll") for (int k = 0; k < 2; ++k) dst[m][k] = *(const PG8_LAS bf16x8*)(lds + PG8_SA(b, h) + aoff + m * 2048 + k * 1024); } while (0)
#define PG8_LDB(dst, b, h) do { _Pragma("unroll") for (int n = 0; n < 2; ++n) _Pragma("unroll") for (int k = 0; k < 2; ++k) dst[n][k] = *(const PG8_LAS bf16x8*)(lds + PG8_SB(b, h) + boff + n * 2048 + k * 1024); } while (0)
#define PG8_MMA(ai, bj, At, Bt) do { __builtin_amdgcn_s_setprio(1); _Pragma("unroll") for (int m = 0; m < 4; ++m) _Pragma("unroll") for (int n = 0; n < 2; ++n) _Pragma("unroll") for (int k = 0; k < 2; ++k) \
        acc[ai][bj][m][n] = __builtin_amdgcn_mfma_f32_16x16x32_bf16(Bt[n][k], At[m][k], acc[ai][bj][m][n], 0, 0, 0); __builtin_amdgcn_s_setprio(0); } while (0)
#define PG8_WAIT_V(n) asm volatile("s_waitcnt vmcnt(" #n ")" ::: "memory")
#define PG8_WAIT_L(n) asm volatile("s_waitcnt lgkmcnt(" #n ")" ::: "memory")
#define PG8_BAR __builtin_amdgcn_s_barrier()
#define PG8_SCHED __builtin_amdgcn_sched_barrier(0)
    Unit cur, nxt; int ui = 0;
    if (!S.next(0, cur)) return;
    f32x4 acc[2][2][4][2];
#pragma unroll
    for (int a = 0; a < 2; ++a)
#pragma unroll
        for (int b = 0; b < 2; ++b)
#pragma unroll
            for (int m = 0; m < 4; ++m)
#pragma unroll
                for (int n = 0; n < 2; ++n) acc[a][b][m][n] = (f32x4){0.f, 0.f, 0.f, 0.f};
    bf16x8 At[4][2], B0[2][2], B1[2][2];
    const char* cA = (const char*)g.A + (size_t)cur.pm * tstep; const char* cB = (const char*)g.Bt + (size_t)cur.pn * tstep;
    S.a_ready(cur);
    PG8_STAGE(PG8_SB(0, 0), cB, voffB); PG8_STAGE(PG8_SA(0, 0), cA, voffA); PG8_STAGE(PG8_SB(0, 1), cB + hstep, voffB); PG8_STAGE(PG8_SA(0, 1), cA + hstep, voffA);
    if (wr == 1) PG8_BAR;
    PG8_WAIT_V(4); PG8_BAR;
    PG8_STAGE(PG8_SB(1, 0), cB + kstep, voffB); PG8_STAGE(PG8_SA(1, 0), cA + kstep, voffA); PG8_STAGE(PG8_SB(1, 1), cB + hstep + kstep, voffB);
    PG8_WAIT_V(6); PG8_BAR;
    PG8_STAMP();
    for (;;) {
        const bool has_next = S.next(ui + 1, nxt);
        const char* nA = has_next ? (const char*)g.A + (size_t)nxt.pm * tstep : cA; const char* nB = has_next ? (const char*)g.Bt + (size_t)nxt.pn * tstep : cB;
        for (int t = 0; t < nt; t += 2) {
            const bool last = (t == nt - 2);
            const char* a1 = cA + (size_t)(t + 1) * kstep;
            const char* a2 = last ? nA : cA + (size_t)(t + 2) * kstep; const char* b2 = last ? nB : cB + (size_t)(t + 2) * kstep;
            const char* a3 = a2 + kstep; const char* b3 = b2 + kstep;
            if (last && has_next) S.a_ready(nxt);
            PG8_LDB(B0, 0, 0); PG8_SCHED; PG8_LDA(At, 0, 0); PG8_STAGE(PG8_SA(1, 1), a1 + hstep, voffA);
            PG8_WAIT_L(8); PG8_BAR; PG8_WAIT_L(0); PG8_MMA(0, 0, At, B0); PG8_BAR; PG8_SCHED;
            PG8_LDB(B1, 0, 1); PG8_STAGE(PG8_SB(0, 0), b2, voffB);
            PG8_BAR; PG8_WAIT_L(0); PG8_MMA(0, 1, At, B1); PG8_BAR;
            PG8_LDA(At, 0, 1); PG8_STAGE(PG8_SA(0, 0), a2, voffA);
            PG8_BAR; PG8_WAIT_L(0); PG8_MMA(1, 0, At, B0); PG8_BAR; PG8_SCHED;
            PG8_STAGE(PG8_SB(0, 1), b2 + hstep, voffB);
            PG8_WAIT_V(6); PG8_BAR; PG8_MMA(1, 1, At, B1); PG8_BAR;
            PG8_LDB(B0, 1, 0); PG8_SCHED; PG8_LDA(At, 1, 0); PG8_STAGE(PG8_SA(0, 1), a2 + hstep, voffA);
            PG8_WAIT_L(8); PG8_BAR; PG8_WAIT_L(0); PG8_MMA(0, 0, At, B0); PG8_BAR; PG8_SCHED;
            PG8_LDB(B1, 1, 1); PG8_STAGE(PG8_SB(1, 0), b3, voffB);
            PG8_BAR; PG8_WAIT_L(0); PG8_MMA(0, 1, At, B1); PG8_BAR;
            PG8_LDA(At, 1, 1); PG8_STAGE(PG8_SA(1, 0), a3, voffA);
            PG8_BAR; PG8_WAIT_L(0); PG8_MMA(1, 0, At, B0); PG8_BAR; PG8_SCHED;
            PG8_STAGE(PG8_SB(1, 1), b3 + hstep, voffB);
            PG8_WAIT_V(6); PG8_BAR; PG8_MMA(1, 1, At, B1); PG8_BAR;
        }
        PG8_STAMP();
        if constexpr (!Epi::AFTER_DRAIN) { E(acc, cur, wr, wc, fr, fq); S.done(cur); }
        PG8_STAMP();
        if (!has_next) break;
#pragma unroll
        for (int a = 0; a < 2; ++a)
#pragma unroll
            for (int b = 0; b < 2; ++b)
#pragma unroll
                for (int m = 0; m < 4; ++m)
#pragma unroll
                    for (int n = 0; n < 2; ++n) acc[a][b][m][n] = (f32x4){0.f, 0.f, 0.f, 0.f};
        cur = nxt; cA = nA; cB = nB; ++ui;
    }
    PG8_WAIT_V(0);
    if (wr == 0) PG8_BAR;
    PG8_BAR;
    if constexpr (Epi::AFTER_DRAIN) { E.fused(acc, cur, wr, wc, fr, fq, lds, wid, lane); S.done(cur); }
    PG8_STAMP();
    if (STAMP && wid == 0) { stamps[lane] = lane < nts ? (((unsigned long long)(unsigned)ts_hi << 32) | (unsigned)ts_lo) : 0ull;
        if (lane == 62) stamps[62] = rt_entry; if (lane == 63) stamps[63] = (unsigned long long)wall_clock64(); }
#undef PG8_STAMP
#undef PG8_SA
#undef PG8_SB
#undef PG8_STAGE
#undef PG8_LDA
#undef PG8_LDB
#undef PG8_MMA
#undef PG8_WAIT_V
#undef PG8_WAIT_L
#undef PG8_BAR
#undef PG8_SCHED
}
}

using pg8::bf16_t; using pg8::bf16x8; using pg8::f32x4; using pg8::u32x4;
typedef unsigned u32x2 __attribute__((ext_vector_type(2)));
typedef float f32x2 __attribute__((ext_vector_type(2)));

constexpr int NT_LAT = 65536, NT_CTX = 2048, NT_ALL = NT_LAT + NT_CTX, DM = 1024, FF = 2816, EIN = 3328, OIN = 6144;
constexpr int NTHREADS = 512, NWAVES = 8;
constexpr int LDS_BYTES = 157696;
constexpr float EPS = 1e-6f;
constexpr int C_AQ = 0, C_AK = 512, C_AV = 640, C_BQ = 768, C_BFF = 1280, C_BFB = 1792, C_BI = 2304, C_BG = 2816;
constexpr int C_RQ = 0, C_RK = 1024, C_RV = 2048, C_RG = 4096;

constexpr size_t al256(size_t x) { return (x + 255) & ~(size_t)255; }
constexpr size_t WS_WT_EIN = 0;
constexpr size_t WS_WT_EOUT = WS_WT_EIN + al256((size_t)EIN * DM * 2);
constexpr size_t WS_WT_OIN = WS_WT_EOUT + al256((size_t)DM * DM * 2);
constexpr size_t WS_WT_OOUT = WS_WT_OIN + al256((size_t)OIN * DM * 2);
constexpr size_t WS_WT_FIN = WS_WT_OOUT + al256((size_t)DM * 2048 * 2);
constexpr size_t WS_WT_FOUT = WS_WT_FIN + al256((size_t)2 * 2 * FF * DM * 2);
constexpr size_t WS_MODS = WS_WT_FOUT + al256((size_t)2 * DM * FF * 2);
constexpr size_t WS_ROPE_AX = WS_MODS + al256((size_t)2 * 9 * 6144 * 4);
constexpr size_t WS_ROPE_RT = WS_ROPE_AX + al256((size_t)8192 * 32 * 2 * 4);
constexpr size_t WS_LB = WS_ROPE_RT + al256((size_t)8192 * 128 * 2 * 4);
constexpr size_t WS_CTXR = WS_LB + al256(512 * 4);
constexpr size_t WS_HA = WS_CTXR + al256((size_t)NT_CTX * DM * 4);
constexpr size_t WS_OB = WS_HA + al256((size_t)NT_ALL * DM * 2);
constexpr size_t WS_BIG = WS_OB + al256((size_t)NT_ALL * 512 * 2);
constexpr size_t BIG_P1_BYTES = (size_t)33792 * OIN * 2;
constexpr size_t BIG_O_BYTES = (size_t)32768 * 2048 * 2;
constexpr size_t WS_OFW = WS_BIG + BIG_P1_BYTES;
constexpr size_t WS_OBW = WS_OFW + BIG_O_BYTES;
constexpr size_t WS_END1 = WS_OBW + BIG_O_BYTES;
constexpr size_t WS_END0 = WS_BIG + (size_t)NT_ALL * EIN * 2;
constexpr size_t WS_END = WS_END1 > WS_END0 ? WS_END1 : WS_END0;

DI float bf2f(unsigned short b) { return __uint_as_float(((unsigned)b) << 16); }
DI unsigned short f2bf(float f) { unsigned u = __float_as_uint(f); u += 0x7fffu + ((u >> 16) & 1u); return (unsigned short)(u >> 16); }
DI unsigned pk2(float lo, float hi) { return (unsigned)f2bf(lo) | ((unsigned)f2bf(hi) << 16); }
DI void unpack8(const bf16x8 v, float* f) {
#pragma unroll
    for (int i = 0; i < 8; ++i) f[i] = bf2f((unsigned short)v[i]);
}
DI bf16x8 pack8(const float* f) { u32x4 p; p.x = pk2(f[0], f[1]); p.y = pk2(f[2], f[3]); p.z = pk2(f[4], f[5]); p.w = pk2(f[6], f[7]); return __builtin_bit_cast(bf16x8, p); }
DI float wave_sum(float v) {
#pragma unroll
    for (int o = 1; o < 64; o <<= 1) v += __shfl_xor(v, o);
    return v;
}
DI float siluf(float x) { return x / (1.0f + __expf(-x)); }
DI float sigmf(float x) { return 1.0f / (1.0f + __expf(-x)); }
#define LDS_WAIT() asm volatile("s_waitcnt lgkmcnt(0)" ::: "memory")
#define MFMA16(a, b, c) __builtin_amdgcn_mfma_f32_16x16x32_bf16((a), (b), (c), 0, 0, 0)

struct Args { const float* in[17]; float* out; unsigned char* ws; };

DI void transpose_item(const float* W, int K, int N, bf16_t* WT, int k0, int n0, int drow0, LAS float* scr, int lane) {
#pragma unroll 8
    for (int i = 0; i < 32; ++i) { const int kk = 2 * i + (lane >> 5); scr[kk * 33 + (lane & 31)] = W[(size_t)(k0 + kk) * N + n0 + (lane & 31)]; }
    LDS_WAIT();
    const int c = lane & 7;
#pragma unroll
    for (int j = 0; j < 4; ++j) { const int n = (lane >> 3) + 8 * j; const LAS float* s = scr + (8 * c) * 33 + n;
        u32x4 o; o.x = pk2(s[0 * 33], s[1 * 33]); o.y = pk2(s[2 * 33], s[3 * 33]); o.z = pk2(s[4 * 33], s[5 * 33]); o.w = pk2(s[6 * 33], s[7 * 33]);
        *(u32x4*)(WT + (size_t)(drow0 + n) * K + k0 + 8 * c) = o; }
    LDS_WAIT();
}
DI void transpose_matrix(const float* W, int K, int N, bf16_t* WT, bool ffn_in, int& it0, int gw, int ngw, LAS float* scr, int lane) {
    const int nblk = N / 32, nitems = (K / 64) * nblk;
    int first = (gw - it0 % ngw + ngw) % ngw;
    for (int it = first; it < nitems; it += ngw) {
        const int kb = it / nblk, nb = it % nblk, n0 = nb * 32;
        int drow0 = n0;
        if (ffn_in) { const int s = n0 / FF, j = n0 % FF, p = j / 128, jj = j % 128; drow0 = 256 * p + 128 * s + jj; }
        transpose_item(W, K, N, WT, kb * 64, n0, drow0, scr, lane);
    }
    it0 += nitems;
}

DI void mods_phase(const Args& a, float* mods, LAS unsigned char* lds) {
    const int tid = pg8::pg8_opaque_tid();
    LAS float* sc = (LAS float*)lds;
    LAS float* red = (LAS float*)(lds + 9 * 1024 * 4);
    if ((int)blockIdx.x >= 192) return;
    for (int i = tid; i < 9 * 1024; i += NTHREADS) { const int r = i >> 10, k = i & 1023; const float v = r < 8 ? a.in[1][r * 1024 + k] : a.in[3][k]; sc[i] = siluf(v); }
    __syncthreads();
    for (int it = blockIdx.x; it < 192; it += gridDim.x) {
        const int l = it / 96, n0 = (it % 96) * 64, nl = tid & 63, kp = tid >> 6;
        const float* w = a.in[4] + (size_t)l * 1024 * 6144 + n0 + nl;
        float acc[9];
#pragma unroll
        for (int r = 0; r < 9; ++r) acc[r] = 0.f;
        for (int k = kp * 128; k < kp * 128 + 128; ++k) { const float wv = w[(size_t)k * 6144];
#pragma unroll
            for (int r = 0; r < 9; ++r) acc[r] += sc[r * 1024 + k] * wv; }
#pragma unroll
        for (int r = 0; r < 9; ++r) red[(kp * 9 + r) * 64 + nl] = acc[r];
        __syncthreads();
        for (int i = tid; i < 576; i += NTHREADS) { const int r = i >> 6, n = i & 63; float s = 0.f;
#pragma unroll
            for (int p = 0; p < 8; ++p) s += red[(p * 9 + r) * 64 + n];
            mods[(size_t)(l * 9 + r) * 6144 + n0 + n] = s + a.in[5][l * 6144 + n0 + n]; }
        __syncthreads();
    }
}

DI void tables_phase(const Args& a, float* ax, float* rt, float* lb) {
    const int gt = blockIdx.x * NTHREADS + pg8::pg8_opaque_tid(), ngt = gridDim.x * NTHREADS;
    for (int i = gt; i < 8192 * 32; i += ngt) { const int t = i >> 5, j = i & 31; const double p = (j < 16) ? (double)(t >> 6) : (double)(t & 63);
        const double inv = pow(10000.0, -(double)(j & 15) / 16.0); const double ang = p * inv;
        ax[i] = (float)cos(ang); ax[8192 * 32 + i] = (float)sin(ang); }
    for (int i = gt; i < 8192 * 128; i += ngt) { const int t = i >> 7, j = i & 127; const double th = pow(10000.0, -(double)j / 127.0); const double ang = (double)t * th;
        rt[i] = (float)cos(ang); rt[8192 * 128 + i] = (float)sin(ang); }
    for (int i = gt; i < 512; i += ngt) { const float a0 = a.in[14][i], a1 = a.in[14][512 + i]; lb[i] = 1.0f / (1.0f + expf(a1 - a0)); }
}

DI void normmod_phase(const float* xlat, const float* xctx, int b0, int nlat, int nrows, const float* g, const float* mods, int sidx, bf16_t* out) {
    const int tid = pg8::pg8_opaque_tid(), lane = tid & 63, wave = __builtin_amdgcn_readfirstlane(tid >> 6);
    const int gw = blockIdx.x * NWAVES + wave, ngw = gridDim.x * NWAVES;
    f32x4 gv[4];
#pragma unroll
    for (int j = 0; j < 4; ++j) gv[j] = *(const f32x4*)(g + 4 * lane + 256 * j);
    for (int lr = gw; lr < nrows; lr += ngw) {
        const float* src; int mrow;
        if (lr < nlat) { const size_t grow = (size_t)b0 * 8192 + lr; src = xlat + grow * 1024; mrow = (int)(grow >> 13); }
        else { const size_t crow = (size_t)b0 * 256 + (lr - nlat); src = xctx + crow * 1024; mrow = 8; }
        f32x4 v[4]; float ss = 0.f;
#pragma unroll
        for (int j = 0; j < 4; ++j) { v[j] = *(const f32x4*)(src + 4 * lane + 256 * j); ss += (v[j].x * v[j].x + v[j].y * v[j].y) + (v[j].z * v[j].z + v[j].w * v[j].w); }
        const float r = rsqrtf(wave_sum(ss) * (1.0f / 1024.0f) + EPS);
        const float* sh = mods + (size_t)mrow * 6144 + sidx * 1024; const float* scl = sh + 1024;
#pragma unroll
        for (int j = 0; j < 4; ++j) { const f32x4 s4 = *(const f32x4*)(sh + 4 * lane + 256 * j), c4 = *(const f32x4*)(scl + 4 * lane + 256 * j);
            const f32x4 y = v[j] * r * gv[j] * (c4 + 1.0f) + s4;
            u32x2 w; w.x = pk2(y.x, y.y); w.y = pk2(y.z, y.w);
            *(u32x2*)(out + (size_t)lr * 1024 + 4 * lane + 256 * j) = w; }
    }
}

DI void attn_phase(const bf16_t* P, bf16_t* mix, const float* qkg, const float* sink, const float* axc, const float* axs, LAS unsigned char* lds) {
    const int tid = pg8::pg8_opaque_tid(), lane = tid & 63, wave = __builtin_amdgcn_readfirstlane(tid >> 6);
    const int fr = lane & 15, fq = lane >> 4;
    LAS bf16_t* Ks = (LAS bf16_t*)lds; LAS bf16_t* Vt = (LAS bf16_t*)(lds + 9216); LAS bf16_t* Pw = (LAS bf16_t*)(lds + 18432 + wave * 2304);
    for (int it = blockIdx.x; it < 4224; it += gridDim.x) {
        const int g = it & 3; int r = it >> 2; const int qt = r % 66; r /= 66; const int kvh = r & 1, b = r >> 1; const int hq = kvh * 4 + g;
        const bool cq = qt >= 64;
        const int q0 = cq ? (qt - 64) * 128 : qt * 128;
        const size_t qrow0 = cq ? (size_t)NT_LAT + b * 256 + q0 : (size_t)b * 8192 + q0;
        bf16x8 aq[2];
        {   const bf16_t* qp = P + (qrow0 + 16 * wave + fr) * EIN + C_AQ + hq * 64;
            float x1[8], x2[8]; unpack8(*(const bf16x8*)(qp + 8 * fq), x1); unpack8(*(const bf16x8*)(qp + 32 + 8 * fq), x2);
            float ss = 0.f;
#pragma unroll
            for (int i = 0; i < 8; ++i) ss += x1[i] * x1[i] + x2[i] * x2[i];
            ss += __shfl_xor(ss, 16); ss += __shfl_xor(ss, 32);
            const float rn = rsqrtf(ss * (1.0f / 64.0f) + EPS);
#pragma unroll
            for (int i = 0; i < 8; ++i) { x1[i] *= rn * qkg[8 * fq + i]; x2[i] *= rn * qkg[32 + 8 * fq + i]; }
            if (!cq) { const int pos = q0 + 16 * wave + fr; const float* cp = axc + pos * 32 + 8 * fq; const float* sp = axs + pos * 32 + 8 * fq;
#pragma unroll
                for (int i = 0; i < 8; ++i) { const float c = cp[i], s = sp[i]; const float o1 = x1[i] * c - x2[i] * s, o2 = x2[i] * c + x1[i] * s; x1[i] = o1; x2[i] = o2; } }
            aq[0] = pack8(x1); aq[1] = pack8(x2); }
        float m_[4], l_[4]; f32x4 oacc[4];
        const float sk = sink[hq];
#pragma unroll
        for (int i = 0; i < 4; ++i) { m_[i] = sk; l_[i] = 1.0f; oacc[i] = (f32x4){0.f, 0.f, 0.f, 0.f}; }
        const int nblk = cq ? 4 : 10;
        for (int kb = 0; kb < nblk; ++kb) {
            const bool kc = cq || kb >= 6;
            int kpos0; size_t krow0;
            if (kc) { const int cb = cq ? kb : kb - 6; kpos0 = cb * 64; krow0 = (size_t)NT_LAT + b * 256 + kpos0; }
            else { kpos0 = q0 - 128 + 64 * kb; if (kpos0 < 0 || kpos0 >= 8192) continue; krow0 = (size_t)b * 8192 + kpos0; }
            __syncthreads();
            if (tid < 256) {
                const int key = tid >> 2, c = tid & 3; const bf16_t* kp = P + (krow0 + key) * EIN + C_AK + kvh * 64;
                float x1[8], x2[8]; unpack8(*(const bf16x8*)(kp + 8 * c), x1); unpack8(*(const bf16x8*)(kp + 32 + 8 * c), x2);
                float ss = 0.f;
#pragma unroll
                for (int i = 0; i < 8; ++i) ss += x1[i] * x1[i] + x2[i] * x2[i];
                ss += __shfl_xor(ss, 1); ss += __shfl_xor(ss, 2);
                const float rn = rsqrtf(ss * (1.0f / 64.0f) + EPS);
#pragma unroll
                for (int i = 0; i < 8; ++i) { x1[i] *= rn * qkg[64 + 8 * c + i]; x2[i] *= rn * qkg[64 + 32 + 8 * c + i]; }
                if (!kc) { const int pos = kpos0 + key; const float* cp = axc + pos * 32 + 8 * c; const float* sp = axs + pos * 32 + 8 * c;
#pragma unroll
                    for (int i = 0; i < 8; ++i) { const float cs = cp[i], sn = sp[i]; const float o1 = x1[i] * cs - x2[i] * sn, o2 = x2[i] * cs + x1[i] * sn; x1[i] = o1; x2[i] = o2; } }
                *(LAS bf16x8*)(Ks + key * 72 + 8 * c) = pack8(x1); *(LAS bf16x8*)(Ks + key * 72 + 32 + 8 * c) = pack8(x2);
            } else {
                const int t = tid - 256, key = t & 63, c = t >> 6; const bf16_t* vp = P + (krow0 + key) * EIN + C_AV + kvh * 64 + 16 * c;
                const bf16x8 v0 = *(const bf16x8*)vp, v1 = *(const bf16x8*)(vp + 8);
#pragma unroll
                for (int j = 0; j < 8; ++j) { Vt[(16 * c + j) * 72 + key] = (bf16_t)v0[j]; Vt[(16 * c + 8 + j) * 72 + key] = (bf16_t)v1[j]; }
            }
            __syncthreads();
            f32x4 sacc[4];
#pragma unroll
            for (int n = 0; n < 4; ++n) { sacc[n] = (f32x4){0.f, 0.f, 0.f, 0.f};
#pragma unroll
                for (int ks = 0; ks < 2; ++ks) { const bf16x8 bk = *(const LAS bf16x8*)(Ks + (16 * n + fr) * 72 + ks * 32 + 8 * fq); sacc[n] = MFMA16(aq[ks], bk, sacc[n]); } }
            float mx[4];
#pragma unroll
            for (int i = 0; i < 4; ++i) { mx[i] = -INFINITY;
#pragma unroll
                for (int n = 0; n < 4; ++n) { float s = sacc[n][i] * 0.125f;
                    if (!kc) { const int dlt = (kpos0 + 16 * n + fr) - (q0 + 16 * wave + 4 * fq + i); if (dlt > 128 || dlt < -128) s = -INFINITY; }
                    sacc[n][i] = s; mx[i] = fmaxf(mx[i], s); } }
#pragma unroll
            for (int i = 0; i < 4; ++i) { mx[i] = fmaxf(mx[i], __shfl_xor(mx[i], 1)); mx[i] = fmaxf(mx[i], __shfl_xor(mx[i], 2)); mx[i] = fmaxf(mx[i], __shfl_xor(mx[i], 4)); mx[i] = fmaxf(mx[i], __shfl_xor(mx[i], 8)); }
#pragma unroll
            for (int i = 0; i < 4; ++i) { const float mn = fmaxf(m_[i], mx[i]); const float alpha = __expf(m_[i] - mn); m_[i] = mn; float rs = 0.f;
#pragma unroll
                for (int n = 0; n < 4; ++n) { const float p = __expf(sacc[n][i] - mn); sacc[n][i] = p; rs += p; }
                rs += __shfl_xor(rs, 1); rs += __shfl_xor(rs, 2); rs += __shfl_xor(rs, 4); rs += __shfl_xor(rs, 8);
                l_[i] = l_[i] * alpha + rs;
#pragma unroll
                for (int nd = 0; nd < 4; ++nd) oacc[nd][i] *= alpha; }
#pragma unroll
            for (int n = 0; n < 4; ++n)
#pragma unroll
                for (int i = 0; i < 4; ++i) Pw[(4 * fq + i) * 72 + 16 * n + fr] = f2bf(sacc[n][i]);
            LDS_WAIT(); __builtin_amdgcn_wave_barrier();
#pragma unroll
            for (int ks = 0; ks < 2; ++ks) { const bf16x8 pa = *(const LAS bf16x8*)(Pw + fr * 72 + ks * 32 + 8 * fq);
#pragma unroll
                for (int nd = 0; nd < 4; ++nd) { const bf16x8 vb = *(const LAS bf16x8*)(Vt + (16 * nd + fr) * 72 + ks * 32 + 8 * fq); oacc[nd] = MFMA16(pa, vb, oacc[nd]); } }
            LDS_WAIT(); __builtin_amdgcn_wave_barrier();
        }
#pragma unroll
        for (int i = 0; i < 4; ++i) { const float inv = 1.0f / l_[i]; bf16_t* op = mix + (qrow0 + 16 * wave + 4 * fq + i) * 1024 + hq * 64 + fr;
#pragma unroll
            for (int nd = 0; nd < 4; ++nd) op[16 * nd] = f2bf(oacc[nd][i] * inv); }
    }
}

constexpr int HG_QI = 0, HG_QO = 17408, HG_KI = 34816, HG_KT = 52224, HG_VT = 70656, HG_PM = 75264, HG_ST = 84480, HG_RED = 93184, HG_DEC = 95744;
DI void hgrn_scan_phase(const bf16_t* P, bf16_t* mix, bf16_t* ob, const float* lb, LAS unsigned char* lds) {
    const int tid = pg8::pg8_opaque_tid(), lane = tid & 63, wave = __builtin_amdgcn_readfirstlane(tid >> 6);
    const int fr = lane & 15, fq = lane >> 4;
    LAS bf16_t* Qi = (LAS bf16_t*)(lds + HG_QI); LAS bf16_t* Qo = (LAS bf16_t*)(lds + HG_QO); LAS bf16_t* Ki = (LAS bf16_t*)(lds + HG_KI); LAS bf16_t* Kt = (LAS bf16_t*)(lds + HG_KT);
    LAS bf16_t* Vt = (LAS bf16_t*)(lds + HG_VT); LAS bf16_t* Pm = (LAS bf16_t*)(lds + HG_PM); LAS bf16_t* St = (LAS bf16_t*)(lds + HG_ST);
    LAS float* red = (LAS float*)(lds + HG_RED); LAS float* dec = (LAS float*)(lds + HG_DEC);
    for (int unit = blockIdx.x; unit < 256; unit += gridDim.x) {
        const int sl = unit & 3, dir = (unit >> 2) & 1, h = (unit >> 3) & 3, b = unit >> 5;
        __syncthreads();
        for (int i = tid; i < 8704 / 4; i += NTHREADS) ((LAS unsigned*)(lds + HG_ST))[i] = 0u;
        f32x4 sacc[2]; sacc[0] = (f32x4){0.f, 0.f, 0.f, 0.f}; sacc[1] = sacc[0];
        const int d = tid & 127, part = tid >> 7;
        const float lbv = lb[h * 128 + d];
        const int cf = (dir ? C_BFB : C_BFF) + h * 128 + d, cqc = C_BQ + h * 128 + d;
        for (int n = 0; n < 132; ++n) {
            size_t row0;
            if (n < 4) { const int cc = dir ? 3 - n : n; row0 = (size_t)NT_LAT + b * 256 + cc * 64; }
            else { const int cc = dir ? 127 - (n - 4) : n - 4; row0 = (size_t)b * 8192 + cc * 64; }
            float lf[16], kk[16], qs[16];
#pragma unroll
            for (int i = 0; i < 16; ++i) { const int t = 16 * part + i; const int tok = dir ? 63 - t : t; const bf16_t* rp = P + (row0 + tok) * EIN;
                const float fraw = bf2f(rp[cf]), qr = bf2f(rp[cqc]); const float f = lbv + (1.0f - lbv) * sigmf(fraw);
                lf[i] = __logf(f); kk[i] = 1.0f - f; qs[i] = siluf(qr); }
#pragma unroll
            for (int i = 1; i < 16; ++i) lf[i] += lf[i - 1];
            red[part * 128 + d] = lf[15]; if (part == 2) red[512 + d] = lf[0];
            if (tid < 256) { const int t = tid & 63, c = tid >> 6; const int tok = dir ? 63 - t : t;
                const bf16x8 v = *(const bf16x8*)(P + (row0 + tok) * EIN + C_BI + h * 128 + sl * 32 + 8 * c);
#pragma unroll
                for (int j = 0; j < 8; ++j) Vt[(8 * c + j) * 72 + t] = (bf16_t)v[j]; }
            __syncthreads();
            {   const float r0 = red[d], r1 = red[128 + d], r2 = red[256 + d], r3 = red[384 + d], l32 = red[512 + d];
                const float pre = part == 0 ? 0.f : (part == 1 ? r0 : (part == 2 ? r0 + r1 : r0 + r1 + r2));
                const float total = (r0 + r1) + (r2 + r3), ref = r0 + r1 + l32;
                if (part == 0) dec[d] = __expf(total);
                float kp[16];
#pragma unroll
                for (int i = 0; i < 16; ++i) { const float cum = pre + lf[i]; const int t = 16 * part + i;
                    Qi[t * 136 + d] = f2bf(qs[i] * __expf(cum - ref)); Qo[t * 136 + d] = f2bf(qs[i] * __expf(cum));
                    Ki[t * 136 + d] = f2bf(kk[i] * __expf(ref - cum)); kp[i] = kk[i] * __expf(total - cum); }
                *(LAS bf16x8*)(Kt + d * 72 + 16 * part) = pack8(kp); *(LAS bf16x8*)(Kt + d * 72 + 16 * part + 8) = pack8(kp + 8); }
            __syncthreads();
            {   const int mt = wave >> 1, nt0 = 2 * (wave & 1); f32x4 sc[2]; sc[0] = (f32x4){0.f, 0.f, 0.f, 0.f}; sc[1] = sc[0];
#pragma unroll
                for (int ks = 0; ks < 4; ++ks) { const bf16x8 a = *(const LAS bf16x8*)(Qi + (16 * mt + fr) * 136 + ks * 32 + 8 * fq);
#pragma unroll
                    for (int n2 = 0; n2 < 2; ++n2) { const bf16x8 bb = *(const LAS bf16x8*)(Ki + (16 * (nt0 + n2) + fr) * 136 + ks * 32 + 8 * fq); sc[n2] = MFMA16(a, bb, sc[n2]); } }
#pragma unroll
                for (int n2 = 0; n2 < 2; ++n2)
#pragma unroll
                    for (int i = 0; i < 4; ++i) { const int t = 16 * mt + 4 * fq + i, s = 16 * (nt0 + n2) + fr; Pm[t * 72 + s] = f2bf(s <= t ? sc[n2][i] : 0.f); } }
            __syncthreads();
            {   const int mt = wave >> 1, nt = wave & 1; f32x4 o = (f32x4){0.f, 0.f, 0.f, 0.f};
#pragma unroll
                for (int ks = 0; ks < 2; ++ks) { const bf16x8 a = *(const LAS bf16x8*)(Pm + (16 * mt + fr) * 72 + ks * 32 + 8 * fq); const bf16x8 bb = *(const LAS bf16x8*)(Vt + (16 * nt + fr) * 72 + ks * 32 + 8 * fq); o = MFMA16(a, bb, o); }
#pragma unroll
                for (int ks = 0; ks < 4; ++ks) { const bf16x8 a = *(const LAS bf16x8*)(Qo + (16 * mt + fr) * 136 + ks * 32 + 8 * fq); const bf16x8 bb = *(const LAS bf16x8*)(St + (16 * nt + fr) * 136 + ks * 32 + 8 * fq); o = MFMA16(a, bb, o); }
#pragma unroll
                for (int i = 0; i < 4; ++i) { const int t = 16 * mt + 4 * fq + i; const int tok = dir ? 63 - t : t; const int e = h * 128 + sl * 32 + 16 * nt + fr;
                    if (dir) ob[(row0 + tok) * 512 + e] = f2bf(o[i]); else mix[(row0 + tok) * 1024 + 512 + e] = f2bf(o[i]); } }
            {
#pragma unroll
                for (int et = 0; et < 2; ++et)
#pragma unroll
                    for (int i = 0; i < 4; ++i) sacc[et][i] *= dec[16 * wave + 4 * fq + i];
#pragma unroll
                for (int ks = 0; ks < 2; ++ks) { const bf16x8 a = *(const LAS bf16x8*)(Kt + (16 * wave + fr) * 72 + ks * 32 + 8 * fq);
#pragma unroll
                    for (int et = 0; et < 2; ++et) { const bf16x8 bb = *(const LAS bf16x8*)(Vt + (16 * et + fr) * 72 + ks * 32 + 8 * fq); sacc[et] = MFMA16(a, bb, sacc[et]); } } }
            __syncthreads();
#pragma unroll
            for (int et = 0; et < 2; ++et) { u32x2 w; w.x = pk2(sacc[et][0], sacc[et][1]); w.y = pk2(sacc[et][2], sacc[et][3]);
                *(LAS u32x2*)(St + (16 * et + fr) * 136 + 16 * wave + 4 * fq) = w; }
        }
    }
}
DI void hgrn_norm_phase(const bf16_t* P, bf16_t* mix, const bf16_t* ob, const float* outg) {
    const int tid = pg8::pg8_opaque_tid(), lane = tid & 63, wave = __builtin_amdgcn_readfirstlane(tid >> 6);
    const int gw = blockIdx.x * NWAVES + wave, ngw = gridDim.x * NWAVES;
    float gv[8];
#pragma unroll
    for (int i = 0; i < 8; ++i) gv[i] = outg[8 * (lane & 15) + i];
    for (int row = gw; row < NT_ALL; row += ngw) {
        float of[8], o2[8], gg[8];
        unpack8(*(const bf16x8*)(mix + (size_t)row * 1024 + 512 + 8 * lane), of); unpack8(*(const bf16x8*)(ob + (size_t)row * 512 + 8 * lane), o2); unpack8(*(const bf16x8*)(P + (size_t)row * EIN + C_BG + 8 * lane), gg);
        float ss = 0.f;
#pragma unroll
        for (int i = 0; i < 8; ++i) { of[i] += o2[i]; ss += of[i] * of[i]; }
        ss += __shfl_xor(ss, 1); ss += __shfl_xor(ss, 2); ss += __shfl_xor(ss, 4); ss += __shfl_xor(ss, 8);
        const float rn = rsqrtf(ss * (1.0f / 128.0f) + EPS);
#pragma unroll
        for (int i = 0; i < 8; ++i) of[i] = of[i] * rn * gv[i] * siluf(gg[i]);
        *(bf16x8*)(mix + (size_t)row * 1024 + 512 + 8 * lane) = pack8(of);
    }
}

constexpr int RT_Q = 0, RT_K = 33792, RT_KT = 67584, RT_VT = 104448, RT_PM = 113664, RT_ST = 122880;
DI void ret_scan_phase(const bf16_t* P1, bf16_t* ofw, bf16_t* obw, const float* rtc, const float* rts, LAS unsigned char* lds) {
    const int tid = pg8::pg8_opaque_tid(), lane = tid & 63, wave = __builtin_amdgcn_readfirstlane(tid >> 6);
    const int fr = lane & 15, fq = lane >> 4;
    LAS bf16_t* Q = (LAS bf16_t*)(lds + RT_Q); LAS bf16_t* K = (LAS bf16_t*)(lds + RT_K); LAS bf16_t* Kt = (LAS bf16_t*)(lds + RT_KT);
    LAS bf16_t* Vt = (LAS bf16_t*)(lds + RT_VT); LAS bf16_t* Pm = (LAS bf16_t*)(lds + RT_PM); LAS bf16_t* St = (LAS bf16_t*)(lds + RT_ST);
    for (int unit = blockIdx.x; unit < 256; unit += gridDim.x) {
        const int sl = unit & 7, dir = (unit >> 3) & 1, h = (unit >> 4) & 3, bl = unit >> 6;
        const int hh = dir ? 3 - h : h;
        const float lg2 = log2f(1.0f - exp2f(-5.0f - (float)hh));
        const float g64 = exp2f(64.0f * lg2);
        __syncthreads();
        for (int i = tid; i < 33792 / 4; i += NTHREADS) ((LAS unsigned*)(lds + RT_ST))[i] = 0u;
        f32x4 sacc[2][4];
#pragma unroll
        for (int a = 0; a < 2; ++a)
#pragma unroll
            for (int e = 0; e < 4; ++e) sacc[a][e] = (f32x4){0.f, 0.f, 0.f, 0.f};
        for (int n = 0; n < 132; ++n) {
            const bool is_ctx = n < 4; int cc; size_t row0;
            if (is_ctx) { cc = dir ? 3 - n : n; row0 = (size_t)32768 + bl * 256 + cc * 64; }
            else { cc = dir ? 127 - (n - 4) : n - 4; row0 = (size_t)bl * 8192 + cc * 64; }
            {   const int t = tid >> 3, c = tid & 7; const int tok = dir ? 63 - t : t; const bf16_t* rp = P1 + (row0 + tok) * OIN + h * 256 + 16 * c;
                float q1[16], q2[16], k1[16], k2[16];
                unpack8(*(const bf16x8*)(rp + C_RQ), q1); unpack8(*(const bf16x8*)(rp + C_RQ + 8), q1 + 8); unpack8(*(const bf16x8*)(rp + C_RQ + 128), q2); unpack8(*(const bf16x8*)(rp + C_RQ + 136), q2 + 8);
                unpack8(*(const bf16x8*)(rp + C_RK), k1); unpack8(*(const bf16x8*)(rp + C_RK + 8), k1 + 8); unpack8(*(const bf16x8*)(rp + C_RK + 128), k2); unpack8(*(const bf16x8*)(rp + C_RK + 136), k2 + 8);
                if (!is_ctx) { const int pos = cc * 64 + tok; const float* cp = rtc + (size_t)pos * 128 + 16 * c; const float* sp = rts + (size_t)pos * 128 + 16 * c;
#pragma unroll
                    for (int i = 0; i < 16; ++i) { const float cs = cp[i], sn = sp[i];
                        const float a1 = q1[i] * cs - q2[i] * sn, a2 = q2[i] * cs + q1[i] * sn; q1[i] = a1; q2[i] = a2;
                        const float b1 = k1[i] * cs - k2[i] * sn, b2 = k2[i] * cs + k1[i] * sn; k1[i] = b1; k2[i] = b2; } }
#pragma unroll
                for (int i = 0; i < 16; ++i) { k1[i] *= 0.0625f; k2[i] *= 0.0625f; }
                *(LAS bf16x8*)(Q + t * 264 + 16 * c) = pack8(q1); *(LAS bf16x8*)(Q + t * 264 + 16 * c + 8) = pack8(q1 + 8);
                *(LAS bf16x8*)(Q + t * 264 + 128 + 16 * c) = pack8(q2); *(LAS bf16x8*)(Q + t * 264 + 136 + 16 * c) = pack8(q2 + 8);
                *(LAS bf16x8*)(K + t * 264 + 16 * c) = pack8(k1); *(LAS bf16x8*)(K + t * 264 + 16 * c + 8) = pack8(k1 + 8);
                *(LAS bf16x8*)(K + t * 264 + 128 + 16 * c) = pack8(k2); *(LAS bf16x8*)(K + t * 264 + 136 + 16 * c) = pack8(k2 + 8); }
            {   const int tv = tid & 63, wv = tid >> 6; const int tokv = dir ? 63 - tv : tv;
                const bf16x8 v = *(const bf16x8*)(P1 + (row0 + tokv) * OIN + C_RV + h * 512 + sl * 64 + 8 * wv);
#pragma unroll
                for (int j = 0; j < 8; ++j) Vt[(8 * wv + j) * 72 + tv] = (bf16_t)v[j]; }
            __syncthreads();
            {   const int t2 = tid & 63, w2 = tid >> 6; const float scl = exp2f((float)(63 - t2) * lg2);
#pragma unroll
                for (int jj = 0; jj < 4; ++jj) { const int j = 4 * w2 + jj; const bf16x8 kv = *(const LAS bf16x8*)(K + t2 * 264 + 8 * j);
#pragma unroll
                    for (int i = 0; i < 8; ++i) Kt[(8 * j + i) * 72 + t2] = f2bf(bf2f((unsigned short)kv[i]) * scl); } }
            {   const int mt = wave >> 1, nt0 = 2 * (wave & 1); f32x4 sc[2]; sc[0] = (f32x4){0.f, 0.f, 0.f, 0.f}; sc[1] = sc[0];
#pragma unroll
                for (int ks = 0; ks < 8; ++ks) { const bf16x8 a = *(const LAS bf16x8*)(Q + (16 * mt + fr) * 264 + ks * 32 + 8 * fq);
#pragma unroll
                    for (int n2 = 0; n2 < 2; ++n2) { const bf16x8 bb = *(const LAS bf16x8*)(K + (16 * (nt0 + n2) + fr) * 264 + ks * 32 + 8 * fq); sc[n2] = MFMA16(a, bb, sc[n2]); } }
#pragma unroll
                for (int n2 = 0; n2 < 2; ++n2)
#pragma unroll
                    for (int i = 0; i < 4; ++i) { const int t = 16 * mt + 4 * fq + i, s = 16 * (nt0 + n2) + fr;
                        Pm[t * 72 + s] = f2bf(s <= t ? sc[n2][i] * exp2f((float)(t - s) * lg2) : 0.f); } }
            __syncthreads();
            if (!is_ctx) { const int mt = wave >> 1, et0 = 2 * (wave & 1); f32x4 o[2]; o[0] = (f32x4){0.f, 0.f, 0.f, 0.f}; o[1] = o[0];
#pragma unroll
                for (int ks = 0; ks < 8; ++ks) { const bf16x8 a = *(const LAS bf16x8*)(Q + (16 * mt + fr) * 264 + ks * 32 + 8 * fq);
#pragma unroll
                    for (int e2 = 0; e2 < 2; ++e2) { const bf16x8 bb = *(const LAS bf16x8*)(St + (16 * (et0 + e2) + fr) * 264 + ks * 32 + 8 * fq); o[e2] = MFMA16(a, bb, o[e2]); } }
#pragma unroll
                for (int i = 0; i < 4; ++i) { const float rsc = exp2f((float)(16 * mt + 4 * fq + i + 1) * lg2); o[0][i] *= rsc; o[1][i] *= rsc; }
#pragma unroll
                for (int ks = 0; ks < 2; ++ks) { const bf16x8 a = *(const LAS bf16x8*)(Pm + (16 * mt + fr) * 72 + ks * 32 + 8 * fq);
#pragma unroll
                    for (int e2 = 0; e2 < 2; ++e2) { const bf16x8 bb = *(const LAS bf16x8*)(Vt + (16 * (et0 + e2) + fr) * 72 + ks * 32 + 8 * fq); o[e2] = MFMA16(a, bb, o[e2]); } }
                bf16_t* ob = dir ? obw : ofw;
#pragma unroll
                for (int i = 0; i < 4; ++i) { const int t = 16 * mt + 4 * fq + i; const int tok = dir ? 63 - t : t;
                    bf16_t* op = ob + (row0 + tok) * 2048 + h * 512 + sl * 64 + 16 * et0 + fr; op[0] = f2bf(o[0][i]); op[16] = f2bf(o[1][i]); } }
            {
#pragma unroll
                for (int dt = 0; dt < 2; ++dt)
#pragma unroll
                    for (int et = 0; et < 4; ++et) sacc[dt][et] *= g64;
#pragma unroll
                for (int ks = 0; ks < 2; ++ks)
#pragma unroll
                    for (int dt = 0; dt < 2; ++dt) { const bf16x8 a = *(const LAS bf16x8*)(Kt + (16 * (2 * wave + dt) + fr) * 72 + ks * 32 + 8 * fq);
#pragma unroll
                        for (int et = 0; et < 4; ++et) { const bf16x8 bb = *(const LAS bf16x8*)(Vt + (16 * et + fr) * 72 + ks * 32 + 8 * fq); sacc[dt][et] = MFMA16(a, bb, sacc[dt][et]); } } }
            __syncthreads();
#pragma unroll
            for (int dt = 0; dt < 2; ++dt)
#pragma unroll
                for (int et = 0; et < 4; ++et) { u32x2 w; w.x = pk2(sacc[dt][et][0], sacc[dt][et][1]); w.y = pk2(sacc[dt][et][2], sacc[dt][et][3]);
                    *(LAS u32x2*)(St + (16 * et + fr) * 264 + 16 * (2 * wave + dt) + 4 * fq) = w; }
        }
    }
}
DI void ret_norm_phase(const bf16_t* P1, bf16_t* ofw, const bf16_t* obw) {
    const int tid = pg8::pg8_opaque_tid(), lane = tid & 63, wave = __builtin_amdgcn_readfirstlane(tid >> 6);
    const int gw = blockIdx.x * NWAVES + wave, ngw = gridDim.x * NWAVES;
    for (int idx = gw; idx < 32768 * 4; idx += ngw) {
        const int row = idx >> 2, h = idx & 3;
        float of[8], o2[8], gg[8];
        bf16_t* yp = ofw + (size_t)row * 2048 + h * 512 + 8 * lane;
        unpack8(*(const bf16x8*)yp, of); unpack8(*(const bf16x8*)(obw + (size_t)row * 2048 + h * 512 + 8 * lane), o2); unpack8(*(const bf16x8*)(P1 + (size_t)row * OIN + C_RG + h * 512 + 8 * lane), gg);
        float ss = 0.f;
#pragma unroll
        for (int i = 0; i < 8; ++i) { of[i] += o2[i]; ss += of[i] * of[i]; }
        const float rn = rsqrtf(wave_sum(ss) * (1.0f / 512.0f) + EPS);
#pragma unroll
        for (int i = 0; i < 8; ++i) of[i] = of[i] * rn * siluf(gg[i]);
        *(bf16x8*)yp = pack8(of);
    }
}

template <class Epi>
DI void run_gemm(LAS unsigned char* lds, const bf16_t* A, const bf16_t* Bt, int M, int N, int K, const Epi& E) {
    pg8::Gemm g{A, Bt, M, N, K}; pg8::StaticOrder S; S.init(M, N, (int)gridDim.x, (int)blockIdx.x);
    pg8::gemm_phase<Epi, pg8::StaticOrder, false>(lds, g, S, E, nullptr);
}

__global__ void __launch_bounds__(NTHREADS, 2) fwd_megakernel(Args a) {
    extern __shared__ __attribute__((aligned(16))) unsigned char lds_raw[];
    LAS unsigned char* lds = (LAS unsigned char*)lds_raw;
    cg::grid_group grid = cg::this_grid();
    unsigned char* ws = a.ws;
    bf16_t* wt_ein = (bf16_t*)(ws + WS_WT_EIN); bf16_t* wt_eout = (bf16_t*)(ws + WS_WT_EOUT); bf16_t* wt_oin = (bf16_t*)(ws + WS_WT_OIN); bf16_t* wt_oout = (bf16_t*)(ws + WS_WT_OOUT);
    bf16_t* wt_fin = (bf16_t*)(ws + WS_WT_FIN); bf16_t* wt_fout = (bf16_t*)(ws + WS_WT_FOUT);
    float* mods = (float*)(ws + WS_MODS); float* axt = (float*)(ws + WS_ROPE_AX); float* rtt = (float*)(ws + WS_ROPE_RT); float* lb = (float*)(ws + WS_LB);
    float* ctxr = (float*)(ws + WS_CTXR); bf16_t* ha = (bf16_t*)(ws + WS_HA); bf16_t* obuf = (bf16_t*)(ws + WS_OB); bf16_t* big = (bf16_t*)(ws + WS_BIG);
    bf16_t* ofw = (bf16_t*)(ws + WS_OFW); bf16_t* obw = (bf16_t*)(ws + WS_OBW);
    const float* x = a.in[0]; const float* ctx = a.in[2]; const float* normg = a.in[6]; float* out = a.out;

    mods_phase(a, mods, lds);
    __syncthreads();
    tables_phase(a, axt, rtt, lb);
    {   const int tid = pg8::pg8_opaque_tid(), lane = tid & 63, wave = __builtin_amdgcn_readfirstlane(tid >> 6);
        LAS float* scr = (LAS float*)(lds + wave * 16384);
        const int gw = blockIdx.x * NWAVES + wave, ngw = gridDim.x * NWAVES; int it0 = 0;
        transpose_matrix(a.in[9], DM, EIN, wt_ein, false, it0, gw, ngw, scr, lane);
        transpose_matrix(a.in[10], DM, DM, wt_eout, false, it0, gw, ngw, scr, lane);
        transpose_matrix(a.in[15], DM, OIN, wt_oin, false, it0, gw, ngw, scr, lane);
        transpose_matrix(a.in[16], 2048, DM, wt_oout, false, it0, gw, ngw, scr, lane);
        transpose_matrix(a.in[7], DM, 2 * FF, wt_fin, true, it0, gw, ngw, scr, lane);
        transpose_matrix(a.in[7] + (size_t)DM * 2 * FF, DM, 2 * FF, wt_fin + (size_t)2 * FF * DM, true, it0, gw, ngw, scr, lane);
        transpose_matrix(a.in[8], FF, DM, wt_fout, false, it0, gw, ngw, scr, lane);
        transpose_matrix(a.in[8] + (size_t)FF * DM, FF, DM, wt_fout + (size_t)DM * FF, false, it0, gw, ngw, scr, lane);
    }
    grid.sync();

    const float* mods0 = mods; const float* mods1 = mods + 9 * 6144;
    normmod_phase(x, ctx, 0, NT_LAT, NT_ALL, normg + 0, mods0, 0, ha);
    grid.sync();
    {   pg8::EpiStoreBf16 E{big, EIN}; run_gemm(lds, ha, wt_ein, NT_ALL, EIN, DM, E); }
    grid.sync();
    hgrn_scan_phase(big, ha, obuf, lb, lds);
    __syncthreads();
    attn_phase(big, ha, a.in[11], a.in[12], axt, axt + 8192 * 32, lds);
    grid.sync();
    hgrn_norm_phase(big, ha, obuf, a.in[13]);
    grid.sync();
    {   pg8::EpiResid E{x, out, ctx, ctxr, mods0 + 2 * 1024, 0, NT_LAT}; run_gemm(lds, ha, wt_eout, NT_ALL, DM, DM, E); }
    grid.sync();
    normmod_phase(out, ctxr, 0, NT_LAT, NT_ALL, normg + 1024, mods0, 3, ha);
    grid.sync();
    {   pg8::EpiSwiglu E{big, FF}; run_gemm(lds, ha, wt_fin, NT_ALL, 2 * FF, DM, E); }
    grid.sync();
    {   pg8::EpiResid E{out, out, ctxr, ctxr, mods0 + 5 * 1024, 0, NT_LAT}; run_gemm(lds, big, wt_fout, NT_ALL, DM, FF, E); }
    grid.sync();

    for (int hb = 0; hb < 2; ++hb) {
        const int b0 = 4 * hb;
        normmod_phase(out, ctxr, b0, 32768, 33792, normg + 2048, mods1, 0, ha);
        grid.sync();
        {   pg8::EpiStoreBf16 E{big, OIN}; run_gemm(lds, ha, wt_oin, 33792, OIN, DM, E); }
        grid.sync();
        ret_scan_phase(big, ofw, obw, rtt, rtt + 8192 * 128, lds);
        grid.sync();
        ret_norm_phase(big, ofw, obw);
        grid.sync();
        {   pg8::EpiResid E{out, out, ctxr, ctxr, mods1 + 2 * 1024, b0, 32768}; run_gemm(lds, ofw, wt_oout, 32768, DM, 2048, E); }
        grid.sync();
        normmod_phase(out, ctxr, b0, 32768, 32768, normg + 3072, mods1, 3, ha);
        grid.sync();
        {   pg8::EpiSwiglu E{big, FF}; run_gemm(lds, ha, wt_fin + (size_t)2 * FF * DM, 32768, 2 * FF, DM, E); }
        grid.sync();
        {   pg8::EpiResid E{out, out, ctxr, ctxr, mods1 + 5 * 1024, b0, 32768}; run_gemm(lds, big, wt_fout + (size_t)DM * FF, 32768, DM, FF, E); }
        grid.sync();
    }
}

extern "C" void kernel_launch(void* const* d_in, const int* in_sizes, int n_in, void* d_out, int out_size, void* d_ws, size_t ws_size, hipStream_t stream) {
    static int grid = 0;
    if (grid == 0) {
        if (n_in != 17 || ws_size < WS_END) { fprintf(stderr, "kernel_launch: need 17 inputs and >= %zu bytes of workspace (got %d, %zu)\n", (size_t)WS_END, n_in, ws_size); grid = -1; return; }
        int dev = 0, cus = 0, per_cu = 0;
        hipGetDevice(&dev); hipDeviceGetAttribute(&cus, hipDeviceAttributeMultiprocessorCount, dev);
        if (hipFuncSetAttribute((const void*)fwd_megakernel, hipFuncAttributeMaxDynamicSharedMemorySize, LDS_BYTES) != hipSuccess) { fprintf(stderr, "kernel_launch: hipFuncSetAttribute failed\n"); grid = -1; return; }
        if (hipOccupancyMaxActiveBlocksPerMultiprocessor(&per_cu, (const void*)fwd_megakernel, NTHREADS, LDS_BYTES) != hipSuccess || per_cu < 1) { fprintf(stderr, "kernel_launch: occupancy query says %d\n", per_cu); per_cu = 1; }
        (void)hipGetLastError();
        grid = cus * 1;
    }
    if (grid < 0) return;
    Args a{};
    for (int i = 0; i < 17; ++i) a.in[i] = (const float*)d_in[i];
    a.out = (float*)d_out; a.ws = (unsigned char*)d_ws;
    void* args[] = {&a};
    hipError_t e = hipLaunchCooperativeKernel((const void*)fwd_megakernel, dim3(grid), dim3(NTHREADS), args, LDS_BYTES, stream);
    if (e != hipSuccess) fprintf(stderr, "cooperative launch failed: %s (grid %d)\n", hipGetErrorString(e), grid);
}
```

```cpp
#include <hip/hip_runtime.h>
#include <hip/hip_cooperative_groups.h>
#include <cstdio>
namespace cg = cooperative_groups;

#define DI __device__ __forceinline__
#define LAS __attribute__((address_space(3)))
namespace pg8 {
#define PG8_LAS __attribute__((address_space(3)))
typedef unsigned short bf16_t;
typedef short bf16x8 __attribute__((ext_vector_type(8)));
typedef float f32x4 __attribute__((ext_vector_type(4)));
typedef unsigned u32x4 __attribute__((ext_vector_type(4)));
constexpr int BM = 256, BK = 64, HALF = 128, HTB = HALF * BK * 2  , STAGE_BYTES = 8 * HTB, NXCD = 8, WGM = 4;

__host__ __device__ __forceinline__ int lds_byte(int r, int c) { const int st = (r >> 4) * 2 + (c >> 5), rr = r & 15, cc = c & 31, ob = rr * 64 + cc * 2; return st * 1024 + (ob ^ (((ob >> 9) & 1) << 5)); }
__host__ __device__ __forceinline__ void stage_rc(int b, int& R, int& C) { const int st = b / 1024, sb = b % 1024, swz = sb ^ (((sb >> 9) & 1) << 5); R = (st >> 1) * 16 + swz / 64; C = (st & 1) * 32 + (swz % 64) / 2; }
__host__ __device__ __forceinline__ int perm32(int rho) { const int n = rho >> 4, i = rho & 15; return 8 * (i >> 2) + 4 * n + (i & 3); }

struct Unit { int pm, pn; };
struct Gemm { const bf16_t* A; const bf16_t* Bt; int M, N, K; };

struct StaticOrder {
    int nM, nN, nwg, G, c;
    __host__ __device__ void init(int M, int N, int G_, int c_) { nM = M / BM; nN = N / BM; nwg = nM * nN; G = G_; c = c_; }
    __host__ __device__ bool next(int i, Unit& u) const {
        const long L = (long)i * G + c; if (L >= nwg) return false;
        int wgid = (int)L; { const int q = nwg / NXCD, r = nwg % NXCD, xcd = wgid % NXCD, off = wgid / NXCD; wgid = (xcd < r ? xcd * (q + 1) : r * (q + 1) + (xcd - r) * q) + off; }
        const int nig = WGM * nN, gid = wgid / nig, fm = gid * WGM, gsz = (nM - fm) < WGM ? (nM - fm) : WGM;
        u.pm = fm + ((wgid % nig) % gsz); u.pn = (wgid % nig) / gsz; return true;
    }
    __device__ __forceinline__ void a_ready(const Unit&) const {}
    __device__ __forceinline__ void done(const Unit&) const {}
};

typedef unsigned u32x2 __attribute__((ext_vector_type(2)));
__device__ __forceinline__ int pg8_opaque_tid(int wv) { unsigned z = 0u; asm volatile("" : "+v"(z)); return (wv << 6) | (int)__builtin_amdgcn_mbcnt_hi(~0u, __builtin_amdgcn_mbcnt_lo(~0u, z)); }
__device__ __forceinline__ unsigned cvt_pk_bf16(float lo, float hi) { unsigned r; asm volatile("v_cvt_pk_bf16_f32 %0, %1, %2" : "=v"(r) : "v"(lo), "v"(hi)); return r; }

struct EpiStoreBf16 {
    static constexpr bool PERM = true, AFTER_DRAIN = false;
    bf16_t* O; int ldc;
    __device__ __forceinline__ void operator()(const f32x4 (&acc)[2][2][4][2], const Unit& u, int wr, int wc, int fr, int fq) const {
        const int row0 = u.pm * BM + wr * 64 + fr; const int col0 = u.pn * BM + wc * 32 + 8 * fq;
#pragma unroll
        for (int ai = 0; ai < 2; ++ai)
#pragma unroll
            for (int m = 0; m < 4; ++m) { bf16_t* rowp = O + (size_t)(row0 + ai * HALF + m * 16) * ldc + col0;
#pragma unroll
                for (int bj = 0; bj < 2; ++bj) { const f32x4 v0 = acc[ai][bj][m][0], v1 = acc[ai][bj][m][1];
                    u32x4 w; w.x = cvt_pk_bf16(v0[0], v0[1]); w.y = cvt_pk_bf16(v0[2], v0[3]); w.z = cvt_pk_bf16(v1[0], v1[1]); w.w = cvt_pk_bf16(v1[2], v1[3]);
                    *(u32x4*)(rowp + bj * HALF) = w; } }
    }
};
struct RowNorm { const float* rowss; const float* bias; int ldb, b0, nlat; };
struct EpiRopeStore {
    static constexpr bool PERM = true, AFTER_DRAIN = false;
    bf16_t* O; int ldc; const float* rtc; const float* rts; int nlat; RowNorm rn;
    __device__ __forceinline__ void operator()(const f32x4 (&acc)[2][2][4][2], const Unit& u, int wr, int wc, int fr, int fq) const {
        const int row0 = u.pm * BM + wr * 64 + fr; const int col0 = u.pn * BM + wc * 32 + 8 * fq;
        const bool rot = (u.pn < 8) && (u.pm * BM < nlat); const float ksc = (u.pn >= 4 && u.pn < 8) ? 0.0625f : 1.0f;
        const int mrow = (u.pm * BM < rn.nlat) ? rn.b0 + ((u.pm * BM) >> 13) : 8;
        const float* bp = rn.bias + (size_t)mrow * rn.ldb + col0;
        const f32x4 bv00 = *(const f32x4*)bp, bv01 = *(const f32x4*)(bp + 4), bv10 = *(const f32x4*)(bp + HALF), bv11 = *(const f32x4*)(bp + HALF + 4);
        float rinv[8];
#pragma unroll
        for (int ii = 0; ii < 8; ii += 2) { const f32x4 qa = *(const f32x4*)(rn.rowss + (size_t)(row0 + (ii >> 2) * HALF + (ii & 3) * 16) * 16 + 4 * fq), qb = *(const f32x4*)(rn.rowss + (size_t)(row0 + ((ii + 1) >> 2) * HALF + ((ii + 1) & 3) * 16) * 16 + 4 * fq);
            float sa = (qa[0] + qa[1]) + (qa[2] + qa[3]), sb = (qb[0] + qb[1]) + (qb[2] + qb[3]);
            sa += __shfl_xor(sa, 16); sb += __shfl_xor(sb, 16); sa += __shfl_xor(sa, 32); sb += __shfl_xor(sb, 32);
            rinv[ii] = rsqrtf(sa * (1.0f / 1024.0f) + 1e-6f); rinv[ii + 1] = rsqrtf(sb * (1.0f / 1024.0f) + 1e-6f); }
        f32x4 tc[4], tn[4];
#define PG8_LOADT(dst, idx) do { const size_t to_ = (size_t)((row0 + ((idx) >> 2) * HALF + ((idx) & 3) * 16) & 8191) * 128 + wc * 32 + 8 * fq; \
            dst[0] = *(const f32x4*)(rtc + to_); dst[1] = *(const f32x4*)(rtc + to_ + 4); dst[2] = *(const f32x4*)(rts + to_); dst[3] = *(const f32x4*)(rts + to_ + 4); } while (0)
        if (rot) PG8_LOADT(tc, 0);
#pragma unroll
        for (int idx = 0; idx < 8; ++idx) { const int ai = idx >> 2, m = idx & 3;
            const int row = row0 + ai * HALF + m * 16; bf16_t* rowp = O + (size_t)row * ldc + col0;
            if (rot && idx + 1 < 8) PG8_LOADT(tn, idx + 1);
            const float ri = rinv[idx];
            f32x4 a0 = acc[ai][0][m][0] * ri + bv00, a1 = acc[ai][0][m][1] * ri + bv01, b0 = acc[ai][1][m][0] * ri + bv10, b1 = acc[ai][1][m][1] * ri + bv11;
            if (rot) { const f32x4 x0 = a0 * tc[0] - b0 * tc[2], y0 = b0 * tc[0] + a0 * tc[2], x1 = a1 * tc[1] - b1 * tc[3], y1 = b1 * tc[1] + a1 * tc[3]; a0 = x0; b0 = y0; a1 = x1; b1 = y1; }
            a0 *= ksc; a1 *= ksc; b0 *= ksc; b1 *= ksc;
            u32x4 w; w.x = cvt_pk_bf16(a0[0], a0[1]); w.y = cvt_pk_bf16(a0[2], a0[3]); w.z = cvt_pk_bf16(a1[0], a1[1]); w.w = cvt_pk_bf16(a1[2], a1[3]);
            *(u32x4*)rowp = w;
            w.x = cvt_pk_bf16(b0[0], b0[1]); w.y = cvt_pk_bf16(b0[2], b0[3]); w.z = cvt_pk_bf16(b1[0], b1[1]); w.w = cvt_pk_bf16(b1[2], b1[3]);
            *(u32x4*)(rowp + HALF) = w;
#pragma unroll
            for (int q = 0; q < 4; ++q) tc[q] = tn[q];
        }
#undef PG8_LOADT
    }
};

struct EpiSwiglu {
    static constexpr bool PERM = true, AFTER_DRAIN = false;
    bf16_t* O; int ldc; RowNorm rn;
    __device__ __forceinline__ void operator()(const f32x4 (&acc)[2][2][4][2], const Unit& u, int wr, int wc, int fr, int fq) const {
        const int row0 = u.pm * BM + wr * 64 + fr; const int col0 = u.pn * HALF + wc * 32 + 8 * fq;
        const int mrow = (u.pm * BM < rn.nlat) ? rn.b0 + ((u.pm * BM) >> 13) : 8;
        const float* bp = rn.bias + (size_t)mrow * rn.ldb + u.pn * BM + wc * 32 + 8 * fq;
        f32x4 bv[2][2];
#pragma unroll
        for (int bj = 0; bj < 2; ++bj)
#pragma unroll
            for (int n = 0; n < 2; ++n) bv[bj][n] = *(const f32x4*)(bp + bj * HALF + 4 * n);
        float rinv[8];
#pragma unroll
        for (int ii = 0; ii < 8; ii += 2) { const f32x4 qa = *(const f32x4*)(rn.rowss + (size_t)(row0 + (ii >> 2) * HALF + (ii & 3) * 16) * 16 + 4 * fq), qb = *(const f32x4*)(rn.rowss + (size_t)(row0 + ((ii + 1) >> 2) * HALF + ((ii + 1) & 3) * 16) * 16 + 4 * fq);
            float sa = (qa[0] + qa[1]) + (qa[2] + qa[3]), sb = (qb[0] + qb[1]) + (qb[2] + qb[3]);
            sa += __shfl_xor(sa, 16); sb += __shfl_xor(sb, 16); sa += __shfl_xor(sa, 32); sb += __shfl_xor(sb, 32);
            rinv[ii] = rsqrtf(sa * (1.0f / 1024.0f) + 1e-6f); rinv[ii + 1] = rsqrtf(sb * (1.0f / 1024.0f) + 1e-6f); }
#pragma unroll
        for (int ai = 0; ai < 2; ++ai) {
#pragma unroll
            for (int m = 0; m < 4; ++m) { const int row = row0 + ai * HALF + m * 16; bf16_t* rowp = O + (size_t)row * ldc + col0;
                const float ri = rinv[4 * ai + m];
                float h[8];
#pragma unroll
                for (int n = 0; n < 2; ++n)
#pragma unroll
                    for (int j = 0; j < 4; ++j) { const float g = acc[ai][0][m][n][j] * ri + bv[0][n][j], up = acc[ai][1][m][n][j] * ri + bv[1][n][j]; h[4 * n + j] = g * __builtin_amdgcn_rcpf(1.0f + __builtin_amdgcn_exp2f(g * -1.4426950408889634f)) * up; }
                u32x4 w; w.x = cvt_pk_bf16(h[0], h[1]); w.y = cvt_pk_bf16(h[2], h[3]); w.z = cvt_pk_bf16(h[4], h[5]); w.w = cvt_pk_bf16(h[6], h[7]);
                *(u32x4*)rowp = w; } }
    }
};
template <bool EMIT> struct EpiResid {
    static constexpr bool PERM = false, AFTER_DRAIN = false;
    const float* resL; float* outL; const float* resC; float* outC; const float* gate; int b0, nlat;
    bf16_t* an; float* rss; const float* gsv; int remap;
    __device__ __forceinline__ void operator()(const f32x4 (&acc)[2][2][4][2], const Unit& u, int wr, int wc, int fr, int fq) const {
        const int lr0 = u.pm * BM; const bool is_ctx = lr0 >= nlat;
        const int col0 = u.pn * BM + wc * 32 + 4 * fq;
        size_t grow0; int mrow; const float* rp0; float* op0;
        if (!is_ctx) { grow0 = (size_t)b0 * 8192 + lr0; mrow = (int)(grow0 >> 13); rp0 = resL; op0 = outL; }
        else { grow0 = (size_t)b0 * 256 + (lr0 - nlat); mrow = 8; rp0 = resC; op0 = outC; }
        size_t nrow0 = (size_t)lr0;
        if (EMIT && remap) nrow0 = is_ctx ? (grow0 >> 10) * 33792 + 32768 + (grow0 & 1023) : (grow0 >> 15) * 33792 + (grow0 & 32767);
        const float* gp = gate + (size_t)mrow * 6144 + col0;
        f32x4 gv[2][2], sv[2][2];
#pragma unroll
        for (int bj = 0; bj < 2; ++bj)
#pragma unroll
            for (int n = 0; n < 2; ++n) { gv[bj][n] = *(const f32x4*)(gp + bj * HALF + n * 16); if (EMIT) sv[bj][n] = *(const f32x4*)(gsv + (size_t)mrow * 1024 + col0 + bj * HALF + n * 16); }
        f32x4 rcur[2][2], rnxt[2][2];
#define PG8_LOADR(dst, idx) do { const int rin_ = wr * 64 + fr + ((idx) >> 2) * HALF + ((idx) & 3) * 16; const size_t off_ = (grow0 + rin_) * 1024 + col0; \
            _Pragma("unroll") for (int bj = 0; bj < 2; ++bj) _Pragma("unroll") for (int n = 0; n < 2; ++n) dst[bj][n] = *(const f32x4*)(rp0 + off_ + bj * HALF + n * 16); } while (0)
        PG8_LOADR(rcur, 0);
#pragma unroll
        for (int idx = 0; idx < 8; ++idx) { const int ai = idx >> 2, m = idx & 3;
            const int rin = wr * 64 + fr + ai * HALF + m * 16; const size_t off = (grow0 + rin) * 1024 + col0; float ss = 0.f;
            if (idx + 1 < 8) PG8_LOADR(rnxt, idx + 1);
#pragma unroll
            for (int bj = 0; bj < 2; ++bj)
#pragma unroll
                for (int n = 0; n < 2; ++n) { const f32x4 o = rcur[bj][n] + gv[bj][n] * acc[ai][bj][m][n];
                    *(f32x4*)(op0 + off + bj * HALF + n * 16) = o;
                    if (EMIT) { ss += (o[0] * o[0] + o[1] * o[1]) + (o[2] * o[2] + o[3] * o[3]); const f32x4 y = o * sv[bj][n];
                        u32x2 w; w.x = cvt_pk_bf16(y[0], y[1]); w.y = cvt_pk_bf16(y[2], y[3]);
                        *(u32x2*)(an + (nrow0 + rin) * 1024 + col0 + bj * HALF + n * 16) = w; } }
            if (EMIT) { ss += __shfl_xor(ss, 16); ss += __shfl_xor(ss, 32);
                if (fq == 0) rss[(nrow0 + rin) * 16 + u.pn * 4 + wc] = ss; }
#pragma unroll
            for (int bj = 0; bj < 2; ++bj)
#pragma unroll
                for (int n = 0; n < 2; ++n) rcur[bj][n] = rnxt[bj][n];
        }
#undef PG8_LOADR
    }
};

template <class Epi, class Sched, bool STAMP = false>
__device__ __forceinline__ void gemm_phase(PG8_LAS unsigned char* lds, const Gemm g, const Sched& S, const Epi& E, unsigned long long* stamps, int wv) {
    const int tid = pg8_opaque_tid(wv), wid = __builtin_amdgcn_readfirstlane(tid >> 6), lane = tid & 63, wr = wid >> 2, wc = wid & 3, fr = lane & 15, fq = lane >> 4;
    const int K = g.K, nt = K / BK;
    int ts_lo = 0, ts_hi = 0, nts = 0; const unsigned long long rt_entry = STAMP ? (unsigned long long)wall_clock64() : 0ull;
#define PG8_STAMP() do { if (STAMP && wid == 0 && nts < 64) { const unsigned long long _c = (unsigned long long)clock64(); \
        ts_lo = (lane == nts) ? (int)(unsigned)_c : ts_lo; ts_hi = (lane == nts) ? (int)(unsigned)(_c >> 32) : ts_hi; ++nts; } } while (0)
    PG8_STAMP();
    unsigned voffA[2], voffB[2];
#pragma unroll
    for (int i = 0; i < 2; ++i) { int R, C; stage_rc(tid * 16 + i * 8192, R, C); const int Rb = Epi::PERM ? ((R & ~31) + perm32(R & 31)) : R;
        voffA[i] = (unsigned)(R * K + C) * 2u; voffB[i] = (unsigned)(Rb * K + C) * 2u; }
    const size_t kstep = (size_t)(BK * 2);
    const size_t hstep = (size_t)HALF * K * 2;
    const size_t tstep = 2 * hstep;
    const unsigned ldsw = (unsigned)wid * 1024u;
    const int aoff = lds_byte(wr * 64 + fr, fq * 8), boff = lds_byte(wc * 32 + fr, fq * 8);
#define PG8_SA(b, h) (((b) * 2 + (h)) * HTB)
#define PG8_SB(b, h) ((4 + (b) * 2 + (h)) * HTB)
#define PG8_STAGE(bufoff, gbase, voff) do { _Pragma("unroll") for (int _i = 0; _i < 2; ++_i) \
        __builtin_amdgcn_global_load_lds((const unsigned*)((const char*)(gbase) + (voff)[_i]), (PG8_LAS unsigned*)(lds + (bufoff) + ldsw + _i * 8192), 16, 0, 0); } while (0)
#define PG8_LDA(dst, b, h) do { _Pragma("unroll") for (int m = 0; m < 4; ++m) _Pragma("unroll") for (int k = 0; k < 2; ++k) dst[m][k] = *(const PG8_LAS bf16x8*)(lds + PG8_SA(b, h) + aoff + m * 2048 + k * 1024); } while (0)
#define PG8_LDB(dst, b, h) do { _Pragma("unroll") for (int n = 0; n < 2; ++n) _Pragma("unroll") for (int k = 0; k < 2; ++k) dst[n][k] = *(const PG8_LAS bf16x8*)(lds + PG8_SB(b, h) + boff + n * 2048 + k * 1024); } while (0)
#define PG8_MMA(ai, bj, At, Bt) do { __builtin_amdgcn_s_setprio(1); _Pragma("unroll") for (int m = 0; m < 4; ++m) _Pragma("unroll") for (int n = 0; n < 2; ++n) _Pragma("unroll") for (int k = 0; k < 2; ++k) \
        acc[ai][bj][m][n] = __builtin_amdgcn_mfma_f32_16x16x32_bf16(Bt[n][k], At[m][k], acc[ai][bj][m][n], 0, 0, 0); __builtin_amdgcn_s_setprio(0); } while (0)
#define PG8_WAIT_V(n) asm volatile("s_waitcnt vmcnt(" #n ")" ::: "memory")
#define PG8_WAIT_L(n) asm volatile("s_waitcnt lgkmcnt(" #n ")" ::: "memory")
#define PG8_BAR __builtin_amdgcn_s_barrier()
#define PG8_SCHED __builtin_amdgcn_sched_barrier(0)
    Unit cur, nxt; int ui = 0;
    if (!S.next(0, cur)) return;
    f32x4 acc[2][2][4][2];
#pragma unroll
    for (int a = 0; a < 2; ++a)
#pragma unroll
        for (int b = 0; b < 2; ++b)
#pragma unroll
            for (int m = 0; m < 4; ++m)
#pragma unroll
                for (int n = 0; n < 2; ++n) acc[a][b][m][n] = (f32x4){0.f, 0.f, 0.f, 0.f};
    bf16x8 At[4][2], B0[2][2], B1[2][2];
    const char* cA = (const char*)g.A + (size_t)cur.pm * tstep; const char* cB = (const char*)g.Bt + (size_t)cur.pn * tstep;
    S.a_ready(cur);
    PG8_STAGE(PG8_SB(0, 0), cB, voffB); PG8_STAGE(PG8_SA(0, 0), cA, voffA); PG8_STAGE(PG8_SB(0, 1), cB + hstep, voffB); PG8_STAGE(PG8_SA(0, 1), cA + hstep, voffA);
    if (wr == 1) PG8_BAR;
    PG8_WAIT_V(4); PG8_BAR;
    PG8_STAGE(PG8_SB(1, 0), cB + kstep, voffB); PG8_STAGE(PG8_SA(1, 0), cA + kstep, voffA); PG8_STAGE(PG8_SB(1, 1), cB + hstep + kstep, voffB);
    PG8_WAIT_V(6); PG8_BAR;
    PG8_STAMP();
    for (;;) {
        const bool has_next = S.next(ui + 1, nxt);
        const char* nA = has_next ? (const char*)g.A + (size_t)nxt.pm * tstep : cA; const char* nB = has_next ? (const char*)g.Bt + (size_t)nxt.pn * tstep : cB;
        for (int t = 0; t < nt; t += 2) {
            const bool last = (t == nt - 2);
            const char* a1 = cA + (size_t)(t + 1) * kstep;
            const char* a2 = last ? nA : cA + (size_t)(t + 2) * kstep; const char* b2 = last ? nB : cB + (size_t)(t + 2) * kstep;
            const char* a3 = a2 + kstep; const char* b3 = b2 + kstep;
            if (last && has_next) S.a_ready(nxt);
            PG8_LDB(B0, 0, 0); PG8_SCHED; PG8_LDA(At, 0, 0); PG8_STAGE(PG8_SA(1, 1), a1 + hstep, voffA);
            PG8_WAIT_L(8); PG8_BAR; PG8_WAIT_L(0); PG8_MMA(0, 0, At, B0); PG8_BAR; PG8_SCHED;
            PG8_LDB(B1, 0, 1); PG8_STAGE(PG8_SB(0, 0), b2, voffB);
            PG8_BAR; PG8_WAIT_L(0); PG8_MMA(0, 1, At, B1); PG8_BAR;
            PG8_LDA(At, 0, 1); PG8_STAGE(PG8_SA(0, 0), a2, voffA);
            PG8_BAR; PG8_WAIT_L(0); PG8_MMA(1, 0, At, B0); PG8_BAR; PG8_SCHED;
            PG8_STAGE(PG8_SB(0, 1), b2 + hstep, voffB);
            PG8_WAIT_V(6); PG8_BAR; PG8_MMA(1, 1, At, B1); PG8_BAR;
            PG8_LDB(B0, 1, 0); PG8_SCHED; PG8_LDA(At, 1, 0); PG8_STAGE(PG8_SA(0, 1), a2 + hstep, voffA);
            PG8_WAIT_L(8); PG8_BAR; PG8_WAIT_L(0); PG8_MMA(0, 0, At, B0); PG8_BAR; PG8_SCHED;
            PG8_LDB(B1, 1, 1); PG8_STAGE(PG8_SB(1, 0), b3, voffB);
            PG8_BAR; PG8_WAIT_L(0); PG8_MMA(0, 1, At, B1); PG8_BAR;
            PG8_LDA(At, 1, 1); PG8_STAGE(PG8_SA(1, 0), a3, voffA);
            PG8_BAR; PG8_WAIT_L(0); PG8_MMA(1, 0, At, B0); PG8_BAR; PG8_SCHED;
            PG8_STAGE(PG8_SB(1, 1), b3 + hstep, voffB);
            PG8_WAIT_V(6); PG8_BAR; PG8_MMA(1, 1, At, B1); PG8_BAR;
        }
        PG8_STAMP();
        if constexpr (!Epi::AFTER_DRAIN) { E(acc, cur, wr, wc, fr, fq); S.done(cur); }
        PG8_STAMP();
        if (!has_next) break;
#pragma unroll
        for (int a = 0; a < 2; ++a)
#pragma unroll
            for (int b = 0; b < 2; ++b)
#pragma unroll
                for (int m = 0; m < 4; ++m)
#pragma unroll
                    for (int n = 0; n < 2; ++n) acc[a][b][m][n] = (f32x4){0.f, 0.f, 0.f, 0.f};
        cur = nxt; cA = nA; cB = nB; ++ui;
    }
    PG8_WAIT_V(0);
    if (wr == 0) PG8_BAR;
    PG8_BAR;
    if constexpr (Epi::AFTER_DRAIN) { E.fused(acc, cur, wr, wc, fr, fq, lds, wid, lane); S.done(cur); }
    PG8_STAMP();
    if (STAMP && wid == 0) { stamps[lane] = lane < nts ? (((unsigned long long)(unsigned)ts_hi << 32) | (unsigned)ts_lo) : 0ull;
        if (lane == 62) stamps[62] = rt_entry; if (lane == 63) stamps[63] = (unsigned long long)wall_clock64(); }
#undef PG8_STAMP
#undef PG8_SA
#undef PG8_SB
#undef PG8_STAGE
#undef PG8_LDA
#undef PG8_LDB
#undef PG8_MMA
#undef PG8_WAIT_V
#undef PG8_WAIT_L
#undef PG8_BAR
#undef PG8_SCHED
}
}

using pg8::bf16_t; using pg8::bf16x8; using pg8::f32x4; using pg8::u32x4;
typedef unsigned u32x2 __attribute__((ext_vector_type(2)));
typedef float f32x2 __attribute__((ext_vector_type(2)));

constexpr int NT_LAT = 65536, NT_CTX = 2048, NT_ALL = NT_LAT + NT_CTX, DM = 1024, FF = 2816, EIN = 3328, OIN = 6144;
constexpr int NTHREADS = 512, NWAVES = 8;
constexpr int LDS_BYTES = 157696;
constexpr float EPS = 1e-6f;
constexpr int C_AQ = 0, C_AK = 512, C_AV = 640, C_BQ = 768, C_BFF = 1280, C_BFB = 1792, C_BI = 2304, C_BG = 2816;
constexpr int C_RQ = 0, C_RK = 1024, C_RV = 2048, C_RG = 4096;

constexpr size_t al256(size_t x) { return (x + 255) & ~(size_t)255; }
constexpr size_t WS_WT_EIN = 0;
constexpr size_t WS_WT_EOUT = WS_WT_EIN + al256((size_t)EIN * DM * 2);
constexpr size_t WS_WT_OIN = WS_WT_EOUT + al256((size_t)DM * DM * 2);
constexpr size_t WS_WT_OOUT = WS_WT_OIN + al256((size_t)OIN * DM * 2);
constexpr size_t WS_WT_FIN = WS_WT_OOUT + al256((size_t)DM * 2048 * 2);
constexpr size_t WS_WT_FOUT = WS_WT_FIN + al256((size_t)2 * 2 * FF * DM * 2);
constexpr size_t WS_MODS = WS_WT_FOUT + al256((size_t)2 * DM * FF * 2);
constexpr size_t WS_ROPE_AX = WS_MODS + al256((size_t)2 * 9 * 6144 * 4);
constexpr size_t WS_ROPE_RT = WS_ROPE_AX + al256((size_t)8192 * 32 * 2 * 4);
constexpr size_t WS_LB = WS_ROPE_RT + al256((size_t)8192 * 128 * 2 * 4);
constexpr size_t WS_CTXR = WS_LB + al256(512 * 4);
constexpr size_t WS_GS = WS_CTXR + al256((size_t)NT_CTX * DM * 4);
constexpr size_t WS_BIAS3 = WS_GS + al256((size_t)3 * 9 * 1024 * 4);
constexpr size_t WS_BIAS5 = WS_BIAS3 + al256((size_t)9 * 5632 * 4);
constexpr size_t WS_BIAS7 = WS_BIAS5 + al256((size_t)9 * 6144 * 4);
constexpr size_t WS_RSS_A = WS_BIAS7 + al256((size_t)9 * 5632 * 4);
constexpr size_t WS_RSS_B = WS_RSS_A + al256((size_t)NT_ALL * 64);
constexpr size_t WS_RSS_C = WS_RSS_B + al256((size_t)NT_ALL * 64);
constexpr size_t WS_BAR = WS_RSS_C + al256((size_t)NT_LAT * 64);
constexpr size_t WS_HA = WS_BAR + al256((size_t)4096 * 4);
constexpr size_t WS_OB = WS_HA + al256((size_t)NT_ALL * DM * 2);
constexpr size_t WS_BIG = WS_OB + al256((size_t)NT_ALL * 512 * 2);
constexpr size_t BIG_P1_BYTES = (size_t)33792 * OIN * 2;
constexpr size_t BIG_O_BYTES = (size_t)32768 * 2048 * 2;
constexpr size_t WS_OFW = WS_BIG + BIG_P1_BYTES;
constexpr size_t WS_OBW = WS_OFW + BIG_O_BYTES;
constexpr size_t WS_END1 = WS_OBW + BIG_O_BYTES;
constexpr size_t WS_END0 = WS_BIG + (size_t)NT_ALL * EIN * 2 + (size_t)8448 * (2 * 8192 * 2 + 128 * 4);
constexpr size_t WS_END = WS_END1 > WS_END0 ? WS_END1 : WS_END0;

DI float bf2f(unsigned short b) { return __uint_as_float(((unsigned)b) << 16); }
typedef __bf16 bfx2_t __attribute__((ext_vector_type(2)));
typedef short s16x4 __attribute__((ext_vector_type(4)));
DI unsigned short f2bf(float f) { const __bf16 h = (__bf16)f; return __builtin_bit_cast(unsigned short, h); }
DI unsigned pk2(float lo, float hi) { const f32x2 p = {lo, hi}; const bfx2_t q = __builtin_convertvector(p, bfx2_t); return __builtin_bit_cast(unsigned, q); }
DI bf16x8 tr_frag(const LAS bf16_t* X, int pitch, int t0, int c0, int lane) {
    const int i = lane & 15, g = lane >> 4;
    const LAS bf16_t* p = X + (t0 + 8 * g + (i >> 2)) * pitch + c0 + 4 * (i & 3);
    const s16x4 lo = __builtin_amdgcn_ds_read_tr16_b64_v4i16((LAS s16x4*)p);
    const s16x4 hi = __builtin_amdgcn_ds_read_tr16_b64_v4i16((LAS s16x4*)(p + 4 * pitch));
    return __builtin_shufflevector(lo, hi, 0, 1, 2, 3, 4, 5, 6, 7);
}
DI void unpack8(const bf16x8 v, float* f) {
#pragma unroll
    for (int i = 0; i < 8; ++i) f[i] = bf2f((unsigned short)v[i]);
}
DI bf16x8 pack8(const float* f) { u32x4 p; p.x = pk2(f[0], f[1]); p.y = pk2(f[2], f[3]); p.z = pk2(f[4], f[5]); p.w = pk2(f[6], f[7]); return __builtin_bit_cast(bf16x8, p); }
DI float wave_sum(float v) {
#pragma unroll
    for (int o = 1; o < 64; o <<= 1) v += __shfl_xor(v, o);
    return v;
}
DI float fexp(float x) { return __builtin_amdgcn_exp2f(x * 1.4426950408889634f); }
DI float flog(float x) { return __builtin_amdgcn_logf(x) * 0.6931471805599453f; }
DI float sigmf(float x) { return __builtin_amdgcn_rcpf(1.0f + fexp(-x)); }
DI float siluf(float x) { return x * sigmf(x); }
#define LDS_WAIT() asm volatile("s_waitcnt lgkmcnt(0)" ::: "memory")
#define MFMA16(a, b, c) __builtin_amdgcn_mfma_f32_16x16x32_bf16((a), (b), (c), 0, 0, 0)

#define XB_TMO      128
#define XB_XCNT(j)  (256  + 64 * (j))
#define XB_XSUB(j)  (1280 + 64 * (j))
#define XB_XGEN(j)  (2304 + 64 * (j))
#define XB_TOP      3328
#define XB_TOPGEN   3392
#define XCD_BAR_WORDS 3456
#define XB_SPIN_CAP (1u << 18)

__device__ __forceinline__ unsigned xb_ld(unsigned* p)              { return __hip_atomic_load(p, __ATOMIC_RELAXED, __HIP_MEMORY_SCOPE_AGENT); }
__device__ __forceinline__ unsigned xb_add(unsigned* p, unsigned v) { return __hip_atomic_fetch_add(p, v, __ATOMIC_RELAXED, __HIP_MEMORY_SCOPE_AGENT); }
__device__ __forceinline__ unsigned xb_xcc_id() { return (unsigned)__builtin_amdgcn_s_getreg((3 << 11) | 20) & 0xFu; }
#define XB_SPIN(cond, bar) do { unsigned _sp = 0; while (cond) { __builtin_amdgcn_s_sleep(1); \
    if ((++_sp & 255u) == 0u) { if (xb_ld(&(bar)[XB_TMO])) break; if (_sp > XB_SPIN_CAP) { atomicAdd(&(bar)[XB_TMO], 1u); break; } } } } while (0)

struct XcdBarrier {
    unsigned* bar; unsigned x; int wv;
    volatile LAS unsigned* st;
};

__device__ __forceinline__ XcdBarrier xcd_barrier_post(unsigned* bar, volatile LAS unsigned* st) {
    XcdBarrier b; b.bar = bar; b.x = xb_xcc_id(); b.st = st;
    if (threadIdx.x == 0) (void)xb_add(&bar[XB_XCNT(b.x)], 1u);
    return b;
}
__device__ __forceinline__ void xcd_barrier_complete(unsigned* bar, unsigned x, unsigned& nloc, unsigned& nx) {
    const unsigned G = gridDim.x * gridDim.y * gridDim.z;
    unsigned sum, cnt, mine, sp = 0u;
    for (;;) {
        sum = 0u; cnt = 0u; mine = 0u;
#pragma unroll
        for (unsigned j = 0; j < 16; ++j) { const unsigned c = xb_ld(&bar[XB_XCNT(j)]); sum += c; cnt += (c > 0u) ? 1u : 0u; mine = (j == x) ? c : mine; }
        if (sum == G) break;
        __builtin_amdgcn_s_sleep(1);
        if ((++sp & 255u) == 0u) { if (xb_ld(&bar[XB_TMO])) break; if (sp > XB_SPIN_CAP) { atomicAdd(&bar[XB_TMO], 1u); break; } }
    }
    nloc = mine > 0u ? mine : 1u; nx = cnt > 0u ? cnt : 1u;
}

__device__ __forceinline__ void xcd_barrier(const XcdBarrier& b) {
    asm volatile("s_waitcnt vmcnt(0)" ::: "memory");
    __syncthreads();
    if (b.wv == 0 && __builtin_amdgcn_mbcnt_hi(~0u, __builtin_amdgcn_mbcnt_lo(~0u, 0u)) == 0u) {
        unsigned* bar = b.bar;
        __builtin_amdgcn_s_waitcnt(0);
        unsigned nloc = b.st[0], nx = b.st[1];
        if (nloc == 0u) { xcd_barrier_complete(bar, b.x, nloc, nx); b.st[0] = nloc; b.st[1] = nx; }
        const unsigned old = xb_add(&bar[XB_XSUB(b.x)], 1u);
        const unsigned gen = old / nloc;
        if (old + 1u == (gen + 1u) * nloc) {
            __builtin_amdgcn_fence(__ATOMIC_RELEASE, "agent");
            asm volatile("s_waitcnt vmcnt(0)" ::: "memory");
            const unsigned og = xb_add(&bar[XB_TOP], 1u);
            const unsigned tg = og / nx;
            if (og + 1u == (tg + 1u) * nx) xb_add(&bar[XB_TOPGEN], 1u);
            else XB_SPIN(xb_ld(&bar[XB_TOPGEN]) == tg, bar);
            __builtin_amdgcn_fence(__ATOMIC_ACQUIRE, "agent");
            xb_add(&bar[XB_XGEN(b.x)], 1u);
            asm volatile("s_waitcnt vmcnt(0)" ::: "memory");
        } else {
            XB_SPIN(xb_ld(&bar[XB_XGEN(b.x)]) == gen, bar);
            __builtin_amdgcn_fence(__ATOMIC_ACQUIRE, "agent");
            asm volatile("s_waitcnt vmcnt(0)" ::: "memory");
        }
    }
    __syncthreads();
}

struct Args { const float* in[17]; float* out; unsigned char* ws; };

DI void transpose_item(const float* W, int K, int N, bf16_t* WT, int k0, int n0, int drow0, LAS float* scr, int lane) {
#pragma unroll 8
    for (int i = 0; i < 32; ++i) { const int kk = 2 * i + (lane >> 5); scr[kk * 33 + (lane & 31)] = W[(size_t)(k0 + kk) * N + n0 + (lane & 31)]; }
    LDS_WAIT();
    const int c = lane & 7;
#pragma unroll
    for (int j = 0; j < 4; ++j) { const int n = (lane >> 3) + 8 * j; const LAS float* s = scr + (8 * c) * 33 + n;
        u32x4 o; o.x = pk2(s[0 * 33], s[1 * 33]); o.y = pk2(s[2 * 33], s[3 * 33]); o.z = pk2(s[4 * 33], s[5 * 33]); o.w = pk2(s[6 * 33], s[7 * 33]);
        *(u32x4*)(WT + (size_t)(drow0 + n) * K + k0 + 8 * c) = o; }
    LDS_WAIT();
}
DI void transpose_matrix(const float* W, int K, int N, bf16_t* WT, bool ffn_in, int& it0, int gw, int ngw, LAS float* scr, int lane) {
    const int nblk = N / 32, nitems = (K / 64) * nblk;
    int first = (gw - it0 % ngw + ngw) % ngw;
    for (int it = first; it < nitems; it += ngw) {
        const int kb = it / nblk, nb = it % nblk, n0 = nb * 32;
        int drow0 = n0;
        if (ffn_in) { const int s = n0 / FF, j = n0 % FF, p = j / 128, jj = j % 128; drow0 = 256 * p + 128 * s + jj; }
        transpose_item(W, K, N, WT, kb * 64, n0, drow0, scr, lane);
    }
    it0 += nitems;
}

DI void mods_phase(int wv, const Args& a, float* mods, LAS unsigned char* lds) {
    const int tid = pg8::pg8_opaque_tid(wv);
    LAS float* sc = (LAS float*)lds;
    LAS float* red = (LAS float*)(lds + 9 * 1024 * 4);
    if ((int)blockIdx.x >= 192) return;
    for (int i = tid; i < 9 * 1024; i += NTHREADS) { const int r = i >> 10, k = i & 1023; const float v = r < 8 ? a.in[1][r * 1024 + k] : a.in[3][k]; sc[i] = siluf(v); }
    __syncthreads();
    for (int it = blockIdx.x; it < 192; it += gridDim.x) {
        const int l = it / 96, n0 = (it % 96) * 64, nl = tid & 63, kp = tid >> 6;
        const float* w = a.in[4] + (size_t)l * 1024 * 6144 + n0 + nl;
        float acc[9];
#pragma unroll
        for (int r = 0; r < 9; ++r) acc[r] = 0.f;
        for (int k = kp * 128; k < kp * 128 + 128; ++k) { const float wv = w[(size_t)k * 6144];
#pragma unroll
            for (int r = 0; r < 9; ++r) acc[r] += sc[r * 1024 + k] * wv; }
#pragma unroll
        for (int r = 0; r < 9; ++r) red[(kp * 9 + r) * 64 + nl] = acc[r];
        __syncthreads();
        for (int i = tid; i < 576; i += NTHREADS) { const int r = i >> 6, n = i & 63; float s = 0.f;
#pragma unroll
            for (int p = 0; p < 8; ++p) s += red[(p * 9 + r) * 64 + n];
            mods[(size_t)(l * 9 + r) * 6144 + n0 + n] = s + a.in[5][l * 6144 + n0 + n]; }
        __syncthreads();
    }
}

DI void tables_phase(int wv, const Args& a, float* ax, float* rt, float* lb, float* rss, int nrss) {
    const int gt = blockIdx.x * NTHREADS + pg8::pg8_opaque_tid(wv), ngt = gridDim.x * NTHREADS;

    for (int i = gt; i < 8192 * 32; i += ngt) { const int t = i >> 5, j = i & 31; const double p = (j < 16) ? (double)(t >> 6) : (double)(t & 63);
        const double inv = pow(10000.0, -(double)(j & 15) / 16.0); const double ang = p * inv;
        ax[i] = (float)cos(ang); ax[8192 * 32 + i] = (float)sin(ang); }
    for (int i = gt; i < 8192 * 128; i += ngt) { const int t = i >> 7, j = i & 127; const double th = pow(10000.0, -(double)j / 127.0); const double ang = (double)t * th;
        rt[i] = (float)cos(ang); rt[8192 * 128 + i] = (float)sin(ang); }
    for (int i = gt; i < 512; i += ngt) { const float a0 = a.in[14][i], a1 = a.in[14][512 + i]; lb[i] = 1.0f / (1.0f + expf(a1 - a0)); }
}


DI void aux_phase(int wv, const float* normg, const float* mods, const bf16_t* wt_fin, const bf16_t* wt_oin, float* gs, float* bias3, float* bias5, float* bias7) {
    const int tid = pg8::pg8_opaque_tid(wv), lane = tid & 63, wave = __builtin_amdgcn_readfirstlane(tid >> 6);
    const int gt = blockIdx.x * NTHREADS + tid, ngt = gridDim.x * NTHREADS;
    for (int i = gt; i < 3 * 9 * 1024; i += ngt) { const int tb = i / 9216, r = (i / 1024) % 9, c = i & 1023;
        const float g = normg[(tb == 0 ? 1024 : (tb == 1 ? 2048 : 3072)) + c];
        const float sc = mods[(size_t)((tb == 0 ? 0 : 9) + r) * 6144 + (tb == 1 ? 1 : 4) * 1024 + c];
        gs[i] = g * (1.0f + sc); }
    const int gw = blockIdx.x * NWAVES + wave, ngw = gridDim.x * NWAVES;
    for (int it = gw; it < 5632 + 6144 + 5632; it += ngw) {
        const bf16_t* wrow; const float* sh; float* dst; int ldb, n;
        if (it < 5632) { n = it; wrow = wt_fin + (size_t)n * 1024; sh = mods + 3 * 1024; dst = bias3; ldb = 5632; }
        else if (it < 5632 + 6144) { n = it - 5632; wrow = wt_oin + (size_t)n * 1024; sh = mods + 9 * 6144; dst = bias5; ldb = 6144; }
        else { n = it - 5632 - 6144; wrow = wt_fin + (size_t)2 * FF * DM + (size_t)n * 1024; sh = mods + 9 * 6144 + 3 * 1024; dst = bias7; ldb = 5632; }
        float w[16]; unpack8(*(const bf16x8*)(wrow + 16 * lane), w); unpack8(*(const bf16x8*)(wrow + 16 * lane + 8), w + 8);
        float keep = 0.f;
#pragma unroll
        for (int r = 0; r < 9; ++r) { const float* sp = sh + (size_t)r * 6144 + 16 * lane; float s = 0.f;
#pragma unroll
            for (int q = 0; q < 4; ++q) { const f32x4 v = *(const f32x4*)(sp + 4 * q); s += (v.x * w[4 * q] + v.y * w[4 * q + 1]) + (v.z * w[4 * q + 2] + v.w * w[4 * q + 3]); }
            s = wave_sum(s); if (lane == r) keep = s; }
        if (lane < 9) dst[(size_t)lane * ldb + n] = keep;
    }
}

DI void normmod_phase(int wv, const float* xlat, const float* xctx, int b0, int nlat, int nrows, const float* g, const float* mods, int sidx, bf16_t* out) {
    const int tid = pg8::pg8_opaque_tid(wv), lane = tid & 63, wave = __builtin_amdgcn_readfirstlane(tid >> 6);
    const int gw = blockIdx.x * NWAVES + wave, ngw = gridDim.x * NWAVES;
    f32x4 gv[4];
#pragma unroll
    for (int j = 0; j < 4; ++j) gv[j] = *(const f32x4*)(g + 4 * lane + 256 * j);
    for (int lr0 = gw * 2; lr0 < nrows; lr0 += ngw * 2) {
        f32x4 v[2][4]; int mrow[2];
#pragma unroll
        for (int u = 0; u < 2; ++u) { const int lr = lr0 + u; const float* src;
            if (lr < nlat) { const size_t grow = (size_t)b0 * 8192 + lr; src = xlat + grow * 1024; mrow[u] = (int)(grow >> 13); }
            else { const size_t crow = (size_t)b0 * 256 + (lr - nlat); src = xctx + crow * 1024; mrow[u] = 8; }
#pragma unroll
            for (int j = 0; j < 4; ++j) v[u][j] = *(const f32x4*)(src + 4 * lane + 256 * j); }
#pragma unroll
        for (int u = 0; u < 2; ++u) { const int lr = lr0 + u; float ss = 0.f;
#pragma unroll
            for (int j = 0; j < 4; ++j) ss += (v[u][j].x * v[u][j].x + v[u][j].y * v[u][j].y) + (v[u][j].z * v[u][j].z + v[u][j].w * v[u][j].w);
            const float r = rsqrtf(wave_sum(ss) * (1.0f / 1024.0f) + EPS);
            const float* sh = mods + (size_t)mrow[u] * 6144 + sidx * 1024; const float* scl = sh + 1024;
#pragma unroll
            for (int j = 0; j < 4; ++j) { const f32x4 s4 = *(const f32x4*)(sh + 4 * lane + 256 * j), c4 = *(const f32x4*)(scl + 4 * lane + 256 * j);
                const f32x4 y = v[u][j] * r * gv[j] * (c4 + 1.0f) + s4;
                u32x2 w; w.x = pk2(y.x, y.y); w.y = pk2(y.z, y.w);
                *(u32x2*)(out + (size_t)lr * 1024 + 4 * lane + 256 * j) = w; } }
    }
}

DI void attn_phase(int wv, const bf16_t* P, bf16_t* mix, const float* qkg, const float* sink, const float* axc, const float* axs, LAS unsigned char* lds) {
    const int tid = pg8::pg8_opaque_tid(wv), lane = tid & 63, wave = __builtin_amdgcn_readfirstlane(tid >> 6);
    const int fr = lane & 15, fq = lane >> 4, g = wave & 3, half = wave >> 2;
    LAS bf16_t* Ks = (LAS bf16_t*)lds; LAS bf16_t* Vl = (LAS bf16_t*)(lds + 46080); LAS bf16_t* Pw = (LAS bf16_t*)(lds + 92160 + wave * 4608);
    for (int it = blockIdx.x; it < 2112; it += gridDim.x) {
        const int qt = it % 132; const int r = it / 132; const int kvh = r & 1, b = r >> 1; const int hq = kvh * 4 + g;
        const bool cq = qt >= 128;
        const int q0 = cq ? (qt - 128) * 64 : qt * 64;
        const size_t qrow0 = cq ? (size_t)NT_LAT + b * 256 + q0 : (size_t)b * 8192 + q0;
        bf16x8 aq[2][2];
#pragma unroll
        for (int mi = 0; mi < 2; ++mi) {
            const int rloc = 32 * half + 16 * mi + fr; const bf16_t* qp = P + (qrow0 + rloc) * EIN + C_AQ + hq * 64;
            float x1[8], x2[8]; unpack8(*(const bf16x8*)(qp + 8 * fq), x1); unpack8(*(const bf16x8*)(qp + 32 + 8 * fq), x2);
            float ss = 0.f;
#pragma unroll
            for (int i = 0; i < 8; ++i) ss += x1[i] * x1[i] + x2[i] * x2[i];
            ss += __shfl_xor(ss, 16); ss += __shfl_xor(ss, 32);
            const float rn = rsqrtf(ss * (1.0f / 64.0f) + EPS);
#pragma unroll
            for (int i = 0; i < 8; ++i) { x1[i] *= rn * qkg[8 * fq + i]; x2[i] *= rn * qkg[32 + 8 * fq + i]; }
            if (!cq) { const int pos = q0 + rloc; const float* cp = axc + pos * 32 + 8 * fq; const float* sp = axs + pos * 32 + 8 * fq;
#pragma unroll
                for (int i = 0; i < 8; ++i) { const float c = cp[i], s = sp[i]; const float o1 = x1[i] * c - x2[i] * s, o2 = x2[i] * c + x1[i] * s; x1[i] = o1; x2[i] = o2; } }
            aq[mi][0] = pack8(x1); aq[mi][1] = pack8(x2); }
        float m_[2], l_[2]; f32x4 oacc[2][4];
        const float sk = sink[hq] * 1.4426950408889634f;
#pragma unroll
        for (int mi = 0; mi < 2; ++mi) { m_[mi] = sk; l_[mi] = 1.0f;
#pragma unroll
            for (int i = 0; i < 4; ++i) oacc[mi][i] = (f32x4){0.f, 0.f, 0.f, 0.f}; }
        for (int round = cq ? 1 : 0; round < 2; ++round) {
            const bool kc = round == 1;
            int kstart, nkeys; size_t krow0;
            if (!kc) { kstart = q0 - 128 < 0 ? 0 : q0 - 128; const int kend = q0 + 192 > 8192 ? 8192 : q0 + 192; nkeys = kend - kstart; krow0 = (size_t)b * 8192 + kstart; }
            else { kstart = 0; nkeys = 256; krow0 = (size_t)NT_LAT + b * 256; }
            __syncthreads();
            for (int task = tid; task < nkeys * 4; task += NTHREADS) {
                const int key = task >> 2, c = task & 3; const bf16_t* kp = P + (krow0 + key) * EIN + C_AK + kvh * 64;
                float x1[8], x2[8]; unpack8(*(const bf16x8*)(kp + 8 * c), x1); unpack8(*(const bf16x8*)(kp + 32 + 8 * c), x2);
                float ss = 0.f;
#pragma unroll
                for (int i = 0; i < 8; ++i) ss += x1[i] * x1[i] + x2[i] * x2[i];
                ss += __shfl_xor(ss, 1); ss += __shfl_xor(ss, 2);
                const float rn = rsqrtf(ss * (1.0f / 64.0f) + EPS);
#pragma unroll
                for (int i = 0; i < 8; ++i) { x1[i] *= rn * qkg[64 + 8 * c + i]; x2[i] *= rn * qkg[64 + 32 + 8 * c + i]; }
                if (!kc) { const int pos = kstart + key; const float* cp = axc + pos * 32 + 8 * c; const float* sp = axs + pos * 32 + 8 * c;
#pragma unroll
                    for (int i = 0; i < 8; ++i) { const float cs = cp[i], sn = sp[i]; const float o1 = x1[i] * cs - x2[i] * sn, o2 = x2[i] * cs + x1[i] * sn; x1[i] = o1; x2[i] = o2; } }
                *(LAS bf16x8*)(Ks + key * 72 + 8 * c) = pack8(x1); *(LAS bf16x8*)(Ks + key * 72 + 32 + 8 * c) = pack8(x2);
            }
            for (int task = tid; task < nkeys * 8; task += NTHREADS) { const int key = task >> 3, c = task & 7;
                *(LAS bf16x8*)(Vl + key * 72 + 8 * c) = *(const bf16x8*)(P + (krow0 + key) * EIN + C_AV + kvh * 64 + 8 * c); }
            __syncthreads();
            for (int kb = 0; kb < (nkeys >> 6); ++kb) {
                const int kpos0 = kstart + 64 * kb;
                if (!kc) { const int rlo = q0 + 32 * half; if (kpos0 + 64 <= rlo - 128 || kpos0 > rlo + 31 + 128) continue; }
                f32x4 sacc[2][4];
#pragma unroll
                for (int n = 0; n < 4; ++n) { sacc[0][n] = (f32x4){0.f, 0.f, 0.f, 0.f}; sacc[1][n] = sacc[0][n];
#pragma unroll
                    for (int ks = 0; ks < 2; ++ks) { const bf16x8 bk = *(const LAS bf16x8*)(Ks + (64 * kb + 16 * n + fr) * 72 + ks * 32 + 8 * fq);
                        sacc[0][n] = MFMA16(bk, aq[0][ks], sacc[0][n]); sacc[1][n] = MFMA16(bk, aq[1][ks], sacc[1][n]); } }
                bf16x8 pf[2][2];
#pragma unroll
                for (int mi = 0; mi < 2; ++mi) {
                    const int qpos = q0 + 32 * half + 16 * mi + fr;
                    float mx = -INFINITY;
#pragma unroll
                    for (int n = 0; n < 4; ++n)
#pragma unroll
                        for (int i = 0; i < 4; ++i) { float s = sacc[mi][n][i] * 0.18033688011112042f;
                            if (!kc) { const int dlt = (kpos0 + 16 * n + 4 * fq + i) - qpos; if (dlt > 128 || dlt < -128) s = -INFINITY; }
                            sacc[mi][n][i] = s; mx = fmaxf(mx, s); }
                    mx = fmaxf(mx, __shfl_xor(mx, 16)); mx = fmaxf(mx, __shfl_xor(mx, 32));
                    const float mn = fmaxf(m_[mi], mx); const float alpha = __builtin_amdgcn_exp2f(m_[mi] - mn); m_[mi] = mn; float rs = 0.f;
#pragma unroll
                    for (int n = 0; n < 4; ++n)
#pragma unroll
                        for (int i = 0; i < 4; ++i) { const float p = __builtin_amdgcn_exp2f(sacc[mi][n][i] - mn); sacc[mi][n][i] = p; rs += p; }
                    rs += __shfl_xor(rs, 16); rs += __shfl_xor(rs, 32);
                    l_[mi] = l_[mi] * alpha + rs;
#pragma unroll
                    for (int nd = 0; nd < 4; ++nd) oacc[mi][nd] *= alpha;
#pragma unroll
                    for (int k2 = 0; k2 < 2; ++k2) { u32x4 w; w.x = pk2(sacc[mi][2 * k2][0], sacc[mi][2 * k2][1]); w.y = pk2(sacc[mi][2 * k2][2], sacc[mi][2 * k2][3]);
                        w.z = pk2(sacc[mi][2 * k2 + 1][0], sacc[mi][2 * k2 + 1][1]); w.w = pk2(sacc[mi][2 * k2 + 1][2], sacc[mi][2 * k2 + 1][3]); pf[mi][k2] = __builtin_bit_cast(bf16x8, w); }
                }
#pragma unroll
                for (int k2 = 0; k2 < 2; ++k2)
#pragma unroll
                    for (int nd = 0; nd < 4; ++nd) {
                        const LAS bf16_t* vp = Vl + (64 * kb + 32 * k2 + 4 * fq + (fr >> 2)) * 72 + 16 * nd + 4 * (fr & 3);
                        const s16x4 lo = __builtin_amdgcn_ds_read_tr16_b64_v4i16((LAS s16x4*)vp), hi = __builtin_amdgcn_ds_read_tr16_b64_v4i16((LAS s16x4*)(vp + 16 * 72));
                        const bf16x8 vf = __builtin_shufflevector(lo, hi, 0, 1, 2, 3, 4, 5, 6, 7);
                        oacc[0][nd] = MFMA16(vf, pf[0][k2], oacc[0][nd]); oacc[1][nd] = MFMA16(vf, pf[1][k2], oacc[1][nd]); }
            }
        }
#pragma unroll
        for (int mi = 0; mi < 2; ++mi) { const float inv = 1.0f / l_[mi]; bf16_t* op = mix + (qrow0 + 32 * half + 16 * mi + fr) * 1024 + hq * 64 + 4 * fq;
#pragma unroll
            for (int nd = 0; nd < 4; ++nd) { const f32x4 r = oacc[mi][nd] * inv; u32x2 w; w.x = pk2(r[0], r[1]); w.y = pk2(r[2], r[3]); *(u32x2*)(op + 16 * nd) = w; } }
    }
}

#define HG_ROW0(n_) ((n_) < 4 ? (size_t)NT_LAT + b * 256 + (dir ? 3 - (n_) : (n_)) * 64 : (size_t)b * 8192 + (dir ? 127 - ((n_) - 4) : (n_) - 4) * 64)
constexpr int HP_QI = 0, HP_QO = 17408, HP_KI = 34816, HP_KP = 52224, HP_V = 69632, HP_PM = 87040, HP_RED = 96256;
DI void hgrn_prep_phase(int wv, const bf16_t* P, bf16_t* mix, bf16_t* ob, const float* lb, bf16_t* sq, bf16_t* sk, float* sd, LAS unsigned char* lds) {
    const int tid = pg8::pg8_opaque_tid(wv), lane = tid & 63, wave = __builtin_amdgcn_readfirstlane(tid >> 6);
    const int fr = lane & 15, fq = lane >> 4;
    LAS bf16_t* Qi = (LAS bf16_t*)(lds + HP_QI); LAS bf16_t* Qo = (LAS bf16_t*)(lds + HP_QO); LAS bf16_t* Ki = (LAS bf16_t*)(lds + HP_KI); LAS bf16_t* Kp = (LAS bf16_t*)(lds + HP_KP);
    LAS bf16_t* Vl = (LAS bf16_t*)(lds + HP_V); LAS bf16_t* Pm = (LAS bf16_t*)(lds + HP_PM); LAS float* red = (LAS float*)(lds + HP_RED);
    const int d = tid & 127, part = tid >> 7, vt = tid >> 3, vc = tid & 7;
    unsigned short fraw[16], qraw[16]; bf16x8 vr0, vr1;
#define HP_LOAD(it_) do { const int n_ = (it_) % 132; const int u_ = (it_) / 132; const int dir = u_ & 1, h = (u_ >> 1) & 3, b = u_ >> 3; const size_t r0_ = HG_ROW0(n_); \
        const int cf_ = (dir ? C_BFB : C_BFF) + h * 128 + d, cq_ = C_BQ + h * 128 + d; \
        _Pragma("unroll") for (int i = 0; i < 16; ++i) { const int t = 16 * part + i; const int tok = dir ? 63 - t : t; const bf16_t* rp = P + (r0_ + tok) * EIN; fraw[i] = rp[cf_]; qraw[i] = rp[cq_]; } \
        { const int tok = dir ? 63 - vt : vt; const bf16_t* vp = P + (r0_ + tok) * EIN + C_BI + h * 128 + 8 * vc; vr0 = *(const bf16x8*)vp; vr1 = *(const bf16x8*)(vp + 64); } } while (0)
    if ((int)blockIdx.x < 8448) HP_LOAD((int)blockIdx.x);
    for (int it = blockIdx.x; it < 8448; it += gridDim.x) {
        const int n = it % 132; const int u3 = it / 132; const int dir = u3 & 1, h = (u3 >> 1) & 3, b = u3 >> 3;
        const size_t row0 = HG_ROW0(n);
        const float lbv = lb[h * 128 + d];
        float lf[16], kk[16], qs[16];
#pragma unroll
        for (int i = 0; i < 16; ++i) { const float fr_ = bf2f(fraw[i]), qr = bf2f(qraw[i]); const float f = lbv + (1.0f - lbv) * sigmf(fr_);
            lf[i] = flog(f); kk[i] = 1.0f - f; qs[i] = siluf(qr); }
#pragma unroll
        for (int i = 1; i < 16; ++i) lf[i] += lf[i - 1];
        const bf16x8 vc0 = vr0, vc1 = vr1;
        if (it + (int)gridDim.x < 8448) HP_LOAD(it + (int)gridDim.x);
        __syncthreads();
        red[part * 128 + d] = lf[15]; if (part == 2) red[512 + d] = lf[0];
        *(LAS bf16x8*)(Vl + vt * 136 + 8 * vc) = vc0; *(LAS bf16x8*)(Vl + vt * 136 + 8 * vc + 64) = vc1;
        __syncthreads();
        {   const float r0 = red[d], r1 = red[128 + d], r2 = red[256 + d], r3 = red[384 + d], l32 = red[512 + d];
            const float pre = part == 0 ? 0.f : (part == 1 ? r0 : (part == 2 ? r0 + r1 : r0 + r1 + r2));
            const float total = (r0 + r1) + (r2 + r3), ref = r0 + r1 + l32;
            const float eref = fexp(ref), etr = fexp(total - ref);
            if (part == 0) sd[(size_t)it * 128 + d] = fexp(total);
            float kp[16];
#pragma unroll
            for (int i = 0; i < 16; ++i) { const float cum = pre + lf[i]; const int t = 16 * part + i;
                const float e1 = fexp(cum - ref), e2 = __builtin_amdgcn_rcpf(e1); const float qe = qs[i] * e1, ke = kk[i] * e2;
                Qi[t * 136 + d] = f2bf(qe); Qo[t * 136 + d] = f2bf(qe * eref); Ki[t * 136 + d] = f2bf(ke); kp[i] = ke * etr; }
            bf16_t* gk = sk + (size_t)it * 8192 + d * 64 + 16 * part;
            *(bf16x8*)gk = pack8(kp); *(bf16x8*)(gk + 8) = pack8(kp + 8); }
        __syncthreads();
        {   bf16_t* gq = sq + (size_t)it * 8192 + vt * 128 + 8 * vc;
            *(bf16x8*)gq = *(const LAS bf16x8*)(Qo + vt * 136 + 8 * vc); *(bf16x8*)(gq + 64) = *(const LAS bf16x8*)(Qo + vt * 136 + 8 * vc + 64); }
        {   const int mt = wave >> 1, nt0 = 2 * (wave & 1); f32x4 sc[2]; sc[0] = (f32x4){0.f, 0.f, 0.f, 0.f}; sc[1] = sc[0];
#pragma unroll
            for (int ks = 0; ks < 4; ++ks) { const bf16x8 a = *(const LAS bf16x8*)(Qi + (16 * mt + fr) * 136 + ks * 32 + 8 * fq);
#pragma unroll
                for (int n2 = 0; n2 < 2; ++n2) { const bf16x8 bb = *(const LAS bf16x8*)(Ki + (16 * (nt0 + n2) + fr) * 136 + ks * 32 + 8 * fq); sc[n2] = MFMA16(a, bb, sc[n2]); } }
#pragma unroll
            for (int n2 = 0; n2 < 2; ++n2)
#pragma unroll
                for (int i = 0; i < 4; ++i) { const int t = 16 * mt + 4 * fq + i, s = 16 * (nt0 + n2) + fr; Pm[t * 72 + s] = f2bf(s <= t ? sc[n2][i] : 0.f); } }
        __syncthreads();
        {   const int mt = wave >> 1, nq = 4 * (wave & 1); f32x4 o[4];
#pragma unroll
            for (int j = 0; j < 4; ++j) o[j] = (f32x4){0.f, 0.f, 0.f, 0.f};
#pragma unroll
            for (int ks = 0; ks < 2; ++ks) { const bf16x8 a = *(const LAS bf16x8*)(Pm + (16 * mt + fr) * 72 + ks * 32 + 8 * fq);
#pragma unroll
                for (int j = 0; j < 4; ++j) { const bf16x8 bb = tr_frag(Vl, 136, 32 * ks, 16 * (nq + j), lane); o[j] = MFMA16(bb, a, o[j]); } }
            {   const int t = 16 * mt + fr; const int tok = dir ? 63 - t : t;
                bf16_t* op = dir ? ob + (row0 + tok) * 512 + h * 128 + 16 * nq + 4 * fq : mix + (row0 + tok) * 1024 + 512 + h * 128 + 16 * nq + 4 * fq;
#pragma unroll
                for (int j = 0; j < 4; ++j) { u32x2 w; w.x = pk2(o[j][0], o[j][1]); w.y = pk2(o[j][2], o[j][3]); *(u32x2*)(op + 16 * j) = w; } } }
    }
}
constexpr int HS_V = 0, HS_ST = 5120;
DI void hgrn_scan_phase(int wv, const bf16_t* P, bf16_t* mix, bf16_t* ob, const bf16_t* sq, const bf16_t* sk, const float* sd, LAS unsigned char* lds) {
    const int tid = pg8::pg8_opaque_tid(wv), lane = tid & 63, wave = __builtin_amdgcn_readfirstlane(tid >> 6);
    const int fr = lane & 15, fq = lane >> 4;
    LAS bf16_t* Vl = (LAS bf16_t*)(lds + HS_V); LAS bf16_t* St = (LAS bf16_t*)(lds + HS_ST);
    const int vt = tid >> 2, vc = tid & 3, mt = wave >> 1, nt = wave & 1;
    for (int unit = blockIdx.x; unit < 256; unit += gridDim.x) {
        const int gx = (unit & 7) * 8 + (unit >> 5), sl = (unit >> 3) & 3, dir = gx & 1, h = (gx >> 1) & 3, b = gx >> 3;
        const size_t item0 = (size_t)(((b * 4 + h) * 2 + dir) * 132);
        __syncthreads();
        for (int i = tid; i < 8704 / 4; i += NTHREADS) ((LAS unsigned*)(lds + HS_ST))[i] = 0u;
        f32x4 sacc[2]; sacc[0] = (f32x4){0.f, 0.f, 0.f, 0.f}; sacc[1] = sacc[0];
        bf16x8 aq[2][4], ak[2][2], vv[2]; f32x4 dv[2]; u32x2 oold[2];
        vv[0] = (bf16x8){0, 0, 0, 0, 0, 0, 0, 0}; vv[1] = vv[0];
        const int otok = dir ? 63 - (16 * mt + fr) : 16 * mt + fr;
        bf16_t* obase = dir ? ob + (size_t)otok * 512 + h * 128 + sl * 32 + 16 * nt + 4 * fq : mix + (size_t)otok * 1024 + 512 + h * 128 + sl * 32 + 16 * nt + 4 * fq;
        const int ostr = dir ? 512 : 1024;
#define HS_LOAD(s_, n_) do { const size_t it_ = item0 + (n_); const size_t r0_ = HG_ROW0(n_); \
            const bf16_t* gq = sq + it_ * 8192 + (16 * mt + fr) * 128 + 8 * fq; const bf16_t* gk = sk + it_ * 8192 + (16 * wave + fr) * 64 + 8 * fq; \
            _Pragma("unroll") for (int ks = 0; ks < 4; ++ks) aq[s_][ks] = *(const bf16x8*)(gq + 32 * ks); \
            ak[s_][0] = *(const bf16x8*)gk; ak[s_][1] = *(const bf16x8*)(gk + 32); \
            if (tid < 256) { const int tok = dir ? 63 - vt : vt; vv[s_] = *(const bf16x8*)(P + (r0_ + tok) * EIN + C_BI + h * 128 + sl * 32 + 8 * vc); } \
            dv[s_] = *(const f32x4*)(sd + it_ * 128 + 16 * wave + 4 * fq); \
            oold[s_] = *(const u32x2*)(obase + r0_ * ostr); } while (0)
        HS_LOAD(0, 0); HS_LOAD(1, 1);
        for (int n0 = 0; n0 < 132; n0 += 2) {
#pragma unroll
          for (int s = 0; s < 2; ++s) {
            const int n = n0 + s;
            const size_t row0 = HG_ROW0(n);
            if (tid < 256) *(LAS bf16x8*)(Vl + vt * 40 + 8 * vc) = vv[s];
            bf16x8 a4[4], k2[2]; f32x4 o, d4 = dv[s];
#pragma unroll
            for (int ks = 0; ks < 4; ++ks) a4[ks] = aq[s][ks];
            k2[0] = ak[s][0]; k2[1] = ak[s][1];
            o[0] = __uint_as_float(oold[s].x << 16); o[1] = __uint_as_float(oold[s].x & 0xffff0000u); o[2] = __uint_as_float(oold[s].y << 16); o[3] = __uint_as_float(oold[s].y & 0xffff0000u);
            if (n + 2 < 132) HS_LOAD(s, n + 2);
            __syncthreads();
            {
#pragma unroll
                for (int ks = 0; ks < 4; ++ks) { const bf16x8 bb = *(const LAS bf16x8*)(St + (16 * nt + fr) * 136 + ks * 32 + 8 * fq); o = MFMA16(bb, a4[ks], o); }
                u32x2 w; w.x = pk2(o[0], o[1]); w.y = pk2(o[2], o[3]); *(u32x2*)(obase + row0 * ostr) = w; }
            {   sacc[0] *= d4; sacc[1] *= d4;
#pragma unroll
                for (int ks = 0; ks < 2; ++ks) {
#pragma unroll
                    for (int et = 0; et < 2; ++et) { const bf16x8 bb = tr_frag(Vl, 40, 32 * ks, 16 * et, lane); sacc[et] = MFMA16(k2[ks], bb, sacc[et]); } } }
            __syncthreads();
#pragma unroll
            for (int et = 0; et < 2; ++et) { u32x2 w; w.x = pk2(sacc[et][0], sacc[et][1]); w.y = pk2(sacc[et][2], sacc[et][3]);
                *(LAS u32x2*)(St + (16 * et + fr) * 136 + 16 * wave + 4 * fq) = w; }
          }
        }
#undef HS_LOAD
    }
}
#undef HP_LOAD
#undef HG_ROW0
DI void hgrn_norm_phase(int wv, const bf16_t* P, bf16_t* mix, const bf16_t* ob, const float* outg) {
    const int tid = pg8::pg8_opaque_tid(wv), lane = tid & 63, wave = __builtin_amdgcn_readfirstlane(tid >> 6);
    const int gw = blockIdx.x * NWAVES + wave, ngw = gridDim.x * NWAVES;
    float gv[8];
#pragma unroll
    for (int i = 0; i < 8; ++i) gv[i] = outg[8 * (lane & 15) + i];
    for (int row0 = gw * 4; row0 < NT_ALL; row0 += ngw * 4) {
        bf16x8 a[4], b[4], g[4];
#pragma unroll
        for (int u = 0; u < 4; ++u) { const size_t row = (size_t)row0 + u;
            a[u] = *(const bf16x8*)(mix + row * 1024 + 512 + 8 * lane); b[u] = *(const bf16x8*)(ob + row * 512 + 8 * lane); g[u] = *(const bf16x8*)(P + row * EIN + C_BG + 8 * lane); }
#pragma unroll
        for (int u = 0; u < 4; ++u) { const size_t row = (size_t)row0 + u;
            float of[8], o2[8], gg[8]; unpack8(a[u], of); unpack8(b[u], o2); unpack8(g[u], gg);
            float ss = 0.f;
#pragma unroll
            for (int i = 0; i < 8; ++i) { of[i] += o2[i]; ss += of[i] * of[i]; }
            ss += __shfl_xor(ss, 1); ss += __shfl_xor(ss, 2); ss += __shfl_xor(ss, 4); ss += __shfl_xor(ss, 8);
            const float rn = rsqrtf(ss * (1.0f / 128.0f) + EPS);
#pragma unroll
            for (int i = 0; i < 8; ++i) of[i] = of[i] * rn * gv[i] * siluf(gg[i]);
            *(bf16x8*)(mix + row * 1024 + 512 + 8 * lane) = pack8(of); }
    }
}

constexpr int RI_Q = 0, RI_K = 33792, RI_V = 67584, RI_PM = 134144;
DI void ret_intra_phase(int wv, const bf16_t* P1, bf16_t* ofw, LAS unsigned char* lds) {
    const int tid = pg8::pg8_opaque_tid(wv), lane = tid & 63, wave = __builtin_amdgcn_readfirstlane(tid >> 6);
    const int fr = lane & 15, fq = lane >> 4;
    LAS bf16_t* Q = (LAS bf16_t*)(lds + RI_Q); LAS bf16_t* K = (LAS bf16_t*)(lds + RI_K); LAS bf16_t* Vl = (LAS bf16_t*)(lds + RI_V); LAS bf16_t* Pm = (LAS bf16_t*)(lds + RI_PM);
    const int pt = tid >> 3, pc = tid & 7;
    bf16x8 qv[4], kv[4], vv[8];
#define RI_LOAD(it_) do { const int h_ = ((it_) >> 7) & 3; const bf16_t* rp_ = P1 + ((size_t)((it_) >> 9) * 8192 + ((it_) & 127) * 64 + pt) * OIN; \
        _Pragma("unroll") for (int j = 0; j < 4; ++j) { qv[j] = *(const bf16x8*)(rp_ + C_RQ + h_ * 256 + 64 * j + 8 * pc); kv[j] = *(const bf16x8*)(rp_ + C_RK + h_ * 256 + 64 * j + 8 * pc); } \
        _Pragma("unroll") for (int j = 0; j < 8; ++j) vv[j] = *(const bf16x8*)(rp_ + C_RV + h_ * 512 + 8 * pc + 64 * j); } while (0)
    if ((int)blockIdx.x < 2048) RI_LOAD((int)blockIdx.x);
    for (int it = blockIdx.x; it < 2048; it += gridDim.x) {
        const int cc = it & 127, h = (it >> 7) & 3, bl = it >> 9;
        const float lgf = log2f(1.0f - exp2f(-5.0f - (float)h)), lgb = log2f(1.0f - exp2f(-5.0f - (float)(3 - h)));
        const size_t row0 = (size_t)bl * 8192 + cc * 64;
        __syncthreads();
#pragma unroll
        for (int j = 0; j < 4; ++j) { *(LAS bf16x8*)(Q + pt * 264 + 64 * j + 8 * pc) = qv[j]; *(LAS bf16x8*)(K + pt * 264 + 64 * j + 8 * pc) = kv[j]; }
#pragma unroll
        for (int j = 0; j < 8; ++j) *(LAS bf16x8*)(Vl + pt * 520 + 8 * pc + 64 * j) = vv[j];
        if (it + (int)gridDim.x < 2048) RI_LOAD(it + (int)gridDim.x);
        __syncthreads();
        {   const int mt = wave >> 1, nt0 = 2 * (wave & 1); f32x4 sc[2]; sc[0] = (f32x4){0.f, 0.f, 0.f, 0.f}; sc[1] = sc[0];
#pragma unroll
            for (int ks = 0; ks < 8; ++ks) { const bf16x8 a = *(const LAS bf16x8*)(Q + (16 * mt + fr) * 264 + ks * 32 + 8 * fq);
#pragma unroll
                for (int n2 = 0; n2 < 2; ++n2) { const bf16x8 bb = *(const LAS bf16x8*)(K + (16 * (nt0 + n2) + fr) * 264 + ks * 32 + 8 * fq); sc[n2] = MFMA16(a, bb, sc[n2]); } }
#pragma unroll
            for (int n2 = 0; n2 < 2; ++n2)
#pragma unroll
                for (int i = 0; i < 4; ++i) { const int t = 16 * mt + 4 * fq + i, s = 16 * (nt0 + n2) + fr; const int dl = t - s;
                    const float w = dl > 0 ? exp2f((float)dl * lgf) : (dl < 0 ? exp2f((float)(-dl) * lgb) : 2.0f);
                    Pm[t * 72 + s] = f2bf(sc[n2][i] * w); } }
        __syncthreads();
        {   f32x4 o[4][4];
#pragma unroll
            for (int mt = 0; mt < 4; ++mt)
#pragma unroll
                for (int j = 0; j < 4; ++j) o[mt][j] = (f32x4){0.f, 0.f, 0.f, 0.f};
#pragma unroll
            for (int ks = 0; ks < 2; ++ks) { bf16x8 bb[4];
#pragma unroll
                for (int j = 0; j < 4; ++j) bb[j] = tr_frag(Vl, 520, 32 * ks, 16 * (4 * wave + j), lane);
#pragma unroll
                for (int mt = 0; mt < 4; ++mt) { const bf16x8 a = *(const LAS bf16x8*)(Pm + (16 * mt + fr) * 72 + ks * 32 + 8 * fq);
#pragma unroll
                    for (int j = 0; j < 4; ++j) o[mt][j] = MFMA16(bb[j], a, o[mt][j]); } }
#pragma unroll
            for (int mt = 0; mt < 4; ++mt) { bf16_t* op = ofw + (row0 + 16 * mt + fr) * 2048 + h * 512 + 64 * wave + 4 * fq;
#pragma unroll
                for (int j = 0; j < 4; ++j) { u32x2 w; w.x = pk2(o[mt][j][0], o[mt][j][1]); w.y = pk2(o[mt][j][2], o[mt][j][3]); *(u32x2*)(op + 16 * j) = w; } } }
    }
}
#undef RI_LOAD
constexpr int RT_Q = 0, RT_K = 33792, RT_VS = 67584, RT_ST = 76800;
DI void ret_scan_phase(int wv, const bf16_t* P1, bf16_t* ofw, bf16_t* obw, LAS unsigned char* lds) {
    const int tid = pg8::pg8_opaque_tid(wv), lane = tid & 63, wave = __builtin_amdgcn_readfirstlane(tid >> 6);
    const int fr = lane & 15, fq = lane >> 4;
    LAS bf16_t* Q = (LAS bf16_t*)(lds + RT_Q); LAS bf16_t* K = (LAS bf16_t*)(lds + RT_K); LAS bf16_t* Vs = (LAS bf16_t*)(lds + RT_VS); LAS bf16_t* St = (LAS bf16_t*)(lds + RT_ST);
    const int mt = wave >> 1, et0 = 2 * (wave & 1);
    for (int unit = blockIdx.x; unit < 256; unit += gridDim.x) {
        const int gx = (unit & 7) * 4 + (unit >> 6), sl = (unit >> 3) & 7, dir = gx & 1, h = (gx >> 1) & 3, bl = gx >> 3;
        const int hh = dir ? 3 - h : h;
        const float lg2 = log2f(1.0f - exp2f(-5.0f - (float)hh));
        const float g64 = exp2f(64.0f * lg2);
        __syncthreads();
        for (int i = tid; i < 33792 / 4; i += NTHREADS) ((LAS unsigned*)(lds + RT_ST))[i] = 0u;
        f32x4 sacc[2][4];
#pragma unroll
        for (int a = 0; a < 2; ++a)
#pragma unroll
            for (int e = 0; e < 4; ++e) sacc[a][e] = (f32x4){0.f, 0.f, 0.f, 0.f};
        const int pt = tid >> 3, pc = tid & 7;
        const int ptok = dir ? 63 - pt : pt;
        const float vscl = exp2f((float)(63 - pt) * lg2);
        const float rsc = exp2f((float)(16 * mt + fr + 1) * lg2);
        bf16x8 qv[2][4], kv[2][4], vv[2]; u32x2 oold[2][2];
        const int otok = dir ? 63 - (16 * mt + fr) : 16 * mt + fr;
        bf16_t* obase = (dir ? obw : ofw) + (size_t)otok * 2048 + h * 512 + sl * 64 + 16 * et0 + 4 * fq;
#define RT_ROW0(n_) ((n_) < 4 ? (size_t)32768 + bl * 256 + (dir ? 3 - (n_) : (n_)) * 64 : (size_t)bl * 8192 + (dir ? 127 - ((n_) - 4) : (n_) - 4) * 64)
#define RT_LOAD(s_, n_) do { const size_t r0_ = RT_ROW0(n_); const bf16_t* rp_ = P1 + (r0_ + ptok) * OIN; \
            _Pragma("unroll") for (int j = 0; j < 4; ++j) { qv[s_][j] = *(const bf16x8*)(rp_ + C_RQ + h * 256 + 64 * j + 8 * pc); kv[s_][j] = *(const bf16x8*)(rp_ + C_RK + h * 256 + 64 * j + 8 * pc); } \
            vv[s_] = *(const bf16x8*)(rp_ + C_RV + h * 512 + sl * 64 + 8 * pc); \
            if (!dir && (n_) >= 4) { oold[s_][0] = *(const u32x2*)(obase + r0_ * 2048); oold[s_][1] = *(const u32x2*)(obase + r0_ * 2048 + 16); } } while (0)
        RT_LOAD(0, 0); RT_LOAD(1, 1);
        for (int n0 = 0; n0 < 132; n0 += 2) {
#pragma unroll
          for (int s = 0; s < 2; ++s) {
            const int n = n0 + s;
            const bool is_ctx = n < 4; const size_t row0 = RT_ROW0(n);
#pragma unroll
            for (int j = 0; j < 4; ++j) { *(LAS bf16x8*)(Q + pt * 264 + 64 * j + 8 * pc) = qv[s][j]; *(LAS bf16x8*)(K + pt * 264 + 64 * j + 8 * pc) = kv[s][j]; }
            {   float vf[8]; unpack8(vv[s], vf);
#pragma unroll
                for (int i = 0; i < 8; ++i) vf[i] *= vscl;
                *(LAS bf16x8*)(Vs + pt * 72 + 8 * pc) = pack8(vf); }
            f32x4 o[2];
#pragma unroll
            for (int e2 = 0; e2 < 2; ++e2) { o[e2][0] = dir ? 0.f : __uint_as_float(oold[s][e2].x << 16); o[e2][1] = dir ? 0.f : __uint_as_float(oold[s][e2].x & 0xffff0000u);
                o[e2][2] = dir ? 0.f : __uint_as_float(oold[s][e2].y << 16); o[e2][3] = dir ? 0.f : __uint_as_float(oold[s][e2].y & 0xffff0000u); }
            if (n + 2 < 132) RT_LOAD(s, n + 2);
            __syncthreads();
            if (!is_ctx) { f32x4 oi[2]; oi[0] = (f32x4){0.f, 0.f, 0.f, 0.f}; oi[1] = oi[0];
#pragma unroll
                for (int ks = 0; ks < 8; ++ks) { const bf16x8 a = *(const LAS bf16x8*)(Q + (16 * mt + fr) * 264 + ks * 32 + 8 * fq);
#pragma unroll
                    for (int e2 = 0; e2 < 2; ++e2) { const bf16x8 bb = *(const LAS bf16x8*)(St + (16 * (et0 + e2) + fr) * 264 + ks * 32 + 8 * fq); oi[e2] = MFMA16(bb, a, oi[e2]); } }
#pragma unroll
                for (int e2 = 0; e2 < 2; ++e2) { const f32x4 r = o[e2] + oi[e2] * rsc; u32x2 w; w.x = pk2(r[0], r[1]); w.y = pk2(r[2], r[3]); *(u32x2*)(obase + row0 * 2048 + 16 * e2) = w; } }
            {
#pragma unroll
                for (int dt = 0; dt < 2; ++dt)
#pragma unroll
                    for (int et = 0; et < 4; ++et) sacc[dt][et] *= g64;
#pragma unroll
                for (int ks = 0; ks < 2; ++ks) { bf16x8 bb[4];
#pragma unroll
                    for (int et = 0; et < 4; ++et) bb[et] = tr_frag(Vs, 72, 32 * ks, 16 * et, lane);
#pragma unroll
                    for (int dt = 0; dt < 2; ++dt) { const bf16x8 a = tr_frag(K, 264, 32 * ks, 16 * (2 * wave + dt), lane);
#pragma unroll
                        for (int et = 0; et < 4; ++et) sacc[dt][et] = MFMA16(a, bb[et], sacc[dt][et]); } } }
            __syncthreads();
#pragma unroll
            for (int dt = 0; dt < 2; ++dt)
#pragma unroll
                for (int et = 0; et < 4; ++et) { u32x2 w; w.x = pk2(sacc[dt][et][0], sacc[dt][et][1]); w.y = pk2(sacc[dt][et][2], sacc[dt][et][3]);
                    *(LAS u32x2*)(St + (16 * et + fr) * 264 + 16 * (2 * wave + dt) + 4 * fq) = w; }
          }
        }
#undef RT_LOAD
#undef RT_ROW0
    }
}
DI void ret_norm_phase(int wv, const bf16_t* P1, bf16_t* ofw, const bf16_t* obw) {
    const int tid = pg8::pg8_opaque_tid(wv), lane = tid & 63, wave = __builtin_amdgcn_readfirstlane(tid >> 6);
    const int gw = blockIdx.x * NWAVES + wave, ngw = gridDim.x * NWAVES;
    for (int idx0 = gw * 4; idx0 < 32768 * 4; idx0 += ngw * 4) {
        bf16x8 a[4], b[4], g[4];
#pragma unroll
        for (int u = 0; u < 4; ++u) { const int idx = idx0 + u; const int row = idx >> 2, h = idx & 3;
            a[u] = *(const bf16x8*)(ofw + (size_t)row * 2048 + h * 512 + 8 * lane); b[u] = *(const bf16x8*)(obw + (size_t)row * 2048 + h * 512 + 8 * lane);
            g[u] = *(const bf16x8*)(P1 + (size_t)row * OIN + C_RG + h * 512 + 8 * lane); }
#pragma unroll
        for (int u = 0; u < 4; ++u) { const int idx = idx0 + u; const int row = idx >> 2, h = idx & 3;
            float of[8], o2[8], gg[8]; unpack8(a[u], of); unpack8(b[u], o2); unpack8(g[u], gg);
            float ss = 0.f;
#pragma unroll
            for (int i = 0; i < 8; ++i) { of[i] += o2[i]; ss += of[i] * of[i]; }
            const float rn = rsqrtf(wave_sum(ss) * (1.0f / 512.0f) + EPS);
#pragma unroll
            for (int i = 0; i < 8; ++i) of[i] = of[i] * rn * siluf(gg[i]);
            *(bf16x8*)(ofw + (size_t)row * 2048 + h * 512 + 8 * lane) = pack8(of); }
    }
}

template <class Epi>
DI void run_gemm(int wv, LAS unsigned char* lds, const bf16_t* A, const bf16_t* Bt, int M, int N, int K, const Epi& E) {
    pg8::Gemm g{A, Bt, M, N, K}; pg8::StaticOrder S; S.init(M, N, (int)gridDim.x, (int)blockIdx.x);
    pg8::gemm_phase<Epi, pg8::StaticOrder, false>(lds, g, S, E, nullptr, wv);
}

__global__ void __launch_bounds__(NTHREADS, 2) fwd_megakernel(Args a) {
    extern __shared__ __attribute__((aligned(16))) unsigned char lds_raw[];
    LAS unsigned char* lds = (LAS unsigned char*)lds_raw;
    cg::grid_group grid = cg::this_grid();
    const int wave_s = __builtin_amdgcn_readfirstlane((int)(threadIdx.x >> 6));
    volatile LAS unsigned* xbst = (volatile LAS unsigned*)(lds + 157680);
    if (threadIdx.x < 4) xbst[threadIdx.x] = 0u;
    __syncthreads();
    (void)xcd_barrier_post((unsigned*)(a.ws + WS_BAR), xbst);
#define GBAR() do { XcdBarrier xb_; xb_.bar = (unsigned*)(a.ws + WS_BAR); xb_.x = xb_xcc_id(); xb_.wv = wave_s; xb_.st = (volatile LAS unsigned*)(lds + 157680); xcd_barrier(xb_); } while (0)
    unsigned char* ws = a.ws;
    bf16_t* wt_ein = (bf16_t*)(ws + WS_WT_EIN); bf16_t* wt_eout = (bf16_t*)(ws + WS_WT_EOUT); bf16_t* wt_oin = (bf16_t*)(ws + WS_WT_OIN); bf16_t* wt_oout = (bf16_t*)(ws + WS_WT_OOUT);
    bf16_t* wt_fin = (bf16_t*)(ws + WS_WT_FIN); bf16_t* wt_fout = (bf16_t*)(ws + WS_WT_FOUT);
    float* mods = (float*)(ws + WS_MODS); float* axt = (float*)(ws + WS_ROPE_AX); float* rtt = (float*)(ws + WS_ROPE_RT); float* lb = (float*)(ws + WS_LB);
    float* gs = (float*)(ws + WS_GS); float* bias3 = (float*)(ws + WS_BIAS3); float* bias5 = (float*)(ws + WS_BIAS5); float* bias7 = (float*)(ws + WS_BIAS7);
    float* rss_a = (float*)(ws + WS_RSS_A); float* rss_b = (float*)(ws + WS_RSS_B); float* rss_c = (float*)(ws + WS_RSS_C);
    float* ctxr = (float*)(ws + WS_CTXR); bf16_t* ha = (bf16_t*)(ws + WS_HA); bf16_t* obuf = (bf16_t*)(ws + WS_OB); bf16_t* big = (bf16_t*)(ws + WS_BIG);
    bf16_t* ofw = (bf16_t*)(ws + WS_OFW); bf16_t* obw = (bf16_t*)(ws + WS_OBW);
    const float* x = a.in[0]; const float* ctx = a.in[2]; const float* normg = a.in[6]; float* out = a.out;

    mods_phase(wave_s, a, mods, lds);
    __syncthreads();
    tables_phase(wave_s, a, axt, rtt, lb, rss_a, (int)((WS_HA - WS_RSS_A) / 4));
    {   const int tid = pg8::pg8_opaque_tid(wave_s), lane = tid & 63, wave = __builtin_amdgcn_readfirstlane(tid >> 6);
        LAS float* scr = (LAS float*)(lds + wave * 16384);
        const int gw = blockIdx.x * NWAVES + wave, ngw = gridDim.x * NWAVES; int it0 = 0;
        transpose_matrix(a.in[9], DM, EIN, wt_ein, false, it0, gw, ngw, scr, lane);
        transpose_matrix(a.in[10], DM, DM, wt_eout, false, it0, gw, ngw, scr, lane);
        transpose_matrix(a.in[15], DM, OIN, wt_oin, false, it0, gw, ngw, scr, lane);
        transpose_matrix(a.in[16], 2048, DM, wt_oout, false, it0, gw, ngw, scr, lane);
        transpose_matrix(a.in[7], DM, 2 * FF, wt_fin, true, it0, gw, ngw, scr, lane);
        transpose_matrix(a.in[7] + (size_t)DM * 2 * FF, DM, 2 * FF, wt_fin + (size_t)2 * FF * DM, true, it0, gw, ngw, scr, lane);
        transpose_matrix(a.in[8], FF, DM, wt_fout, false, it0, gw, ngw, scr, lane);
        transpose_matrix(a.in[8] + (size_t)FF * DM, FF, DM, wt_fout + (size_t)DM * FF, false, it0, gw, ngw, scr, lane);
    }
    grid.sync();

    const float* mods0 = mods; const float* mods1 = mods + 9 * 6144;
    normmod_phase(wave_s, x, ctx, 0, NT_LAT, NT_ALL, normg + 0, mods0, 0, ha);
    aux_phase(wave_s, normg, mods, wt_fin, wt_oin, gs, bias3, bias5, bias7);
    GBAR();
    {   pg8::EpiStoreBf16 E{big, EIN}; run_gemm(wave_s, lds, ha, wt_ein, NT_ALL, EIN, DM, E); }
    GBAR();
    bf16_t* hsq = big + (size_t)NT_ALL * EIN; bf16_t* hsk = hsq + (size_t)8448 * 8192; float* hsd = (float*)(hsk + (size_t)8448 * 8192);
    hgrn_prep_phase(wave_s, big, ha, obuf, lb, hsq, hsk, hsd, lds);
    GBAR();
    hgrn_scan_phase(wave_s, big, ha, obuf, hsq, hsk, hsd, lds);
    __syncthreads();
    attn_phase(wave_s, big, ha, a.in[11], a.in[12], axt, axt + 8192 * 32, lds);
    GBAR();
    hgrn_norm_phase(wave_s, big, ha, obuf, a.in[13]);
    GBAR();
    bf16_t* a3 = big + (size_t)NT_ALL * FF;
    {   pg8::EpiResid<true> E{x, out, ctx, ctxr, mods0 + 2 * 1024, 0, NT_LAT, a3, rss_a, gs, 0}; run_gemm(wave_s, lds, ha, wt_eout, NT_ALL, DM, DM, E); }
    GBAR();
    {   pg8::EpiSwiglu E{big, FF, pg8::RowNorm{rss_a, bias3, 5632, 0, NT_LAT}}; run_gemm(wave_s, lds, a3, wt_fin, NT_ALL, 2 * FF, DM, E); }
    GBAR();
    {   pg8::EpiResid<true> E{out, out, ctxr, ctxr, mods0 + 5 * 1024, 0, NT_LAT, ha, rss_b, gs + 9 * 1024, 1}; run_gemm(wave_s, lds, big, wt_fout, NT_ALL, DM, FF, E); }
    GBAR();

    bf16_t* a7 = obuf;
    for (int hb = 0; hb < 2; ++hb) {
        const int b0 = 4 * hb;
        {   pg8::EpiRopeStore E{big, OIN, rtt, rtt + 8192 * 128, 32768, pg8::RowNorm{rss_b + (size_t)hb * 33792 * 16, bias5, 6144, b0, 32768}}; run_gemm(wave_s, lds, ha + (size_t)hb * 33792 * DM, wt_oin, 33792, OIN, DM, E); }
        GBAR();
        ret_intra_phase(wave_s, big, ofw, lds);
        GBAR();
        ret_scan_phase(wave_s, big, ofw, obw, lds);
        GBAR();
        ret_norm_phase(wave_s, big, ofw, obw);
        GBAR();
        {   pg8::EpiResid<true> E{out, out, ctxr, ctxr, mods1 + 2 * 1024, b0, 32768, a7, rss_c + (size_t)hb * 32768 * 16, gs + 18 * 1024, 0}; run_gemm(wave_s, lds, ofw, wt_oout, 32768, DM, 2048, E); }
        GBAR();
        {   pg8::EpiSwiglu E{big, FF, pg8::RowNorm{rss_c + (size_t)hb * 32768 * 16, bias7, 5632, b0, 32768}}; run_gemm(wave_s, lds, a7, wt_fin + (size_t)2 * FF * DM, 32768, 2 * FF, DM, E); }
        GBAR();
        {   pg8::EpiResid<false> E{out, out, ctxr, ctxr, mods1 + 5 * 1024, b0, 32768, nullptr, nullptr, nullptr, 0}; run_gemm(wave_s, lds, big, wt_fout + (size_t)DM * FF, 32768, DM, FF, E); }
        GBAR();
    }
}

extern "C" void kernel_launch(void* const* d_in, const int* in_sizes, int n_in, void* d_out, int out_size, void* d_ws, size_t ws_size, hipStream_t stream) {
    static int grid = 0;
    if (grid == 0) {
        if (n_in != 17 || ws_size < WS_END) { fprintf(stderr, "kernel_launch: need 17 inputs and >= %zu bytes of workspace (got %d, %zu)\n", (size_t)WS_END, n_in, ws_size); grid = -1; return; }
        int dev = 0, cus = 0, per_cu = 0;
        hipGetDevice(&dev); hipDeviceGetAttribute(&cus, hipDeviceAttributeMultiprocessorCount, dev);
        if (hipFuncSetAttribute((const void*)fwd_megakernel, hipFuncAttributeMaxDynamicSharedMemorySize, LDS_BYTES) != hipSuccess) { fprintf(stderr, "kernel_launch: hipFuncSetAttribute failed\n"); grid = -1; return; }
        if (hipOccupancyMaxActiveBlocksPerMultiprocessor(&per_cu, (const void*)fwd_megakernel, NTHREADS, LDS_BYTES) != hipSuccess || per_cu < 1) { fprintf(stderr, "kernel_launch: occupancy query says %d\n", per_cu); per_cu = 1; }
        (void)hipGetLastError();
        grid = cus * 1;
    }
    if (grid < 0) return;
    if (hipMemsetAsync((char*)d_ws + WS_BAR, 0, 4096 * 4, stream) != hipSuccess) { fprintf(stderr, "kernel_launch: memset of barrier words failed\n"); return; }
    Args a{};
    for (int i = 0; i < 17; ++i) a.in[i] = (const float*)d_in[i];
    a.out = (float*)d_out; a.ws = (unsigned char*)d_ws;
    void* args[] = {&a};
    hipError_t e = hipLaunchCooperativeKernel((const void*)fwd_megakernel, dim3(grid), dim3(NTHREADS), args, LDS_BYTES, stream);
    if (e != hipSuccess) fprintf(stderr, "cooperative launch failed: %s (grid %d)\n", hipGetErrorString(e), grid);
}
```

```cpp
#include <hip/hip_runtime.h>
#include <hip/hip_cooperative_groups.h>
#include <cstdio>
namespace cg = cooperative_groups;

#define DI __device__ __forceinline__
#define LAS __attribute__((address_space(3)))
namespace pg8 {
#define PG8_LAS __attribute__((address_space(3)))
typedef unsigned short bf16_t;
typedef short bf16x8 __attribute__((ext_vector_type(8)));
typedef float f32x4 __attribute__((ext_vector_type(4)));
typedef unsigned u32x4 __attribute__((ext_vector_type(4)));
constexpr int BM = 256, BK = 64, HALF = 128, HTB = HALF * BK * 2  , STAGE_BYTES = 8 * HTB, NXCD = 8, WGM = 4;

__host__ __device__ __forceinline__ int lds_byte(int r, int c) { const int st = (r >> 4) * 2 + (c >> 5), rr = r & 15, cc = c & 31, ob = rr * 64 + cc * 2; return st * 1024 + (ob ^ (((ob >> 9) & 1) << 5)); }
__host__ __device__ __forceinline__ void stage_rc(int b, int& R, int& C) { const int st = b / 1024, sb = b % 1024, swz = sb ^ (((sb >> 9) & 1) << 5); R = (st >> 1) * 16 + swz / 64; C = (st & 1) * 32 + (swz % 64) / 2; }
__host__ __device__ __forceinline__ int perm32(int rho) { const int n = rho >> 4, i = rho & 15; return 8 * (i >> 2) + 4 * n + (i & 3); }

struct Unit { int pm, pn; };
struct Gemm { const bf16_t* A; const bf16_t* Bt; int M, N, K; };

struct StaticOrder {
    int nM, nN, nwg, G, c, rev;
    __host__ __device__ void init(int M, int N, int G_, int c_, int rev_ = 0) { nM = M / BM; nN = N / BM; nwg = nM * nN; G = G_; c = c_; rev = rev_; }
    __host__ __device__ bool next(int i, Unit& u) const {
        const long L = (long)i * G + c; if (L >= nwg) return false;
        int wgid = (int)L; { const int q = nwg / NXCD, r = nwg % NXCD, xcd = wgid % NXCD, off = wgid / NXCD; wgid = (xcd < r ? xcd * (q + 1) : r * (q + 1) + (xcd - r) * q) + off; }
        const int nig = WGM * nN, gid = wgid / nig, fm = gid * WGM, gsz = (nM - fm) < WGM ? (nM - fm) : WGM;
        u.pm = fm + ((wgid % nig) % gsz); u.pn = (wgid % nig) / gsz; if (rev) u.pm = nM - 1 - u.pm; return true;
    }
    __device__ __forceinline__ void a_ready(const Unit&) const {}
    __device__ __forceinline__ void done(const Unit&) const {}
};

typedef unsigned u32x2 __attribute__((ext_vector_type(2)));
__device__ __forceinline__ int pg8_opaque_tid(int wv) { unsigned z = 0u; asm volatile("" : "+v"(z)); return (wv << 6) | (int)__builtin_amdgcn_mbcnt_hi(~0u, __builtin_amdgcn_mbcnt_lo(~0u, z)); }
__device__ __forceinline__ unsigned cvt_pk_bf16(float lo, float hi) { unsigned r; asm volatile("v_cvt_pk_bf16_f32 %0, %1, %2" : "=v"(r) : "v"(lo), "v"(hi)); return r; }

struct EpiStoreBf16 {
    static constexpr bool PERM = true, AFTER_DRAIN = false;
    bf16_t* O; int ldc;
    __device__ __forceinline__ void operator()(const f32x4 (&acc)[2][2][4][2], const Unit& u, int wr, int wc, int fr, int fq) const {
        const int row0 = u.pm * BM + wr * 64 + fr; const int col0 = u.pn * BM + wc * 32 + 8 * fq;
#pragma unroll
        for (int ai = 0; ai < 2; ++ai)
#pragma unroll
            for (int m = 0; m < 4; ++m) { bf16_t* rowp = O + (size_t)(row0 + ai * HALF + m * 16) * ldc + col0;
#pragma unroll
                for (int bj = 0; bj < 2; ++bj) { const f32x4 v0 = acc[ai][bj][m][0], v1 = acc[ai][bj][m][1];
                    u32x4 w; w.x = cvt_pk_bf16(v0[0], v0[1]); w.y = cvt_pk_bf16(v0[2], v0[3]); w.z = cvt_pk_bf16(v1[0], v1[1]); w.w = cvt_pk_bf16(v1[2], v1[3]);
                    *(u32x4*)(rowp + bj * HALF) = w; } }
    }
};
struct RowNorm { const float* rowss; const float* bias; int ldb, b0, nlat; };
struct EpiRopeStore {
    static constexpr bool PERM = true, AFTER_DRAIN = false;
    bf16_t* O; int ldc; const float* rtc; const float* rts; int nlat; RowNorm rn;
    __device__ __forceinline__ void operator()(const f32x4 (&acc)[2][2][4][2], const Unit& u, int wr, int wc, int fr, int fq) const {
        const int row0 = u.pm * BM + wr * 64 + fr; const int col0 = u.pn * BM + wc * 32 + 8 * fq;
        const bool rot = (u.pn < 8) && (u.pm * BM < nlat); const float ksc = (u.pn >= 4 && u.pn < 8) ? 0.0625f : 1.0f;
        const int mrow = (u.pm * BM < rn.nlat) ? rn.b0 + ((u.pm * BM) >> 13) : 8;
        const float* bp = rn.bias + (size_t)mrow * rn.ldb + col0;
        const f32x4 bv00 = *(const f32x4*)bp, bv01 = *(const f32x4*)(bp + 4), bv10 = *(const f32x4*)(bp + HALF), bv11 = *(const f32x4*)(bp + HALF + 4);
        float rinv[8];
#pragma unroll
        for (int ii = 0; ii < 8; ii += 2) { const f32x4 qa = *(const f32x4*)(rn.rowss + (size_t)(row0 + (ii >> 2) * HALF + (ii & 3) * 16) * 16 + 4 * fq), qb = *(const f32x4*)(rn.rowss + (size_t)(row0 + ((ii + 1) >> 2) * HALF + ((ii + 1) & 3) * 16) * 16 + 4 * fq);
            float sa = (qa[0] + qa[1]) + (qa[2] + qa[3]), sb = (qb[0] + qb[1]) + (qb[2] + qb[3]);
            sa += __shfl_xor(sa, 16); sb += __shfl_xor(sb, 16); sa += __shfl_xor(sa, 32); sb += __shfl_xor(sb, 32);
            rinv[ii] = rsqrtf(sa * (1.0f / 1024.0f) + 1e-6f); rinv[ii + 1] = rsqrtf(sb * (1.0f / 1024.0f) + 1e-6f); }
        f32x4 tc[4], tn[4];
#define PG8_LOADT(dst, idx) do { const size_t to_ = (size_t)((row0 + ((idx) >> 2) * HALF + ((idx) & 3) * 16) & 8191) * 128 + wc * 32 + 8 * fq; \
            dst[0] = *(const f32x4*)(rtc + to_); dst[1] = *(const f32x4*)(rtc + to_ + 4); dst[2] = *(const f32x4*)(rts + to_); dst[3] = *(const f32x4*)(rts + to_ + 4); } while (0)
        if (rot) PG8_LOADT(tc, 0);
#pragma unroll
        for (int idx = 0; idx < 8; ++idx) { const int ai = idx >> 2, m = idx & 3;
            const int row = row0 + ai * HALF + m * 16; bf16_t* rowp = O + (size_t)row * ldc + col0;
            if (rot && idx + 1 < 8) PG8_LOADT(tn, idx + 1);
            const float ri = rinv[idx];
            f32x4 a0 = acc[ai][0][m][0] * ri + bv00, a1 = acc[ai][0][m][1] * ri + bv01, b0 = acc[ai][1][m][0] * ri + bv10, b1 = acc[ai][1][m][1] * ri + bv11;
            if (rot) { const f32x4 x0 = a0 * tc[0] - b0 * tc[2], y0 = b0 * tc[0] + a0 * tc[2], x1 = a1 * tc[1] - b1 * tc[3], y1 = b1 * tc[1] + a1 * tc[3]; a0 = x0; b0 = y0; a1 = x1; b1 = y1; }
            a0 *= ksc; a1 *= ksc; b0 *= ksc; b1 *= ksc;
            u32x4 w; w.x = cvt_pk_bf16(a0[0], a0[1]); w.y = cvt_pk_bf16(a0[2], a0[3]); w.z = cvt_pk_bf16(a1[0], a1[1]); w.w = cvt_pk_bf16(a1[2], a1[3]);
            *(u32x4*)rowp = w;
            w.x = cvt_pk_bf16(b0[0], b0[1]); w.y = cvt_pk_bf16(b0[2], b0[3]); w.z = cvt_pk_bf16(b1[0], b1[1]); w.w = cvt_pk_bf16(b1[2], b1[3]);
            *(u32x4*)(rowp + HALF) = w;
#pragma unroll
            for (int q = 0; q < 4; ++q) tc[q] = tn[q];
        }
#undef PG8_LOADT
    }
};

struct EpiSwiglu {
    static constexpr bool PERM = true, AFTER_DRAIN = false;
    bf16_t* O; int ldc; RowNorm rn;
    __device__ __forceinline__ void operator()(const f32x4 (&acc)[2][2][4][2], const Unit& u, int wr, int wc, int fr, int fq) const {
        const int row0 = u.pm * BM + wr * 64 + fr; const int col0 = u.pn * HALF + wc * 32 + 8 * fq;
        const int mrow = (u.pm * BM < rn.nlat) ? rn.b0 + ((u.pm * BM) >> 13) : 8;
        const float* bp = rn.bias + (size_t)mrow * rn.ldb + u.pn * BM + wc * 32 + 8 * fq;
        f32x4 bv[2][2];
#pragma unroll
        for (int bj = 0; bj < 2; ++bj)
#pragma unroll
            for (int n = 0; n < 2; ++n) bv[bj][n] = *(const f32x4*)(bp + bj * HALF + 4 * n);
        float rinv[8];
#pragma unroll
        for (int ii = 0; ii < 8; ii += 2) { const f32x4 qa = *(const f32x4*)(rn.rowss + (size_t)(row0 + (ii >> 2) * HALF + (ii & 3) * 16) * 16 + 4 * fq), qb = *(const f32x4*)(rn.rowss + (size_t)(row0 + ((ii + 1) >> 2) * HALF + ((ii + 1) & 3) * 16) * 16 + 4 * fq);
            float sa = (qa[0] + qa[1]) + (qa[2] + qa[3]), sb = (qb[0] + qb[1]) + (qb[2] + qb[3]);
            sa += __shfl_xor(sa, 16); sb += __shfl_xor(sb, 16); sa += __shfl_xor(sa, 32); sb += __shfl_xor(sb, 32);
            rinv[ii] = rsqrtf(sa * (1.0f / 1024.0f) + 1e-6f); rinv[ii + 1] = rsqrtf(sb * (1.0f / 1024.0f) + 1e-6f); }
#pragma unroll
        for (int ai = 0; ai < 2; ++ai) {
#pragma unroll
            for (int m = 0; m < 4; ++m) { const int row = row0 + ai * HALF + m * 16; bf16_t* rowp = O + (size_t)row * ldc + col0;
                const float ri = rinv[4 * ai + m];
                float h[8];
#pragma unroll
                for (int n = 0; n < 2; ++n)
#pragma unroll
                    for (int j = 0; j < 4; ++j) { const float g = acc[ai][0][m][n][j] * ri + bv[0][n][j], up = acc[ai][1][m][n][j] * ri + bv[1][n][j]; h[4 * n + j] = g * __builtin_amdgcn_rcpf(1.0f + __builtin_amdgcn_exp2f(g * -1.4426950408889634f)) * up; }
                u32x4 w; w.x = cvt_pk_bf16(h[0], h[1]); w.y = cvt_pk_bf16(h[2], h[3]); w.z = cvt_pk_bf16(h[4], h[5]); w.w = cvt_pk_bf16(h[6], h[7]);
                *(u32x4*)rowp = w; } }
    }
};
template <bool EMIT> struct EpiResid {
    static constexpr bool PERM = false, AFTER_DRAIN = false;
    const float* resL; float* outL; const float* resC; float* outC; const float* gate; int b0, nlat;
    bf16_t* an; float* rss; const float* gsv; int remap;
    __device__ __forceinline__ void operator()(const f32x4 (&acc)[2][2][4][2], const Unit& u, int wr, int wc, int fr, int fq) const {
        const int lr0 = u.pm * BM; const bool is_ctx = lr0 >= nlat;
        const int col0 = u.pn * BM + wc * 32 + 4 * fq;
        size_t grow0; int mrow; const float* rp0; float* op0;
        if (!is_ctx) { grow0 = (size_t)b0 * 8192 + lr0; mrow = (int)(grow0 >> 13); rp0 = resL; op0 = outL; }
        else { grow0 = (size_t)b0 * 256 + (lr0 - nlat); mrow = 8; rp0 = resC; op0 = outC; }
        size_t nrow0 = (size_t)lr0;
        if (EMIT && remap) nrow0 = is_ctx ? (grow0 >> 10) * 33792 + 32768 + (grow0 & 1023) : (grow0 >> 15) * 33792 + (grow0 & 32767);
        const float* gp = gate + (size_t)mrow * 6144 + col0;
        f32x4 gv[2][2], sv[2][2];
#pragma unroll
        for (int bj = 0; bj < 2; ++bj)
#pragma unroll
            for (int n = 0; n < 2; ++n) { gv[bj][n] = *(const f32x4*)(gp + bj * HALF + n * 16); if (EMIT) sv[bj][n] = *(const f32x4*)(gsv + (size_t)mrow * 1024 + col0 + bj * HALF + n * 16); }
        f32x4 rcur[2][2], rnxt[2][2];
#define PG8_LOADR(dst, idx) do { const int rin_ = wr * 64 + fr + ((idx) >> 2) * HALF + ((idx) & 3) * 16; const size_t off_ = (grow0 + rin_) * 1024 + col0; \
            _Pragma("unroll") for (int bj = 0; bj < 2; ++bj) _Pragma("unroll") for (int n = 0; n < 2; ++n) dst[bj][n] = *(const f32x4*)(rp0 + off_ + bj * HALF + n * 16); } while (0)
        PG8_LOADR(rcur, 0);
#pragma unroll
        for (int idx = 0; idx < 8; ++idx) { const int ai = idx >> 2, m = idx & 3;
            const int rin = wr * 64 + fr + ai * HALF + m * 16; const size_t off = (grow0 + rin) * 1024 + col0; float ss = 0.f;
            if (idx + 1 < 8) PG8_LOADR(rnxt, idx + 1);
#pragma unroll
            for (int bj = 0; bj < 2; ++bj)
#pragma unroll
                for (int n = 0; n < 2; ++n) { const f32x4 o = rcur[bj][n] + gv[bj][n] * acc[ai][bj][m][n];
                    *(f32x4*)(op0 + off + bj * HALF + n * 16) = o;
                    if (EMIT) { ss += (o[0] * o[0] + o[1] * o[1]) + (o[2] * o[2] + o[3] * o[3]); const f32x4 y = o * sv[bj][n];
                        u32x2 w; w.x = cvt_pk_bf16(y[0], y[1]); w.y = cvt_pk_bf16(y[2], y[3]);
                        *(u32x2*)(an + (nrow0 + rin) * 1024 + col0 + bj * HALF + n * 16) = w; } }
            if (EMIT) { ss += __shfl_xor(ss, 16); ss += __shfl_xor(ss, 32);
                if (fq == 0) rss[(nrow0 + rin) * 16 + u.pn * 4 + wc] = ss; }
#pragma unroll
            for (int bj = 0; bj < 2; ++bj)
#pragma unroll
                for (int n = 0; n < 2; ++n) rcur[bj][n] = rnxt[bj][n];
        }
#undef PG8_LOADR
    }
};

template <class Epi, class Sched, bool STAMP = false>
__device__ __forceinline__ void gemm_phase(PG8_LAS unsigned char* lds, const Gemm g, const Sched& S, const Epi& E, unsigned long long* stamps, int wv) {
    const int tid = pg8_opaque_tid(wv), wid = __builtin_amdgcn_readfirstlane(tid >> 6), lane = tid & 63, wr = wid >> 2, wc = wid & 3, fr = lane & 15, fq = lane >> 4;
    const int K = g.K, nt = K / BK;
    int ts_lo = 0, ts_hi = 0, nts = 0; const unsigned long long rt_entry = STAMP ? (unsigned long long)wall_clock64() : 0ull;
#define PG8_STAMP() do { if (STAMP && wid == 0 && nts < 64) { const unsigned long long _c = (unsigned long long)clock64(); \
        ts_lo = (lane == nts) ? (int)(unsigned)_c : ts_lo; ts_hi = (lane == nts) ? (int)(unsigned)(_c >> 32) : ts_hi; ++nts; } } while (0)
    PG8_STAMP();
    unsigned voffA[2], voffB[2];
#pragma unroll
    for (int i = 0; i < 2; ++i) { int R, C; stage_rc(tid * 16 + i * 8192, R, C); const int Rb = Epi::PERM ? ((R & ~31) + perm32(R & 31)) : R;
        voffA[i] = (unsigned)(R * K + C) * 2u; voffB[i] = (unsigned)(Rb * K + C) * 2u; }
    const size_t kstep = (size_t)(BK * 2);
    const size_t hstep = (size_t)HALF * K * 2;
    const size_t tstep = 2 * hstep;
    const unsigned ldsw = (unsigned)wid * 1024u;
    const int aoff = lds_byte(wr * 64 + fr, fq * 8), boff = lds_byte(wc * 32 + fr, fq * 8);
#define PG8_SA(b, h) (((b) * 2 + (h)) * HTB)
#define PG8_SB(b, h) ((4 + (b) * 2 + (h)) * HTB)
#define PG8_STAGE(bufoff, gbase, voff) do { _Pragma("unroll") for (int _i = 0; _i < 2; ++_i) \
        __builtin_amdgcn_global_load_lds((const unsigned*)((const char*)(gbase) + (voff)[_i]), (PG8_LAS unsigned*)(lds + (bufoff) + ldsw + _i * 8192), 16, 0, 0); } while (0)
#define PG8_LDA(dst, b, h) do { _Pragma("unroll") for (int m = 0; m < 4; ++m) _Pragma("unroll") for (int k = 0; k < 2; ++k) dst[m][k] = *(const PG8_LAS bf16x8*)(lds + PG8_SA(b, h) + aoff + m * 2048 + k * 1024); } while (0)
#define PG8_LDB(dst, b, h) do { _Pragma("unroll") for (int n = 0; n < 2; ++n) _Pragma("unroll") for (int k = 0; k < 2; ++k) dst[n][k] = *(const PG8_LAS bf16x8*)(lds + PG8_SB(b, h) + boff + n * 2048 + k * 1024); } while (0)
#define PG8_MMA(ai, bj, At, Bt) do { __builtin_amdgcn_s_setprio(1); _Pragma("unroll") for (int m = 0; m < 4; ++m) _Pragma("unroll") for (int n = 0; n < 2; ++n) _Pragma("unroll") for (int k = 0; k < 2; ++k) \
        acc[ai][bj][m][n] = __builtin_amdgcn_mfma_f32_16x16x32_bf16(Bt[n][k], At[m][k], acc[ai][bj][m][n], 0, 0, 0); __builtin_amdgcn_s_setprio(0); } while (0)
#define PG8_WAIT_V(n) asm volatile("s_waitcnt vmcnt(" #n ")" ::: "memory")
#define PG8_WAIT_L(n) asm volatile("s_waitcnt lgkmcnt(" #n ")" ::: "memory")
#define PG8_BAR __builtin_amdgcn_s_barrier()
#define PG8_SCHED __builtin_amdgcn_sched_barrier(0)
    Unit cur, nxt; int ui = 0;
    if (!S.next(0, cur)) return;
    f32x4 acc[2][2][4][2];
#pragma unroll
    for (int a = 0; a < 2; ++a)
#pragma unroll
        for (int b = 0; b < 2; ++b)
#pragma unroll
            for (int m = 0; m < 4; ++m)
#pragma unroll
                for (int n = 0; n < 2; ++n) acc[a][b][m][n] = (f32x4){0.f, 0.f, 0.f, 0.f};
    bf16x8 At[4][2], B0[2][2], B1[2][2];
    const char* cA = (const char*)g.A + (size_t)cur.pm * tstep; const char* cB = (const char*)g.Bt + (size_t)cur.pn * tstep;
    S.a_ready(cur);
    PG8_STAGE(PG8_SB(0, 0), cB, voffB); PG8_STAGE(PG8_SA(0, 0), cA, voffA); PG8_STAGE(PG8_SB(0, 1), cB + hstep, voffB); PG8_STAGE(PG8_SA(0, 1), cA + hstep, voffA);
    if (wr == 1) PG8_BAR;
    PG8_WAIT_V(4); PG8_BAR;
    PG8_STAGE(PG8_SB(1, 0), cB + kstep, voffB); PG8_STAGE(PG8_SA(1, 0), cA + kstep, voffA); PG8_STAGE(PG8_SB(1, 1), cB + hstep + kstep, voffB);
    PG8_WAIT_V(6); PG8_BAR;
    PG8_STAMP();
    for (;;) {
        const bool has_next = S.next(ui + 1, nxt);
        const char* nA = has_next ? (const char*)g.A + (size_t)nxt.pm * tstep : cA; const char* nB = has_next ? (const char*)g.Bt + (size_t)nxt.pn * tstep : cB;
        for (int t = 0; t < nt; t += 2) {
            const bool last = (t == nt - 2);
            const char* a1 = cA + (size_t)(t + 1) * kstep;
            const char* a2 = last ? nA : cA + (size_t)(t + 2) * kstep; const char* b2 = last ? nB : cB + (size_t)(t + 2) * kstep;
            const char* a3 = a2 + kstep; const char* b3 = b2 + kstep;
            if (last && has_next) S.a_ready(nxt);
            PG8_LDB(B0, 0, 0); PG8_SCHED; PG8_LDA(At, 0, 0); PG8_STAGE(PG8_SA(1, 1), a1 + hstep, voffA);
            PG8_WAIT_L(8); PG8_BAR; PG8_WAIT_L(0); PG8_MMA(0, 0, At, B0); PG8_BAR; PG8_SCHED;
            PG8_LDB(B1, 0, 1); PG8_STAGE(PG8_SB(0, 0), b2, voffB);
            PG8_BAR; PG8_WAIT_L(0); PG8_MMA(0, 1, At, B1); PG8_BAR;
            PG8_LDA(At, 0, 1); PG8_STAGE(PG8_SA(0, 0), a2, voffA);
            PG8_BAR; PG8_WAIT_L(0); PG8_MMA(1, 0, At, B0); PG8_BAR; PG8_SCHED;
            PG8_STAGE(PG8_SB(0, 1), b2 + hstep, voffB);
            PG8_WAIT_V(6); PG8_BAR; PG8_MMA(1, 1, At, B1); PG8_BAR;
            PG8_LDB(B0, 1, 0); PG8_SCHED; PG8_LDA(At, 1, 0); PG8_STAGE(PG8_SA(0, 1), a2 + hstep, voffA);
            PG8_WAIT_L(8); PG8_BAR; PG8_WAIT_L(0); PG8_MMA(0, 0, At, B0); PG8_BAR; PG8_SCHED;
            PG8_LDB(B1, 1, 1); PG8_STAGE(PG8_SB(1, 0), b3, voffB);
            PG8_BAR; PG8_WAIT_L(0); PG8_MMA(0, 1, At, B1); PG8_BAR;
            PG8_LDA(At, 1, 1); PG8_STAGE(PG8_SA(1, 0), a3, voffA);
            PG8_BAR; PG8_WAIT_L(0); PG8_MMA(1, 0, At, B0); PG8_BAR; PG8_SCHED;
            PG8_STAGE(PG8_SB(1, 1), b3 + hstep, voffB);
            PG8_WAIT_V(6); PG8_BAR; PG8_MMA(1, 1, At, B1); PG8_BAR;
        }
        PG8_STAMP();
        if constexpr (!Epi::AFTER_DRAIN) { E(acc, cur, wr, wc, fr, fq); S.done(cur); }
        PG8_STAMP();
        if (!has_next) break;
#pragma unroll
        for (int a = 0; a < 2; ++a)
#pragma unroll
            for (int b = 0; b < 2; ++b)
#pragma unroll
                for (int m = 0; m < 4; ++m)
#pragma unroll
                    for (int n = 0; n < 2; ++n) acc[a][b][m][n] = (f32x4){0.f, 0.f, 0.f, 0.f};
        cur = nxt; cA = nA; cB = nB; ++ui;
    }
    PG8_WAIT_V(0);
    if (wr == 0) PG8_BAR;
    PG8_BAR;
    if constexpr (Epi::AFTER_DRAIN) { E.fused(acc, cur, wr, wc, fr, fq, lds, wid, lane); S.done(cur); }
    PG8_STAMP();
    if (STAMP && wid == 0) { stamps[lane] = lane < nts ? (((unsigned long long)(unsigned)ts_hi << 32) | (unsigned)ts_lo) : 0ull;
        if (lane == 62) stamps[62] = rt_entry; if (lane == 63) stamps[63] = (unsigned long long)wall_clock64(); }
#undef PG8_STAMP
#undef PG8_SA
#undef PG8_SB
#undef PG8_STAGE
#undef PG8_LDA
#undef PG8_LDB
#undef PG8_MMA
#undef PG8_WAIT_V
#undef PG8_WAIT_L
#undef PG8_BAR
#undef PG8_SCHED
}
}

using pg8::bf16_t; using pg8::bf16x8; using pg8::f32x4; using pg8::u32x4;
typedef unsigned u32x2 __attribute__((ext_vector_type(2)));
typedef float f32x2 __attribute__((ext_vector_type(2)));

constexpr int NT_LAT = 65536, NT_CTX = 2048, NT_ALL = NT_LAT + NT_CTX, DM = 1024, FF = 2816, EIN = 3328, OIN = 6144;
constexpr int NTHREADS = 512, NWAVES = 8;
constexpr int LDS_BYTES = 157696;
constexpr float EPS = 1e-6f;
constexpr int C_AQ = 0, C_AK = 512, C_AV = 640, C_BQ = 768, C_BFF = 1280, C_BFB = 1792, C_BI = 2304, C_BG = 2816;
constexpr int C_RQ = 0, C_RK = 1024, C_RV = 2048, C_RG = 4096;

constexpr size_t al256(size_t x) { return (x + 255) & ~(size_t)255; }
constexpr size_t WS_WT_EIN = 0;
constexpr size_t WS_WT_EOUT = WS_WT_EIN + al256((size_t)EIN * DM * 2);
constexpr size_t WS_WT_OIN = WS_WT_EOUT + al256((size_t)DM * DM * 2);
constexpr size_t WS_WT_OOUT = WS_WT_OIN + al256((size_t)OIN * DM * 2);
constexpr size_t WS_WT_FIN = WS_WT_OOUT + al256((size_t)DM * 2048 * 2);
constexpr size_t WS_WT_FOUT = WS_WT_FIN + al256((size_t)2 * 2 * FF * DM * 2);
constexpr size_t WS_MODS = WS_WT_FOUT + al256((size_t)2 * DM * FF * 2);
constexpr size_t WS_ROPE_AX = WS_MODS + al256((size_t)2 * 9 * 6144 * 4);
constexpr size_t WS_ROPE_RT = WS_ROPE_AX + al256((size_t)8192 * 32 * 2 * 4);
constexpr size_t WS_LB = WS_ROPE_RT + al256((size_t)8192 * 128 * 2 * 4);
constexpr size_t WS_CTXR = WS_LB + al256(512 * 4);
constexpr size_t WS_GS = WS_CTXR + al256((size_t)NT_CTX * DM * 4);
constexpr size_t WS_BIAS3 = WS_GS + al256((size_t)3 * 9 * 1024 * 4);
constexpr size_t WS_BIAS5 = WS_BIAS3 + al256((size_t)9 * 5632 * 4);
constexpr size_t WS_BIAS7 = WS_BIAS5 + al256((size_t)9 * 6144 * 4);
constexpr size_t WS_RSS_A = WS_BIAS7 + al256((size_t)9 * 5632 * 4);
constexpr size_t WS_RSS_B = WS_RSS_A + al256((size_t)NT_ALL * 64);
constexpr size_t WS_RSS_C = WS_RSS_B + al256((size_t)NT_ALL * 64);
constexpr size_t WS_BAR = WS_RSS_C + al256((size_t)NT_LAT * 64);
constexpr size_t WS_HA = WS_BAR + al256((size_t)4096 * 4);
constexpr size_t WS_OB = WS_HA + al256((size_t)NT_ALL * DM * 2);
constexpr size_t WS_BIG = WS_OB + al256((size_t)NT_ALL * 512 * 2);
constexpr size_t BIG_P1_BYTES = (size_t)33792 * OIN * 2;
constexpr size_t BIG_O_BYTES = (size_t)32768 * 2048 * 2;
constexpr size_t WS_OFW = WS_BIG + BIG_P1_BYTES;
constexpr size_t WS_OBW = WS_OFW + BIG_O_BYTES;
constexpr size_t WS_END1 = WS_OBW + BIG_O_BYTES;
constexpr size_t WS_END0 = WS_BIG + (size_t)NT_ALL * EIN * 2 + (size_t)8448 * (2 * 8192 * 2 + 128 * 4);
constexpr size_t WS_END = WS_END1 > WS_END0 ? WS_END1 : WS_END0;

DI float bf2f(unsigned short b) { return __uint_as_float(((unsigned)b) << 16); }
typedef __bf16 bfx2_t __attribute__((ext_vector_type(2)));
typedef short s16x4 __attribute__((ext_vector_type(4)));
DI unsigned short f2bf(float f) { const __bf16 h = (__bf16)f; return __builtin_bit_cast(unsigned short, h); }
DI unsigned pk2(float lo, float hi) { const f32x2 p = {lo, hi}; const bfx2_t q = __builtin_convertvector(p, bfx2_t); return __builtin_bit_cast(unsigned, q); }
DI bf16x8 tr_frag(const LAS bf16_t* X, int pitch, int t0, int c0, int lane) {
    const int i = lane & 15, g = lane >> 4;
    const LAS bf16_t* p = X + (t0 + 8 * g + (i >> 2)) * pitch + c0 + 4 * (i & 3);
    const s16x4 lo = __builtin_amdgcn_ds_read_tr16_b64_v4i16((LAS s16x4*)p);
    const s16x4 hi = __builtin_amdgcn_ds_read_tr16_b64_v4i16((LAS s16x4*)(p + 4 * pitch));
    return __builtin_shufflevector(lo, hi, 0, 1, 2, 3, 4, 5, 6, 7);
}
DI void unpack8(const bf16x8 v, float* f) {
#pragma unroll
    for (int i = 0; i < 8; ++i) f[i] = bf2f((unsigned short)v[i]);
}
DI bf16x8 pack8(const float* f) { u32x4 p; p.x = pk2(f[0], f[1]); p.y = pk2(f[2], f[3]); p.z = pk2(f[4], f[5]); p.w = pk2(f[6], f[7]); return __builtin_bit_cast(bf16x8, p); }
DI float wave_sum(float v) {
#pragma unroll
    for (int o = 1; o < 64; o <<= 1) v += __shfl_xor(v, o);
    return v;
}
DI float fexp(float x) { return __builtin_amdgcn_exp2f(x * 1.4426950408889634f); }
DI float flog(float x) { return __builtin_amdgcn_logf(x) * 0.6931471805599453f; }
DI float sigmf(float x) { return __builtin_amdgcn_rcpf(1.0f + fexp(-x)); }
DI float siluf(float x) { return x * sigmf(x); }
#define LDS_WAIT() asm volatile("s_waitcnt lgkmcnt(0)" ::: "memory")
#define MFMA16(a, b, c) __builtin_amdgcn_mfma_f32_16x16x32_bf16((a), (b), (c), 0, 0, 0)

#define XB_TMO      128
#define XB_XCNT(j)  (256  + 64 * (j))
#define XB_XSUB(j)  (1280 + 64 * (j))
#define XB_XGEN(j)  (2304 + 64 * (j))
#define XB_TOP      3328
#define XB_TOPGEN   3392
#define XCD_BAR_WORDS 3456
#define XB_SPIN_CAP (1u << 18)

__device__ __forceinline__ unsigned xb_ld(unsigned* p)              { return __hip_atomic_load(p, __ATOMIC_RELAXED, __HIP_MEMORY_SCOPE_AGENT); }
__device__ __forceinline__ unsigned xb_add(unsigned* p, unsigned v) { return __hip_atomic_fetch_add(p, v, __ATOMIC_RELAXED, __HIP_MEMORY_SCOPE_AGENT); }
__device__ __forceinline__ unsigned xb_xcc_id() { return (unsigned)__builtin_amdgcn_s_getreg((3 << 11) | 20) & 0xFu; }
#define XB_SPIN(cond, bar) do { unsigned _sp = 0; while (cond) { __builtin_amdgcn_s_sleep(1); \
    if ((++_sp & 255u) == 0u) { if (xb_ld(&(bar)[XB_TMO])) break; if (_sp > XB_SPIN_CAP) { atomicAdd(&(bar)[XB_TMO], 1u); break; } } } } while (0)

struct XcdBarrier {
    unsigned* bar; unsigned x; int wv;
    volatile LAS unsigned* st;
};

__device__ __forceinline__ XcdBarrier xcd_barrier_post(unsigned* bar, volatile LAS unsigned* st) {
    XcdBarrier b; b.bar = bar; b.x = xb_xcc_id(); b.st = st;
    if (threadIdx.x == 0) (void)xb_add(&bar[XB_XCNT(b.x)], 1u);
    return b;
}
__device__ __forceinline__ void xcd_barrier_complete(unsigned* bar, unsigned x, unsigned& nloc, unsigned& nx) {
    const unsigned G = gridDim.x * gridDim.y * gridDim.z;
    unsigned sum, cnt, mine, sp = 0u;
    for (;;) {
        sum = 0u; cnt = 0u; mine = 0u;
#pragma unroll
        for (unsigned j = 0; j < 16; ++j) { const unsigned c = xb_ld(&bar[XB_XCNT(j)]); sum += c; cnt += (c > 0u) ? 1u : 0u; mine = (j == x) ? c : mine; }
        if (sum == G) break;
        __builtin_amdgcn_s_sleep(1);
        if ((++sp & 255u) == 0u) { if (xb_ld(&bar[XB_TMO])) break; if (sp > XB_SPIN_CAP) { atomicAdd(&bar[XB_TMO], 1u); break; } }
    }
    nloc = mine > 0u ? mine : 1u; nx = cnt > 0u ? cnt : 1u;
}

__device__ __forceinline__ void xcd_barrier(const XcdBarrier& b) {
    asm volatile("s_waitcnt vmcnt(0)" ::: "memory");
    __syncthreads();
    if (b.wv == 0 && __builtin_amdgcn_mbcnt_hi(~0u, __builtin_amdgcn_mbcnt_lo(~0u, 0u)) == 0u) {
        unsigned* bar = b.bar;
        __builtin_amdgcn_s_waitcnt(0);
        unsigned nloc = b.st[0], nx = b.st[1];
        if (nloc == 0u) { xcd_barrier_complete(bar, b.x, nloc, nx); b.st[0] = nloc; b.st[1] = nx; }
        const unsigned old = xb_add(&bar[XB_XSUB(b.x)], 1u);
        const unsigned gen = old / nloc;
        if (old + 1u == (gen + 1u) * nloc) {
            __builtin_amdgcn_fence(__ATOMIC_RELEASE, "agent");
            asm volatile("s_waitcnt vmcnt(0)" ::: "memory");
            const unsigned og = xb_add(&bar[XB_TOP], 1u);
            const unsigned tg = og / nx;
            if (og + 1u == (tg + 1u) * nx) xb_add(&bar[XB_TOPGEN], 1u);
            else XB_SPIN(xb_ld(&bar[XB_TOPGEN]) == tg, bar);
            __builtin_amdgcn_fence(__ATOMIC_ACQUIRE, "agent");
            xb_add(&bar[XB_XGEN(b.x)], 1u);
            asm volatile("s_waitcnt vmcnt(0)" ::: "memory");
        } else {
            XB_SPIN(xb_ld(&bar[XB_XGEN(b.x)]) == gen, bar);
            __builtin_amdgcn_fence(__ATOMIC_ACQUIRE, "agent");
            asm volatile("s_waitcnt vmcnt(0)" ::: "memory");
        }
    }
    __syncthreads();
}

struct Args { const float* in[17]; float* out; unsigned char* ws; };

DI void transpose_item(const float* W, int K, int N, bf16_t* WT, int k0, int n0, int drow0, LAS float* scr, int lane) {
#pragma unroll 8
    for (int i = 0; i < 32; ++i) { const int kk = 2 * i + (lane >> 5); scr[kk * 33 + (lane & 31)] = W[(size_t)(k0 + kk) * N + n0 + (lane & 31)]; }
    LDS_WAIT();
    const int c = lane & 7;
#pragma unroll
    for (int j = 0; j < 4; ++j) { const int n = (lane >> 3) + 8 * j; const LAS float* s = scr + (8 * c) * 33 + n;
        u32x4 o; o.x = pk2(s[0 * 33], s[1 * 33]); o.y = pk2(s[2 * 33], s[3 * 33]); o.z = pk2(s[4 * 33], s[5 * 33]); o.w = pk2(s[6 * 33], s[7 * 33]);
        *(u32x4*)(WT + (size_t)(drow0 + n) * K + k0 + 8 * c) = o; }
    LDS_WAIT();
}
DI void transpose_matrix(const float* W, int K, int N, bf16_t* WT, bool ffn_in, int& it0, int gw, int ngw, LAS float* scr, int lane) {
    const int nblk = N / 32, nitems = (K / 64) * nblk;
    int first = (gw - it0 % ngw + ngw) % ngw;
    for (int it = first; it < nitems; it += ngw) {
        const int kb = it / nblk, nb = it % nblk, n0 = nb * 32;
        int drow0 = n0;
        if (ffn_in) { const int s = n0 / FF, j = n0 % FF, p = j / 128, jj = j % 128; drow0 = 256 * p + 128 * s + jj; }
        transpose_item(W, K, N, WT, kb * 64, n0, drow0, scr, lane);
    }
    it0 += nitems;
}

DI void mods_phase(int wv, const Args& a, float* mods, LAS unsigned char* lds) {
    const int tid = pg8::pg8_opaque_tid(wv);
    LAS float* sc = (LAS float*)lds;
    LAS float* red = (LAS float*)(lds + 9 * 1024 * 4);
    if ((int)blockIdx.x >= 192) return;
    for (int i = tid; i < 9 * 1024; i += NTHREADS) { const int r = i >> 10, k = i & 1023; const float v = r < 8 ? a.in[1][r * 1024 + k] : a.in[3][k]; sc[i] = siluf(v); }
    __syncthreads();
    for (int it = blockIdx.x; it < 192; it += gridDim.x) {
        const int l = it / 96, n0 = (it % 96) * 64, nl = tid & 63, kp = tid >> 6;
        const float* w = a.in[4] + (size_t)l * 1024 * 6144 + n0 + nl;
        float acc[9];
#pragma unroll
        for (int r = 0; r < 9; ++r) acc[r] = 0.f;
        for (int k = kp * 128; k < kp * 128 + 128; ++k) { const float wv = w[(size_t)k * 6144];
#pragma unroll
            for (int r = 0; r < 9; ++r) acc[r] += sc[r * 1024 + k] * wv; }
#pragma unroll
        for (int r = 0; r < 9; ++r) red[(kp * 9 + r) * 64 + nl] = acc[r];
        __syncthreads();
        for (int i = tid; i < 576; i += NTHREADS) { const int r = i >> 6, n = i & 63; float s = 0.f;
#pragma unroll
            for (int p = 0; p < 8; ++p) s += red[(p * 9 + r) * 64 + n];
            mods[(size_t)(l * 9 + r) * 6144 + n0 + n] = s + a.in[5][l * 6144 + n0 + n]; }
        __syncthreads();
    }
}

DI void tables_phase(int wv, const Args& a, float* ax, float* rt, float* lb, float* rss, int nrss) {
    const int gt = blockIdx.x * NTHREADS + pg8::pg8_opaque_tid(wv), ngt = gridDim.x * NTHREADS;

    for (int i = gt; i < 8192 * 32; i += ngt) { const int t = i >> 5, j = i & 31; const double p = (j < 16) ? (double)(t >> 6) : (double)(t & 63);
        const double inv = pow(10000.0, -(double)(j & 15) / 16.0); const double ang = p * inv;
        ax[i] = (float)cos(ang); ax[8192 * 32 + i] = (float)sin(ang); }
    for (int i = gt; i < 8192 * 128; i += ngt) { const int t = i >> 7, j = i & 127; const double th = pow(10000.0, -(double)j / 127.0); const double ang = (double)t * th;
        rt[i] = (float)cos(ang); rt[8192 * 128 + i] = (float)sin(ang); }
    for (int i = gt; i < 512; i += ngt) { const float a0 = a.in[14][i], a1 = a.in[14][512 + i]; lb[i] = 1.0f / (1.0f + expf(a1 - a0)); }
}


DI void aux_phase(int wv, const float* normg, const float* mods, const bf16_t* wt_fin, const bf16_t* wt_oin, float* gs, float* bias3, float* bias5, float* bias7) {
    const int tid = pg8::pg8_opaque_tid(wv), lane = tid & 63, wave = __builtin_amdgcn_readfirstlane(tid >> 6);
    const int gt = blockIdx.x * NTHREADS + tid, ngt = gridDim.x * NTHREADS;
    for (int i = gt; i < 3 * 9 * 1024; i += ngt) { const int tb = i / 9216, r = (i / 1024) % 9, c = i & 1023;
        const float g = normg[(tb == 0 ? 1024 : (tb == 1 ? 2048 : 3072)) + c];
        const float sc = mods[(size_t)((tb == 0 ? 0 : 9) + r) * 6144 + (tb == 1 ? 1 : 4) * 1024 + c];
        gs[i] = g * (1.0f + sc); }
    const int gw = blockIdx.x * NWAVES + wave, ngw = gridDim.x * NWAVES;
    for (int it = gw; it < 5632 + 6144 + 5632; it += ngw) {
        const bf16_t* wrow; const float* sh; float* dst; int ldb, n;
        if (it < 5632) { n = it; wrow = wt_fin + (size_t)n * 1024; sh = mods + 3 * 1024; dst = bias3; ldb = 5632; }
        else if (it < 5632 + 6144) { n = it - 5632; wrow = wt_oin + (size_t)n * 1024; sh = mods + 9 * 6144; dst = bias5; ldb = 6144; }
        else { n = it - 5632 - 6144; wrow = wt_fin + (size_t)2 * FF * DM + (size_t)n * 1024; sh = mods + 9 * 6144 + 3 * 1024; dst = bias7; ldb = 5632; }
        float w[16]; unpack8(*(const bf16x8*)(wrow + 16 * lane), w); unpack8(*(const bf16x8*)(wrow + 16 * lane + 8), w + 8);
        float keep = 0.f;
#pragma unroll
        for (int r = 0; r < 9; ++r) { const float* sp = sh + (size_t)r * 6144 + 16 * lane; float s = 0.f;
#pragma unroll
            for (int q = 0; q < 4; ++q) { const f32x4 v = *(const f32x4*)(sp + 4 * q); s += (v.x * w[4 * q] + v.y * w[4 * q + 1]) + (v.z * w[4 * q + 2] + v.w * w[4 * q + 3]); }
            s = wave_sum(s); if (lane == r) keep = s; }
        if (lane < 9) dst[(size_t)lane * ldb + n] = keep;
    }
}

DI void normmod_phase(int wv, const float* xlat, const float* xctx, int b0, int nlat, int nrows, const float* g, const float* mods, int sidx, bf16_t* out) {
    const int tid = pg8::pg8_opaque_tid(wv), lane = tid & 63, wave = __builtin_amdgcn_readfirstlane(tid >> 6);
    const int gw = blockIdx.x * NWAVES + wave, ngw = gridDim.x * NWAVES;
    f32x4 gv[4];
#pragma unroll
    for (int j = 0; j < 4; ++j) gv[j] = *(const f32x4*)(g + 4 * lane + 256 * j);
    for (int lr0 = gw * 2; lr0 < nrows; lr0 += ngw * 2) {
        f32x4 v[2][4]; int mrow[2];
#pragma unroll
        for (int u = 0; u < 2; ++u) { const int lr = lr0 + u; const float* src;
            if (lr < nlat) { const size_t grow = (size_t)b0 * 8192 + lr; src = xlat + grow * 1024; mrow[u] = (int)(grow >> 13); }
            else { const size_t crow = (size_t)b0 * 256 + (lr - nlat); src = xctx + crow * 1024; mrow[u] = 8; }
#pragma unroll
            for (int j = 0; j < 4; ++j) v[u][j] = *(const f32x4*)(src + 4 * lane + 256 * j); }
#pragma unroll
        for (int u = 0; u < 2; ++u) { const int lr = lr0 + u; float ss = 0.f;
#pragma unroll
            for (int j = 0; j < 4; ++j) ss += (v[u][j].x * v[u][j].x + v[u][j].y * v[u][j].y) + (v[u][j].z * v[u][j].z + v[u][j].w * v[u][j].w);
            const float r = rsqrtf(wave_sum(ss) * (1.0f / 1024.0f) + EPS);
            const float* sh = mods + (size_t)mrow[u] * 6144 + sidx * 1024; const float* scl = sh + 1024;
#pragma unroll
            for (int j = 0; j < 4; ++j) { const f32x4 s4 = *(const f32x4*)(sh + 4 * lane + 256 * j), c4 = *(const f32x4*)(scl + 4 * lane + 256 * j);
                const f32x4 y = v[u][j] * r * gv[j] * (c4 + 1.0f) + s4;
                u32x2 w; w.x = pk2(y.x, y.y); w.y = pk2(y.z, y.w);
                *(u32x2*)(out + (size_t)lr * 1024 + 4 * lane + 256 * j) = w; } }
    }
}

DI void attn_phase(int wv, const bf16_t* P, bf16_t* mix, const float* qkg, const float* sink, const float* axc, const float* axs, LAS unsigned char* lds) {
    const int tid = pg8::pg8_opaque_tid(wv), lane = tid & 63, wave = __builtin_amdgcn_readfirstlane(tid >> 6);
    const int fr = lane & 15, fq = lane >> 4, g = wave & 3, half = wave >> 2;
    LAS bf16_t* Ks = (LAS bf16_t*)lds; LAS bf16_t* Vl = (LAS bf16_t*)(lds + 46080); LAS bf16_t* Pw = (LAS bf16_t*)(lds + 92160 + wave * 4608);
    for (int it = blockIdx.x; it < 2112; it += gridDim.x) {
        const int qt = it % 132; const int r = it / 132; const int kvh = r & 1, b = r >> 1; const int hq = kvh * 4 + g;
        const bool cq = qt >= 128;
        const int q0 = cq ? (qt - 128) * 64 : qt * 64;
        const size_t qrow0 = cq ? (size_t)NT_LAT + b * 256 + q0 : (size_t)b * 8192 + q0;
        bf16x8 aq[2][2];
#pragma unroll
        for (int mi = 0; mi < 2; ++mi) {
            const int rloc = 32 * half + 16 * mi + fr; const bf16_t* qp = P + (qrow0 + rloc) * EIN + C_AQ + hq * 64;
            float x1[8], x2[8]; unpack8(*(const bf16x8*)(qp + 8 * fq), x1); unpack8(*(const bf16x8*)(qp + 32 + 8 * fq), x2);
            float ss = 0.f;
#pragma unroll
            for (int i = 0; i < 8; ++i) ss += x1[i] * x1[i] + x2[i] * x2[i];
            ss += __shfl_xor(ss, 16); ss += __shfl_xor(ss, 32);
            const float rn = rsqrtf(ss * (1.0f / 64.0f) + EPS);
#pragma unroll
            for (int i = 0; i < 8; ++i) { x1[i] *= rn * qkg[8 * fq + i]; x2[i] *= rn * qkg[32 + 8 * fq + i]; }
            if (!cq) { const int pos = q0 + rloc; const float* cp = axc + pos * 32 + 8 * fq; const float* sp = axs + pos * 32 + 8 * fq;
#pragma unroll
                for (int i = 0; i < 8; ++i) { const float c = cp[i], s = sp[i]; const float o1 = x1[i] * c - x2[i] * s, o2 = x2[i] * c + x1[i] * s; x1[i] = o1; x2[i] = o2; } }
            aq[mi][0] = pack8(x1); aq[mi][1] = pack8(x2); }
        float m_[2], l_[2]; f32x4 oacc[2][4];
        const float sk = sink[hq] * 1.4426950408889634f;
#pragma unroll
        for (int mi = 0; mi < 2; ++mi) { m_[mi] = sk; l_[mi] = 1.0f;
#pragma unroll
            for (int i = 0; i < 4; ++i) oacc[mi][i] = (f32x4){0.f, 0.f, 0.f, 0.f}; }
        for (int round = cq ? 1 : 0; round < 2; ++round) {
            const bool kc = round == 1;
            int kstart, nkeys; size_t krow0;
            if (!kc) { kstart = q0 - 128 < 0 ? 0 : q0 - 128; const int kend = q0 + 192 > 8192 ? 8192 : q0 + 192; nkeys = kend - kstart; krow0 = (size_t)b * 8192 + kstart; }
            else { kstart = 0; nkeys = 256; krow0 = (size_t)NT_LAT + b * 256; }
            __syncthreads();
            for (int task = tid; task < nkeys * 4; task += NTHREADS) {
                const int key = task >> 2, c = task & 3; const bf16_t* kp = P + (krow0 + key) * EIN + C_AK + kvh * 64;
                float x1[8], x2[8]; unpack8(*(const bf16x8*)(kp + 8 * c), x1); unpack8(*(const bf16x8*)(kp + 32 + 8 * c), x2);
                float ss = 0.f;
#pragma unroll
                for (int i = 0; i < 8; ++i) ss += x1[i] * x1[i] + x2[i] * x2[i];
                ss += __shfl_xor(ss, 1); ss += __shfl_xor(ss, 2);
                const float rn = rsqrtf(ss * (1.0f / 64.0f) + EPS);
#pragma unroll
                for (int i = 0; i < 8; ++i) { x1[i] *= rn * qkg[64 + 8 * c + i]; x2[i] *= rn * qkg[64 + 32 + 8 * c + i]; }
                if (!kc) { const int pos = kstart + key; const float* cp = axc + pos * 32 + 8 * c; const float* sp = axs + pos * 32 + 8 * c;
#pragma unroll
                    for (int i = 0; i < 8; ++i) { const float cs = cp[i], sn = sp[i]; const float o1 = x1[i] * cs - x2[i] * sn, o2 = x2[i] * cs + x1[i] * sn; x1[i] = o1; x2[i] = o2; } }
                *(LAS bf16x8*)(Ks + key * 72 + 8 * c) = pack8(x1); *(LAS bf16x8*)(Ks + key * 72 + 32 + 8 * c) = pack8(x2);
            }
            for (int task = tid; task < nkeys * 8; task += NTHREADS) { const int key = task >> 3, c = task & 7;
                *(LAS bf16x8*)(Vl + key * 72 + 8 * c) = *(const bf16x8*)(P + (krow0 + key) * EIN + C_AV + kvh * 64 + 8 * c); }
            __syncthreads();
            for (int kb = 0; kb < (nkeys >> 6); ++kb) {
                const int kpos0 = kstart + 64 * kb;
                if (!kc) { const int rlo = q0 + 32 * half; if (kpos0 + 64 <= rlo - 128 || kpos0 > rlo + 31 + 128) continue; }
                f32x4 sacc[2][4];
#pragma unroll
                for (int n = 0; n < 4; ++n) { sacc[0][n] = (f32x4){0.f, 0.f, 0.f, 0.f}; sacc[1][n] = sacc[0][n];
#pragma unroll
                    for (int ks = 0; ks < 2; ++ks) { const bf16x8 bk = *(const LAS bf16x8*)(Ks + (64 * kb + 16 * n + fr) * 72 + ks * 32 + 8 * fq);
                        sacc[0][n] = MFMA16(bk, aq[0][ks], sacc[0][n]); sacc[1][n] = MFMA16(bk, aq[1][ks], sacc[1][n]); } }
                bf16x8 pf[2][2];
#pragma unroll
                for (int mi = 0; mi < 2; ++mi) {
                    const int qpos = q0 + 32 * half + 16 * mi + fr;
                    float mx = -INFINITY;
#pragma unroll
                    for (int n = 0; n < 4; ++n)
#pragma unroll
                        for (int i = 0; i < 4; ++i) { float s = sacc[mi][n][i] * 0.18033688011112042f;
                            if (!kc) { const int dlt = (kpos0 + 16 * n + 4 * fq + i) - qpos; if (dlt > 128 || dlt < -128) s = -INFINITY; }
                            sacc[mi][n][i] = s; mx = fmaxf(mx, s); }
                    mx = fmaxf(mx, __shfl_xor(mx, 16)); mx = fmaxf(mx, __shfl_xor(mx, 32));
                    const float mn = fmaxf(m_[mi], mx); const float alpha = __builtin_amdgcn_exp2f(m_[mi] - mn); m_[mi] = mn; float rs = 0.f;
#pragma unroll
                    for (int n = 0; n < 4; ++n)
#pragma unroll
                        for (int i = 0; i < 4; ++i) { const float p = __builtin_amdgcn_exp2f(sacc[mi][n][i] - mn); sacc[mi][n][i] = p; rs += p; }
                    rs += __shfl_xor(rs, 16); rs += __shfl_xor(rs, 32);
                    l_[mi] = l_[mi] * alpha + rs;
#pragma unroll
                    for (int nd = 0; nd < 4; ++nd) oacc[mi][nd] *= alpha;
#pragma unroll
                    for (int k2 = 0; k2 < 2; ++k2) { u32x4 w; w.x = pk2(sacc[mi][2 * k2][0], sacc[mi][2 * k2][1]); w.y = pk2(sacc[mi][2 * k2][2], sacc[mi][2 * k2][3]);
                        w.z = pk2(sacc[mi][2 * k2 + 1][0], sacc[mi][2 * k2 + 1][1]); w.w = pk2(sacc[mi][2 * k2 + 1][2], sacc[mi][2 * k2 + 1][3]); pf[mi][k2] = __builtin_bit_cast(bf16x8, w); }
                }
#pragma unroll
                for (int k2 = 0; k2 < 2; ++k2)
#pragma unroll
                    for (int nd = 0; nd < 4; ++nd) {
                        const LAS bf16_t* vp = Vl + (64 * kb + 32 * k2 + 4 * fq + (fr >> 2)) * 72 + 16 * nd + 4 * (fr & 3);
                        const s16x4 lo = __builtin_amdgcn_ds_read_tr16_b64_v4i16((LAS s16x4*)vp), hi = __builtin_amdgcn_ds_read_tr16_b64_v4i16((LAS s16x4*)(vp + 16 * 72));
                        const bf16x8 vf = __builtin_shufflevector(lo, hi, 0, 1, 2, 3, 4, 5, 6, 7);
                        oacc[0][nd] = MFMA16(vf, pf[0][k2], oacc[0][nd]); oacc[1][nd] = MFMA16(vf, pf[1][k2], oacc[1][nd]); }
            }
        }
#pragma unroll
        for (int mi = 0; mi < 2; ++mi) { const float inv = 1.0f / l_[mi]; bf16_t* op = mix + (qrow0 + 32 * half + 16 * mi + fr) * 1024 + hq * 64 + 4 * fq;
#pragma unroll
            for (int nd = 0; nd < 4; ++nd) { const f32x4 r = oacc[mi][nd] * inv; u32x2 w; w.x = pk2(r[0], r[1]); w.y = pk2(r[2], r[3]); *(u32x2*)(op + 16 * nd) = w; } }
    }
}

#define HG_ROW0(n_) ((n_) < 4 ? (size_t)NT_LAT + b * 256 + (dir ? 3 - (n_) : (n_)) * 64 : (size_t)b * 8192 + (dir ? 127 - ((n_) - 4) : (n_) - 4) * 64)
constexpr int HP_QI = 0, HP_QO = 17408, HP_KI = 34816, HP_KP = 52224, HP_V = 69632, HP_PM = 87040, HP_RED = 96256;
DI void hgrn_prep_phase(int wv, const bf16_t* P, bf16_t* mix, bf16_t* ob, const float* lb, bf16_t* sq, bf16_t* sk, float* sd, LAS unsigned char* lds) {
    const int tid = pg8::pg8_opaque_tid(wv), lane = tid & 63, wave = __builtin_amdgcn_readfirstlane(tid >> 6);
    const int fr = lane & 15, fq = lane >> 4;
    LAS bf16_t* Qi = (LAS bf16_t*)(lds + HP_QI); LAS bf16_t* Qo = (LAS bf16_t*)(lds + HP_QO); LAS bf16_t* Ki = (LAS bf16_t*)(lds + HP_KI); LAS bf16_t* Kp = (LAS bf16_t*)(lds + HP_KP);
    LAS bf16_t* Vl = (LAS bf16_t*)(lds + HP_V); LAS bf16_t* Pm = (LAS bf16_t*)(lds + HP_PM); LAS float* red = (LAS float*)(lds + HP_RED);
    const int d = tid & 127, part = tid >> 7, vt = tid >> 3, vc = tid & 7;
    unsigned short fraw[16], qraw[16]; bf16x8 vr0, vr1;
#define HP_LOAD(it_) do { const int n_ = (it_) % 132; const int u_ = (it_) / 132; const int dir = u_ & 1, h = (u_ >> 1) & 3, b = u_ >> 3; const size_t r0_ = HG_ROW0(n_); \
        const int cf_ = (dir ? C_BFB : C_BFF) + h * 128 + d, cq_ = C_BQ + h * 128 + d; \
        _Pragma("unroll") for (int i = 0; i < 16; ++i) { const int t = 16 * part + i; const int tok = dir ? 63 - t : t; const bf16_t* rp = P + (r0_ + tok) * EIN; fraw[i] = rp[cf_]; qraw[i] = rp[cq_]; } \
        { const int tok = dir ? 63 - vt : vt; const bf16_t* vp = P + (r0_ + tok) * EIN + C_BI + h * 128 + 8 * vc; vr0 = *(const bf16x8*)vp; vr1 = *(const bf16x8*)(vp + 64); } } while (0)
    if ((int)blockIdx.x < 8448) HP_LOAD(8447 - (int)blockIdx.x);
    for (int itf = blockIdx.x; itf < 8448; itf += gridDim.x) { const int it = 8447 - itf;
        const int n = it % 132; const int u3 = it / 132; const int dir = u3 & 1, h = (u3 >> 1) & 3, b = u3 >> 3;
        const size_t row0 = HG_ROW0(n);
        const float lbv = lb[h * 128 + d];
        float lf[16], kk[16], qs[16];
#pragma unroll
        for (int i = 0; i < 16; ++i) { const float fr_ = bf2f(fraw[i]), qr = bf2f(qraw[i]); const float f = lbv + (1.0f - lbv) * sigmf(fr_);
            lf[i] = flog(f); kk[i] = 1.0f - f; qs[i] = siluf(qr); }
#pragma unroll
        for (int i = 1; i < 16; ++i) lf[i] += lf[i - 1];
        const bf16x8 vc0 = vr0, vc1 = vr1;
        if (itf + (int)gridDim.x < 8448) HP_LOAD(8447 - (itf + (int)gridDim.x));
        __syncthreads();
        red[part * 128 + d] = lf[15]; if (part == 2) red[512 + d] = lf[0];
        *(LAS bf16x8*)(Vl + vt * 136 + 8 * vc) = vc0; *(LAS bf16x8*)(Vl + vt * 136 + 8 * vc + 64) = vc1;
        __syncthreads();
        {   const float r0 = red[d], r1 = red[128 + d], r2 = red[256 + d], r3 = red[384 + d], l32 = red[512 + d];
            const float pre = part == 0 ? 0.f : (part == 1 ? r0 : (part == 2 ? r0 + r1 : r0 + r1 + r2));
            const float total = (r0 + r1) + (r2 + r3), ref = r0 + r1 + l32;
            const float eref = fexp(ref), etr = fexp(total - ref);
            if (part == 0) sd[(size_t)it * 128 + d] = fexp(total);
            float kp[16];
#pragma unroll
            for (int i = 0; i < 16; ++i) { const float cum = pre + lf[i]; const int t = 16 * part + i;
                const float e1 = fexp(cum - ref), e2 = __builtin_amdgcn_rcpf(e1); const float qe = qs[i] * e1, ke = kk[i] * e2;
                Qi[t * 136 + d] = f2bf(qe); Qo[t * 136 + d] = f2bf(qe * eref); Ki[t * 136 + d] = f2bf(ke); kp[i] = ke * etr; }
            bf16_t* gk = sk + (size_t)it * 8192 + d * 64 + 16 * part;
            *(bf16x8*)gk = pack8(kp); *(bf16x8*)(gk + 8) = pack8(kp + 8); }
        __syncthreads();
        {   bf16_t* gq = sq + (size_t)it * 8192 + vt * 128 + 8 * vc;
            *(bf16x8*)gq = *(const LAS bf16x8*)(Qo + vt * 136 + 8 * vc); *(bf16x8*)(gq + 64) = *(const LAS bf16x8*)(Qo + vt * 136 + 8 * vc + 64); }
        {   const int mt = wave >> 1, nt0 = 2 * (wave & 1); f32x4 sc[2]; sc[0] = (f32x4){0.f, 0.f, 0.f, 0.f}; sc[1] = sc[0];
#pragma unroll
            for (int ks = 0; ks < 4; ++ks) { const bf16x8 a = *(const LAS bf16x8*)(Qi + (16 * mt + fr) * 136 + ks * 32 + 8 * fq);
#pragma unroll
                for (int n2 = 0; n2 < 2; ++n2) { const bf16x8 bb = *(const LAS bf16x8*)(Ki + (16 * (nt0 + n2) + fr) * 136 + ks * 32 + 8 * fq); sc[n2] = MFMA16(a, bb, sc[n2]); } }
#pragma unroll
            for (int n2 = 0; n2 < 2; ++n2)
#pragma unroll
                for (int i = 0; i < 4; ++i) { const int t = 16 * mt + 4 * fq + i, s = 16 * (nt0 + n2) + fr; Pm[t * 72 + s] = f2bf(s <= t ? sc[n2][i] : 0.f); } }
        __syncthreads();
        {   const int mt = wave >> 1, nq = 4 * (wave & 1); f32x4 o[4];
#pragma unroll
            for (int j = 0; j < 4; ++j) o[j] = (f32x4){0.f, 0.f, 0.f, 0.f};
#pragma unroll
            for (int ks = 0; ks < 2; ++ks) { const bf16x8 a = *(const LAS bf16x8*)(Pm + (16 * mt + fr) * 72 + ks * 32 + 8 * fq);
#pragma unroll
                for (int j = 0; j < 4; ++j) { const bf16x8 bb = tr_frag(Vl, 136, 32 * ks, 16 * (nq + j), lane); o[j] = MFMA16(bb, a, o[j]); } }
            {   const int t = 16 * mt + fr; const int tok = dir ? 63 - t : t;
                bf16_t* op = dir ? ob + (row0 + tok) * 512 + h * 128 + 16 * nq + 4 * fq : mix + (row0 + tok) * 1024 + 512 + h * 128 + 16 * nq + 4 * fq;
#pragma unroll
                for (int j = 0; j < 4; ++j) { u32x2 w; w.x = pk2(o[j][0], o[j][1]); w.y = pk2(o[j][2], o[j][3]); *(u32x2*)(op + 16 * j) = w; } } }
    }
}
constexpr int HS_V = 0, HS_ST = 5120;
DI void hgrn_scan_phase(int wv, const bf16_t* P, bf16_t* mix, bf16_t* ob, const bf16_t* sq, const bf16_t* sk, const float* sd, LAS unsigned char* lds) {
    const int tid = pg8::pg8_opaque_tid(wv), lane = tid & 63, wave = __builtin_amdgcn_readfirstlane(tid >> 6);
    const int fr = lane & 15, fq = lane >> 4;
    LAS bf16_t* Vl = (LAS bf16_t*)(lds + HS_V); LAS bf16_t* St = (LAS bf16_t*)(lds + HS_ST);
    const int vt = tid >> 2, vc = tid & 3, mt = wave >> 1, nt = wave & 1;
    for (int unit = blockIdx.x; unit < 256; unit += gridDim.x) {
        const int gx = (unit & 7) * 8 + (unit >> 5), sl = (unit >> 3) & 3, dir = gx & 1, h = (gx >> 1) & 3, b = gx >> 3;
        const size_t item0 = (size_t)(((b * 4 + h) * 2 + dir) * 132);
        __syncthreads();
        for (int i = tid; i < 8704 / 4; i += NTHREADS) ((LAS unsigned*)(lds + HS_ST))[i] = 0u;
        f32x4 sacc[2]; sacc[0] = (f32x4){0.f, 0.f, 0.f, 0.f}; sacc[1] = sacc[0];
        bf16x8 aq[2][4], ak[2][2], vv[2]; f32x4 dv[2]; u32x2 oold[2];
        vv[0] = (bf16x8){0, 0, 0, 0, 0, 0, 0, 0}; vv[1] = vv[0];
        const int otok = dir ? 63 - (16 * mt + fr) : 16 * mt + fr;
        bf16_t* obase = dir ? ob + (size_t)otok * 512 + h * 128 + sl * 32 + 16 * nt + 4 * fq : mix + (size_t)otok * 1024 + 512 + h * 128 + sl * 32 + 16 * nt + 4 * fq;
        const int ostr = dir ? 512 : 1024;
#define HS_LOAD(s_, n_) do { const size_t it_ = item0 + (n_); const size_t r0_ = HG_ROW0(n_); \
            const bf16_t* gq = sq + it_ * 8192 + (16 * mt + fr) * 128 + 8 * fq; const bf16_t* gk = sk + it_ * 8192 + (16 * wave + fr) * 64 + 8 * fq; \
            _Pragma("unroll") for (int ks = 0; ks < 4; ++ks) aq[s_][ks] = *(const bf16x8*)(gq + 32 * ks); \
            ak[s_][0] = *(const bf16x8*)gk; ak[s_][1] = *(const bf16x8*)(gk + 32); \
            if (tid < 256) { const int tok = dir ? 63 - vt : vt; vv[s_] = *(const bf16x8*)(P + (r0_ + tok) * EIN + C_BI + h * 128 + sl * 32 + 8 * vc); } \
            dv[s_] = *(const f32x4*)(sd + it_ * 128 + 16 * wave + 4 * fq); \
            oold[s_] = *(const u32x2*)(obase + r0_ * ostr); } while (0)
        HS_LOAD(0, 0); HS_LOAD(1, 1);
        for (int n0 = 0; n0 < 132; n0 += 2) {
#pragma unroll
          for (int s = 0; s < 2; ++s) {
            const int n = n0 + s;
            const size_t row0 = HG_ROW0(n);
            if (tid < 256) *(LAS bf16x8*)(Vl + vt * 40 + 8 * vc) = vv[s];
            bf16x8 a4[4], k2[2]; f32x4 o, d4 = dv[s];
#pragma unroll
            for (int ks = 0; ks < 4; ++ks) a4[ks] = aq[s][ks];
            k2[0] = ak[s][0]; k2[1] = ak[s][1];
            o[0] = __uint_as_float(oold[s].x << 16); o[1] = __uint_as_float(oold[s].x & 0xffff0000u); o[2] = __uint_as_float(oold[s].y << 16); o[3] = __uint_as_float(oold[s].y & 0xffff0000u);
            if (n + 2 < 132) HS_LOAD(s, n + 2);
            __syncthreads();
            {
#pragma unroll
                for (int ks = 0; ks < 4; ++ks) { const bf16x8 bb = *(const LAS bf16x8*)(St + (16 * nt + fr) * 136 + ks * 32 + 8 * fq); o = MFMA16(bb, a4[ks], o); }
                u32x2 w; w.x = pk2(o[0], o[1]); w.y = pk2(o[2], o[3]); *(u32x2*)(obase + row0 * ostr) = w; }
            {   sacc[0] *= d4; sacc[1] *= d4;
#pragma unroll
                for (int ks = 0; ks < 2; ++ks) {
#pragma unroll
                    for (int et = 0; et < 2; ++et) { const bf16x8 bb = tr_frag(Vl, 40, 32 * ks, 16 * et, lane); sacc[et] = MFMA16(k2[ks], bb, sacc[et]); } } }
            __syncthreads();
#pragma unroll
            for (int et = 0; et < 2; ++et) { u32x2 w; w.x = pk2(sacc[et][0], sacc[et][1]); w.y = pk2(sacc[et][2], sacc[et][3]);
                *(LAS u32x2*)(St + (16 * et + fr) * 136 + 16 * wave + 4 * fq) = w; }
          }
        }
#undef HS_LOAD
    }
}
#undef HP_LOAD
#undef HG_ROW0
DI void hgrn_norm_phase(int wv, const bf16_t* P, bf16_t* mix, const bf16_t* ob, const float* outg) {
    const int tid = pg8::pg8_opaque_tid(wv), lane = tid & 63, wave = __builtin_amdgcn_readfirstlane(tid >> 6);
    const int gw = blockIdx.x * NWAVES + wave, ngw = gridDim.x * NWAVES;
    float gv[8];
#pragma unroll
    for (int i = 0; i < 8; ++i) gv[i] = outg[8 * (lane & 15) + i];
    for (int row0 = gw * 4; row0 < NT_ALL; row0 += ngw * 4) {
        bf16x8 a[4], b[4], g[4];
#pragma unroll
        for (int u = 0; u < 4; ++u) { const size_t row = (size_t)row0 + u;
            a[u] = *(const bf16x8*)(mix + row * 1024 + 512 + 8 * lane); b[u] = *(const bf16x8*)(ob + row * 512 + 8 * lane); g[u] = *(const bf16x8*)(P + row * EIN + C_BG + 8 * lane); }
#pragma unroll
        for (int u = 0; u < 4; ++u) { const size_t row = (size_t)row0 + u;
            float of[8], o2[8], gg[8]; unpack8(a[u], of); unpack8(b[u], o2); unpack8(g[u], gg);
            float ss = 0.f;
#pragma unroll
            for (int i = 0; i < 8; ++i) { of[i] += o2[i]; ss += of[i] * of[i]; }
            ss += __shfl_xor(ss, 1); ss += __shfl_xor(ss, 2); ss += __shfl_xor(ss, 4); ss += __shfl_xor(ss, 8);
            const float rn = rsqrtf(ss * (1.0f / 128.0f) + EPS);
#pragma unroll
            for (int i = 0; i < 8; ++i) of[i] = of[i] * rn * gv[i] * siluf(gg[i]);
            *(bf16x8*)(mix + row * 1024 + 512 + 8 * lane) = pack8(of); }
    }
}

constexpr int RI_Q = 0, RI_K = 33792, RI_V = 67584, RI_PM = 134144;
DI void ret_intra_phase(int wv, const bf16_t* P1, bf16_t* ofw, LAS unsigned char* lds) {
    const int tid = pg8::pg8_opaque_tid(wv), lane = tid & 63, wave = __builtin_amdgcn_readfirstlane(tid >> 6);
    const int fr = lane & 15, fq = lane >> 4;
    LAS bf16_t* Q = (LAS bf16_t*)(lds + RI_Q); LAS bf16_t* K = (LAS bf16_t*)(lds + RI_K); LAS bf16_t* Vl = (LAS bf16_t*)(lds + RI_V); LAS bf16_t* Pm = (LAS bf16_t*)(lds + RI_PM);
    const int pt = tid >> 3, pc = tid & 7;
    bf16x8 qv[4], kv[4], vv[8];
#define RI_LOAD(it_) do { const int h_ = ((it_) >> 7) & 3; const bf16_t* rp_ = P1 + ((size_t)((it_) >> 9) * 8192 + ((it_) & 127) * 64 + pt) * OIN; \
        _Pragma("unroll") for (int j = 0; j < 4; ++j) { qv[j] = *(const bf16x8*)(rp_ + C_RQ + h_ * 256 + 64 * j + 8 * pc); kv[j] = *(const bf16x8*)(rp_ + C_RK + h_ * 256 + 64 * j + 8 * pc); } \
        _Pragma("unroll") for (int j = 0; j < 8; ++j) vv[j] = *(const bf16x8*)(rp_ + C_RV + h_ * 512 + 8 * pc + 64 * j); } while (0)
    if ((int)blockIdx.x < 2048) RI_LOAD(2047 - (int)blockIdx.x);
    for (int itf = blockIdx.x; itf < 2048; itf += gridDim.x) { const int it = 2047 - itf;
        const int cc = it & 127, h = (it >> 7) & 3, bl = it >> 9;
        const float lgf = log2f(1.0f - exp2f(-5.0f - (float)h)), lgb = log2f(1.0f - exp2f(-5.0f - (float)(3 - h)));
        const size_t row0 = (size_t)bl * 8192 + cc * 64;
        __syncthreads();
#pragma unroll
        for (int j = 0; j < 4; ++j) { *(LAS bf16x8*)(Q + pt * 264 + 64 * j + 8 * pc) = qv[j]; *(LAS bf16x8*)(K + pt * 264 + 64 * j + 8 * pc) = kv[j]; }
#pragma unroll
        for (int j = 0; j < 8; ++j) *(LAS bf16x8*)(Vl + pt * 520 + 8 * pc + 64 * j) = vv[j];
        if (itf + (int)gridDim.x < 2048) RI_LOAD(2047 - (itf + (int)gridDim.x));
        __syncthreads();
        {   const int mt = wave >> 1, nt0 = 2 * (wave & 1); f32x4 sc[2]; sc[0] = (f32x4){0.f, 0.f, 0.f, 0.f}; sc[1] = sc[0];
#pragma unroll
            for (int ks = 0; ks < 8; ++ks) { const bf16x8 a = *(const LAS bf16x8*)(Q + (16 * mt + fr) * 264 + ks * 32 + 8 * fq);
#pragma unroll
                for (int n2 = 0; n2 < 2; ++n2) { const bf16x8 bb = *(const LAS bf16x8*)(K + (16 * (nt0 + n2) + fr) * 264 + ks * 32 + 8 * fq); sc[n2] = MFMA16(a, bb, sc[n2]); } }
#pragma unroll
            for (int n2 = 0; n2 < 2; ++n2)
#pragma unroll
                for (int i = 0; i < 4; ++i) { const int t = 16 * mt + 4 * fq + i, s = 16 * (nt0 + n2) + fr; const int dl = t - s;
                    const float w = dl > 0 ? exp2f((float)dl * lgf) : (dl < 0 ? exp2f((float)(-dl) * lgb) : 2.0f);
                    Pm[t * 72 + s] = f2bf(sc[n2][i] * w); } }
        __syncthreads();
        {   f32x4 o[4][4];
#pragma unroll
            for (int mt = 0; mt < 4; ++mt)
#pragma unroll
                for (int j = 0; j < 4; ++j) o[mt][j] = (f32x4){0.f, 0.f, 0.f, 0.f};
#pragma unroll
            for (int ks = 0; ks < 2; ++ks) { bf16x8 bb[4];
#pragma unroll
                for (int j = 0; j < 4; ++j) bb[j] = tr_frag(Vl, 520, 32 * ks, 16 * (4 * wave + j), lane);
#pragma unroll
                for (int mt = 0; mt < 4; ++mt) { const bf16x8 a = *(const LAS bf16x8*)(Pm + (16 * mt + fr) * 72 + ks * 32 + 8 * fq);
#pragma unroll
                    for (int j = 0; j < 4; ++j) o[mt][j] = MFMA16(bb[j], a, o[mt][j]); } }
#pragma unroll
            for (int mt = 0; mt < 4; ++mt) { bf16_t* op = ofw + (row0 + 16 * mt + fr) * 2048 + h * 512 + 64 * wave + 4 * fq;
#pragma unroll
                for (int j = 0; j < 4; ++j) { u32x2 w; w.x = pk2(o[mt][j][0], o[mt][j][1]); w.y = pk2(o[mt][j][2], o[mt][j][3]); *(u32x2*)(op + 16 * j) = w; } } }
    }
}
#undef RI_LOAD
constexpr int RT_Q = 0, RT_K = 33792, RT_VS = 67584, RT_ST = 76800;
DI void ret_scan_phase(int wv, const bf16_t* P1, bf16_t* ofw, bf16_t* obw, LAS unsigned char* lds) {
    const int tid = pg8::pg8_opaque_tid(wv), lane = tid & 63, wave = __builtin_amdgcn_readfirstlane(tid >> 6);
    const int fr = lane & 15, fq = lane >> 4;
    LAS bf16_t* Q = (LAS bf16_t*)(lds + RT_Q); LAS bf16_t* K = (LAS bf16_t*)(lds + RT_K); LAS bf16_t* Vs = (LAS bf16_t*)(lds + RT_VS); LAS bf16_t* St = (LAS bf16_t*)(lds + RT_ST);
    const int mt = wave >> 1, et0 = 2 * (wave & 1);
    for (int unit = blockIdx.x; unit < 256; unit += gridDim.x) {
        const int gx = (unit & 7) * 4 + (unit >> 6), sl = (unit >> 3) & 7, dir = gx & 1, h = (gx >> 1) & 3, bl = gx >> 3;
        const int hh = dir ? 3 - h : h;
        const float lg2 = log2f(1.0f - exp2f(-5.0f - (float)hh));
        const float g64 = exp2f(64.0f * lg2);
        __syncthreads();
        for (int i = tid; i < 33792 / 4; i += NTHREADS) ((LAS unsigned*)(lds + RT_ST))[i] = 0u;
        f32x4 sacc[2][4];
#pragma unroll
        for (int a = 0; a < 2; ++a)
#pragma unroll
            for (int e = 0; e < 4; ++e) sacc[a][e] = (f32x4){0.f, 0.f, 0.f, 0.f};
        const int pt = tid >> 3, pc = tid & 7;
        const int ptok = dir ? 63 - pt : pt;
        const float vscl = exp2f((float)(63 - pt) * lg2);
        const float rsc = exp2f((float)(16 * mt + fr + 1) * lg2);
        bf16x8 qv[2][4], kv[2][4], vv[2]; u32x2 oold[2][2];
        const int otok = dir ? 63 - (16 * mt + fr) : 16 * mt + fr;
        bf16_t* obase = (dir ? obw : ofw) + (size_t)otok * 2048 + h * 512 + sl * 64 + 16 * et0 + 4 * fq;
#define RT_ROW0(n_) ((n_) < 4 ? (size_t)32768 + bl * 256 + (dir ? 3 - (n_) : (n_)) * 64 : (size_t)bl * 8192 + (dir ? 127 - ((n_) - 4) : (n_) - 4) * 64)
#define RT_LOAD(s_, n_) do { const size_t r0_ = RT_ROW0(n_); const bf16_t* rp_ = P1 + (r0_ + ptok) * OIN; \
            _Pragma("unroll") for (int j = 0; j < 4; ++j) { qv[s_][j] = *(const bf16x8*)(rp_ + C_RQ + h * 256 + 64 * j + 8 * pc); kv[s_][j] = *(const bf16x8*)(rp_ + C_RK + h * 256 + 64 * j + 8 * pc); } \
            vv[s_] = *(const bf16x8*)(rp_ + C_RV + h * 512 + sl * 64 + 8 * pc); \
            if (!dir && (n_) >= 4) { oold[s_][0] = *(const u32x2*)(obase + r0_ * 2048); oold[s_][1] = *(const u32x2*)(obase + r0_ * 2048 + 16); } } while (0)
        RT_LOAD(0, 0); RT_LOAD(1, 1);
        for (int n0 = 0; n0 < 132; n0 += 2) {
#pragma unroll
          for (int s = 0; s < 2; ++s) {
            const int n = n0 + s;
            const bool is_ctx = n < 4; const size_t row0 = RT_ROW0(n);
#pragma unroll
            for (int j = 0; j < 4; ++j) { *(LAS bf16x8*)(Q + pt * 264 + 64 * j + 8 * pc) = qv[s][j]; *(LAS bf16x8*)(K + pt * 264 + 64 * j + 8 * pc) = kv[s][j]; }
            {   float vf[8]; unpack8(vv[s], vf);
#pragma unroll
                for (int i = 0; i < 8; ++i) vf[i] *= vscl;
                *(LAS bf16x8*)(Vs + pt * 72 + 8 * pc) = pack8(vf); }
            f32x4 o[2];
#pragma unroll
            for (int e2 = 0; e2 < 2; ++e2) { o[e2][0] = dir ? 0.f : __uint_as_float(oold[s][e2].x << 16); o[e2][1] = dir ? 0.f : __uint_as_float(oold[s][e2].x & 0xffff0000u);
                o[e2][2] = dir ? 0.f : __uint_as_float(oold[s][e2].y << 16); o[e2][3] = dir ? 0.f : __uint_as_float(oold[s][e2].y & 0xffff0000u); }
            if (n + 2 < 132) RT_LOAD(s, n + 2);
            __syncthreads();
            if (!is_ctx) { f32x4 oi[2]; oi[0] = (f32x4){0.f, 0.f, 0.f, 0.f}; oi[1] = oi[0];
#pragma unroll
                for (int ks = 0; ks < 8; ++ks) { const bf16x8 a = *(const LAS bf16x8*)(Q + (16 * mt + fr) * 264 + ks * 32 + 8 * fq);
#pragma unroll
                    for (int e2 = 0; e2 < 2; ++e2) { const bf16x8 bb = *(const LAS bf16x8*)(St + (16 * (et0 + e2) + fr) * 264 + ks * 32 + 8 * fq); oi[e2] = MFMA16(bb, a, oi[e2]); } }
#pragma unroll
                for (int e2 = 0; e2 < 2; ++e2) { const f32x4 r = o[e2] + oi[e2] * rsc; u32x2 w; w.x = pk2(r[0], r[1]); w.y = pk2(r[2], r[3]); *(u32x2*)(obase + row0 * 2048 + 16 * e2) = w; } }
            {
#pragma unroll
                for (int dt = 0; dt < 2; ++dt)
#pragma unroll
                    for (int et = 0; et < 4; ++et) sacc[dt][et] *= g64;
#pragma unroll
                for (int ks = 0; ks < 2; ++ks) { bf16x8 bb[4];
#pragma unroll
                    for (int et = 0; et < 4; ++et) bb[et] = tr_frag(Vs, 72, 32 * ks, 16 * et, lane);
#pragma unroll
                    for (int dt = 0; dt < 2; ++dt) { const bf16x8 a = tr_frag(K, 264, 32 * ks, 16 * (2 * wave + dt), lane);
#pragma unroll
                        for (int et = 0; et < 4; ++et) sacc[dt][et] = MFMA16(a, bb[et], sacc[dt][et]); } } }
            __syncthreads();
#pragma unroll
            for (int dt = 0; dt < 2; ++dt)
#pragma unroll
                for (int et = 0; et < 4; ++et) { u32x2 w; w.x = pk2(sacc[dt][et][0], sacc[dt][et][1]); w.y = pk2(sacc[dt][et][2], sacc[dt][et][3]);
                    *(LAS u32x2*)(St + (16 * et + fr) * 264 + 16 * (2 * wave + dt) + 4 * fq) = w; }
          }
        }
#undef RT_LOAD
#undef RT_ROW0
    }
}
DI void ret_norm_phase(int wv, const bf16_t* P1, bf16_t* ofw, const bf16_t* obw) {
    const int tid = pg8::pg8_opaque_tid(wv), lane = tid & 63, wave = __builtin_amdgcn_readfirstlane(tid >> 6);
    const int gw = blockIdx.x * NWAVES + wave, ngw = gridDim.x * NWAVES;
    for (int idx0 = gw * 4; idx0 < 32768 * 4; idx0 += ngw * 4) {
        bf16x8 a[4], b[4], g[4];
#pragma unroll
        for (int u = 0; u < 4; ++u) { const int idx = idx0 + u; const int row = idx >> 2, h = idx & 3;
            a[u] = *(const bf16x8*)(ofw + (size_t)row * 2048 + h * 512 + 8 * lane); b[u] = *(const bf16x8*)(obw + (size_t)row * 2048 + h * 512 + 8 * lane);
            g[u] = *(const bf16x8*)(P1 + (size_t)row * OIN + C_RG + h * 512 + 8 * lane); }
#pragma unroll
        for (int u = 0; u < 4; ++u) { const int idx = idx0 + u; const int row = idx >> 2, h = idx & 3;
            float of[8], o2[8], gg[8]; unpack8(a[u], of); unpack8(b[u], o2); unpack8(g[u], gg);
            float ss = 0.f;
#pragma unroll
            for (int i = 0; i < 8; ++i) { of[i] += o2[i]; ss += of[i] * of[i]; }
            const float rn = rsqrtf(wave_sum(ss) * (1.0f / 512.0f) + EPS);
#pragma unroll
            for (int i = 0; i < 8; ++i) of[i] = of[i] * rn * siluf(gg[i]);
            *(bf16x8*)(ofw + (size_t)row * 2048 + h * 512 + 8 * lane) = pack8(of); }
    }
}

template <class Epi>
DI void run_gemm(int wv, LAS unsigned char* lds, const bf16_t* A, const bf16_t* Bt, int M, int N, int K, const Epi& E, int rev = 0) {
    pg8::Gemm g{A, Bt, M, N, K}; pg8::StaticOrder S; S.init(M, N, (int)gridDim.x, (int)blockIdx.x, rev);
    pg8::gemm_phase<Epi, pg8::StaticOrder, false>(lds, g, S, E, nullptr, wv);
}

__global__ void __launch_bounds__(NTHREADS, 2) fwd_megakernel(Args a) {
    extern __shared__ __attribute__((aligned(16))) unsigned char lds_raw[];
    LAS unsigned char* lds = (LAS unsigned char*)lds_raw;
    cg::grid_group grid = cg::this_grid();
    const int wave_s = __builtin_amdgcn_readfirstlane((int)(threadIdx.x >> 6));
    volatile LAS unsigned* xbst = (volatile LAS unsigned*)(lds + 157680);
    if (threadIdx.x < 4) xbst[threadIdx.x] = 0u;
    __syncthreads();
    (void)xcd_barrier_post((unsigned*)(a.ws + WS_BAR), xbst);
#define GBAR() do { XcdBarrier xb_; xb_.bar = (unsigned*)(a.ws + WS_BAR); xb_.x = xb_xcc_id(); xb_.wv = wave_s; xb_.st = (volatile LAS unsigned*)(lds + 157680); xcd_barrier(xb_); } while (0)
    unsigned char* ws = a.ws;
    bf16_t* wt_ein = (bf16_t*)(ws + WS_WT_EIN); bf16_t* wt_eout = (bf16_t*)(ws + WS_WT_EOUT); bf16_t* wt_oin = (bf16_t*)(ws + WS_WT_OIN); bf16_t* wt_oout = (bf16_t*)(ws + WS_WT_OOUT);
    bf16_t* wt_fin = (bf16_t*)(ws + WS_WT_FIN); bf16_t* wt_fout = (bf16_t*)(ws + WS_WT_FOUT);
    float* mods = (float*)(ws + WS_MODS); float* axt = (float*)(ws + WS_ROPE_AX); float* rtt = (float*)(ws + WS_ROPE_RT); float* lb = (float*)(ws + WS_LB);
    float* gs = (float*)(ws + WS_GS); float* bias3 = (float*)(ws + WS_BIAS3); float* bias5 = (float*)(ws + WS_BIAS5); float* bias7 = (float*)(ws + WS_BIAS7);
    float* rss_a = (float*)(ws + WS_RSS_A); float* rss_b = (float*)(ws + WS_RSS_B); float* rss_c = (float*)(ws + WS_RSS_C);
    float* ctxr = (float*)(ws + WS_CTXR); bf16_t* ha = (bf16_t*)(ws + WS_HA); bf16_t* obuf = (bf16_t*)(ws + WS_OB); bf16_t* big = (bf16_t*)(ws + WS_BIG);
    bf16_t* ofw = (bf16_t*)(ws + WS_OFW); bf16_t* obw = (bf16_t*)(ws + WS_OBW);
    const float* x = a.in[0]; const float* ctx = a.in[2]; const float* normg = a.in[6]; float* out = a.out;

    mods_phase(wave_s, a, mods, lds);
    __syncthreads();
    tables_phase(wave_s, a, axt, rtt, lb, rss_a, (int)((WS_HA - WS_RSS_A) / 4));
    {   const int tid = pg8::pg8_opaque_tid(wave_s), lane = tid & 63, wave = __builtin_amdgcn_readfirstlane(tid >> 6);
        LAS float* scr = (LAS float*)(lds + wave * 16384);
        const int gw = blockIdx.x * NWAVES + wave, ngw = gridDim.x * NWAVES; int it0 = 0;
        transpose_matrix(a.in[9], DM, EIN, wt_ein, false, it0, gw, ngw, scr, lane);
        transpose_matrix(a.in[10], DM, DM, wt_eout, false, it0, gw, ngw, scr, lane);
        transpose_matrix(a.in[15], DM, OIN, wt_oin, false, it0, gw, ngw, scr, lane);
        transpose_matrix(a.in[16], 2048, DM, wt_oout, false, it0, gw, ngw, scr, lane);
        transpose_matrix(a.in[7], DM, 2 * FF, wt_fin, true, it0, gw, ngw, scr, lane);
        transpose_matrix(a.in[7] + (size_t)DM * 2 * FF, DM, 2 * FF, wt_fin + (size_t)2 * FF * DM, true, it0, gw, ngw, scr, lane);
        transpose_matrix(a.in[8], FF, DM, wt_fout, false, it0, gw, ngw, scr, lane);
        transpose_matrix(a.in[8] + (size_t)FF * DM, FF, DM, wt_fout + (size_t)DM * FF, false, it0, gw, ngw, scr, lane);
    }
    grid.sync();

    const float* mods0 = mods; const float* mods1 = mods + 9 * 6144;
    normmod_phase(wave_s, x, ctx, 0, NT_LAT, NT_ALL, normg + 0, mods0, 0, ha);
    aux_phase(wave_s, normg, mods, wt_fin, wt_oin, gs, bias3, bias5, bias7);
    GBAR();
    {   pg8::EpiStoreBf16 E{big, EIN}; run_gemm(wave_s, lds, ha, wt_ein, NT_ALL, EIN, DM, E); }
    GBAR();
    bf16_t* hsq = big + (size_t)NT_ALL * EIN; bf16_t* hsk = hsq + (size_t)8448 * 8192; float* hsd = (float*)(hsk + (size_t)8448 * 8192);
    hgrn_prep_phase(wave_s, big, ha, obuf, lb, hsq, hsk, hsd, lds);
    GBAR();
    hgrn_scan_phase(wave_s, big, ha, obuf, hsq, hsk, hsd, lds);
    __syncthreads();
    attn_phase(wave_s, big, ha, a.in[11], a.in[12], axt, axt + 8192 * 32, lds);
    GBAR();
    hgrn_norm_phase(wave_s, big, ha, obuf, a.in[13]);
    GBAR();
    bf16_t* a3 = big + (size_t)NT_ALL * FF;
    {   pg8::EpiResid<true> E{x, out, ctx, ctxr, mods0 + 2 * 1024, 0, NT_LAT, a3, rss_a, gs, 0}; run_gemm(wave_s, lds, ha, wt_eout, NT_ALL, DM, DM, E); }
    GBAR();
    {   pg8::EpiSwiglu E{big, FF, pg8::RowNorm{rss_a, bias3, 5632, 0, NT_LAT}}; run_gemm(wave_s, lds, a3, wt_fin, NT_ALL, 2 * FF, DM, E); }
    GBAR();
    {   pg8::EpiResid<true> E{out, out, ctxr, ctxr, mods0 + 5 * 1024, 0, NT_LAT, ha, rss_b, gs + 9 * 1024, 1}; run_gemm(wave_s, lds, big, wt_fout, NT_ALL, DM, FF, E, 1); }
    GBAR();

    bf16_t* a7 = obuf;
    for (int hb = 0; hb < 2; ++hb) {
        const int b0 = 4 * hb;
        {   pg8::EpiRopeStore E{big, OIN, rtt, rtt + 8192 * 128, 32768, pg8::RowNorm{rss_b + (size_t)hb * 33792 * 16, bias5, 6144, b0, 32768}}; run_gemm(wave_s, lds, ha + (size_t)hb * 33792 * DM, wt_oin, 33792, OIN, DM, E); }
        GBAR();
        ret_intra_phase(wave_s, big, ofw, lds);
        GBAR();
        ret_scan_phase(wave_s, big, ofw, obw, lds);
        GBAR();
        ret_norm_phase(wave_s, big, ofw, obw);
        GBAR();
        {   pg8::EpiResid<true> E{out, out, ctxr, ctxr, mods1 + 2 * 1024, b0, 32768, a7, rss_c + (size_t)hb * 32768 * 16, gs + 18 * 1024, 0}; run_gemm(wave_s, lds, ofw, wt_oout, 32768, DM, 2048, E); }
        GBAR();
        {   pg8::EpiSwiglu E{big, FF, pg8::RowNorm{rss_c + (size_t)hb * 32768 * 16, bias7, 5632, b0, 32768}}; run_gemm(wave_s, lds, a7, wt_fin + (size_t)2 * FF * DM, 32768, 2 * FF, DM, E); }
        GBAR();
        {   pg8::EpiResid<false> E{out, out, ctxr, ctxr, mods1 + 5 * 1024, b0, 32768, nullptr, nullptr, nullptr, 0}; run_gemm(wave_s, lds, big, wt_fout + (size_t)DM * FF, 32768, DM, FF, E, 1); }
        GBAR();
    }
}

extern "C" void kernel_launch(void* const* d_in, const int* in_sizes, int n_in, void* d_out, int out_size, void* d_ws, size_t ws_size, hipStream_t stream) {
    static int grid = 0;
    if (grid == 0) {
        if (n_in != 17 || ws_size < WS_END) { fprintf(stderr, "kernel_launch: need 17 inputs and >= %zu bytes of workspace (got %d, %zu)\n", (size_t)WS_END, n_in, ws_size); grid = -1; return; }
        int dev = 0, cus = 0, per_cu = 0;
        hipGetDevice(&dev); hipDeviceGetAttribute(&cus, hipDeviceAttributeMultiprocessorCount, dev);
        if (hipFuncSetAttribute((const void*)fwd_megakernel, hipFuncAttributeMaxDynamicSharedMemorySize, LDS_BYTES) != hipSuccess) { fprintf(stderr, "kernel_launch: hipFuncSetAttribute failed\n"); grid = -1; return; }
        if (hipOccupancyMaxActiveBlocksPerMultiprocessor(&per_cu, (const void*)fwd_megakernel, NTHREADS, LDS_BYTES) != hipSuccess || per_cu < 1) { fprintf(stderr, "kernel_launch: occupancy query says %d\n", per_cu); per_cu = 1; }
        (void)hipGetLastError();
        grid = cus * 1;
    }
    if (grid < 0) return;
    if (hipMemsetAsync((char*)d_ws + WS_BAR, 0, 4096 * 4, stream) != hipSuccess) { fprintf(stderr, "kernel_launch: memset of barrier words failed\n"); return; }
    Args a{};
    for (int i = 0; i < 17; ++i) a.in[i] = (const float*)d_in[i];
    a.out = (float*)d_out; a.ws = (unsigned char*)d_ws;
    void* args[] = {&a};
    hipError_t e = hipLaunchCooperativeKernel((const void*)fwd_megakernel, dim3(grid), dim3(NTHREADS), args, LDS_BYTES, stream);
    if (e != hipSuccess) fprintf(stderr, "cooperative launch failed: %s (grid %d)\n", hipGetErrorString(e), grid);
}
```

```cpp
#include <hip/hip_runtime.h>
#include <hip/hip_cooperative_groups.h>
#include <cstdio>
namespace cg = cooperative_groups;

#define DI __device__ __forceinline__
#define LAS __attribute__((address_space(3)))
namespace pg8 {
#define PG8_LAS __attribute__((address_space(3)))
typedef unsigned short bf16_t;
typedef short bf16x8 __attribute__((ext_vector_type(8)));
typedef float f32x4 __attribute__((ext_vector_type(4)));
typedef unsigned u32x4 __attribute__((ext_vector_type(4)));
constexpr int BM = 256, BK = 64, HALF = 128, HTB = HALF * BK * 2  , STAGE_BYTES = 8 * HTB, NXCD = 8, WGM = 4;

__host__ __device__ __forceinline__ int lds_byte(int r, int c) { const int st = (r >> 4) * 2 + (c >> 5), rr = r & 15, cc = c & 31, ob = rr * 64 + cc * 2; return st * 1024 + (ob ^ (((ob >> 9) & 1) << 5)); }
__host__ __device__ __forceinline__ void stage_rc(int b, int& R, int& C) { const int st = b / 1024, sb = b % 1024, swz = sb ^ (((sb >> 9) & 1) << 5); R = (st >> 1) * 16 + swz / 64; C = (st & 1) * 32 + (swz % 64) / 2; }
__host__ __device__ __forceinline__ int perm32(int rho) { const int n = rho >> 4, i = rho & 15; return 8 * (i >> 2) + 4 * n + (i & 3); }

struct Unit { int pm, pn; };
struct Gemm { const bf16_t* A; const bf16_t* Bt; int M, N, K; };

struct StaticOrder {
    int nM, nN, nwg, G, c, rev;
    __host__ __device__ void init(int M, int N, int G_, int c_, int rev_ = 0) { nM = M / BM; nN = N / BM; nwg = nM * nN; G = G_; c = c_; rev = rev_; }
    __host__ __device__ bool next(int i, Unit& u) const {
        const long L = (long)i * G + c; if (L >= nwg) return false;
        int wgid = (int)L; { const int q = nwg / NXCD, r = nwg % NXCD, xcd = wgid % NXCD, off = wgid / NXCD; wgid = (xcd < r ? xcd * (q + 1) : r * (q + 1) + (xcd - r) * q) + off; }
        const int nig = WGM * nN, gid = wgid / nig, fm = gid * WGM, gsz = (nM - fm) < WGM ? (nM - fm) : WGM;
        u.pm = fm + ((wgid % nig) % gsz); u.pn = (wgid % nig) / gsz; if (rev) u.pm = nM - 1 - u.pm; return true;
    }
    __device__ __forceinline__ void a_ready(const Unit&) const {}
    __device__ __forceinline__ void done(const Unit&) const {}
};

typedef unsigned u32x2 __attribute__((ext_vector_type(2)));
__device__ __forceinline__ int pg8_opaque_tid(int wv) { unsigned z = 0u; asm volatile("" : "+v"(z)); return (wv << 6) | (int)__builtin_amdgcn_mbcnt_hi(~0u, __builtin_amdgcn_mbcnt_lo(~0u, z)); }
__device__ __forceinline__ unsigned cvt_pk_bf16(float lo, float hi) { unsigned r; asm volatile("v_cvt_pk_bf16_f32 %0, %1, %2" : "=v"(r) : "v"(lo), "v"(hi)); return r; }

struct EpiStoreBf16 {
    static constexpr bool PERM = true, AFTER_DRAIN = false;
    bf16_t* O; int ldc;
    __device__ __forceinline__ void operator()(const f32x4 (&acc)[2][2][4][2], const Unit& u, int wr, int wc, int fr, int fq) const {
        const int row0 = u.pm * BM + wr * 64 + fr; const int col0 = u.pn * BM + wc * 32 + 8 * fq;
#pragma unroll
        for (int ai = 0; ai < 2; ++ai)
#pragma unroll
            for (int m = 0; m < 4; ++m) { bf16_t* rowp = O + (size_t)(row0 + ai * HALF + m * 16) * ldc + col0;
#pragma unroll
                for (int bj = 0; bj < 2; ++bj) { const f32x4 v0 = acc[ai][bj][m][0], v1 = acc[ai][bj][m][1];
                    u32x4 w; w.x = cvt_pk_bf16(v0[0], v0[1]); w.y = cvt_pk_bf16(v0[2], v0[3]); w.z = cvt_pk_bf16(v1[0], v1[1]); w.w = cvt_pk_bf16(v1[2], v1[3]);
                    *(u32x4*)(rowp + bj * HALF) = w; } }
    }
};
struct RowNorm { const float* rowss; const float* bias; int ldb, b0, nlat; };
struct EpiRopeStore {
    static constexpr bool PERM = true, AFTER_DRAIN = false;
    bf16_t* O; int ldc; const float* rtc; const float* rts; int nlat; RowNorm rn;
    __device__ __forceinline__ void operator()(const f32x4 (&acc)[2][2][4][2], const Unit& u, int wr, int wc, int fr, int fq) const {
        const int row0 = u.pm * BM + wr * 64 + fr; const int col0 = u.pn * BM + wc * 32 + 8 * fq;
        const bool rot = (u.pn < 8) && (u.pm * BM < nlat); const float ksc = (u.pn >= 4 && u.pn < 8) ? 0.0625f : 1.0f;
        const int mrow = (u.pm * BM < rn.nlat) ? rn.b0 + ((u.pm * BM) >> 13) : 8;
        const float* bp = rn.bias + (size_t)mrow * rn.ldb + col0;
        const f32x4 bv00 = *(const f32x4*)bp, bv01 = *(const f32x4*)(bp + 4), bv10 = *(const f32x4*)(bp + HALF), bv11 = *(const f32x4*)(bp + HALF + 4);
        float rinv[8];
#pragma unroll
        for (int ii = 0; ii < 8; ii += 2) { const f32x4 qa = *(const f32x4*)(rn.rowss + (size_t)(row0 + (ii >> 2) * HALF + (ii & 3) * 16) * 16 + 4 * fq), qb = *(const f32x4*)(rn.rowss + (size_t)(row0 + ((ii + 1) >> 2) * HALF + ((ii + 1) & 3) * 16) * 16 + 4 * fq);
            float sa = (qa[0] + qa[1]) + (qa[2] + qa[3]), sb = (qb[0] + qb[1]) + (qb[2] + qb[3]);
            sa += __shfl_xor(sa, 16); sb += __shfl_xor(sb, 16); sa += __shfl_xor(sa, 32); sb += __shfl_xor(sb, 32);
            rinv[ii] = rsqrtf(sa * (1.0f / 1024.0f) + 1e-6f); rinv[ii + 1] = rsqrtf(sb * (1.0f / 1024.0f) + 1e-6f); }
        f32x4 tc[4], tn[4];
#define PG8_LOADT(dst, idx) do { const size_t to_ = (size_t)((row0 + ((idx) >> 2) * HALF + ((idx) & 3) * 16) & 8191) * 128 + wc * 32 + 8 * fq; \
            dst[0] = *(const f32x4*)(rtc + to_); dst[1] = *(const f32x4*)(rtc + to_ + 4); dst[2] = *(const f32x4*)(rts + to_); dst[3] = *(const f32x4*)(rts + to_ + 4); } while (0)
        if (rot) PG8_LOADT(tc, 0);
#pragma unroll
        for (int idx = 0; idx < 8; ++idx) { const int ai = idx >> 2, m = idx & 3;
            const int row = row0 + ai * HALF + m * 16; bf16_t* rowp = O + (size_t)row * ldc + col0;
            if (rot && idx + 1 < 8) PG8_LOADT(tn, idx + 1);
            const float ri = rinv[idx];
            f32x4 a0 = acc[ai][0][m][0] * ri + bv00, a1 = acc[ai][0][m][1] * ri + bv01, b0 = acc[ai][1][m][0] * ri + bv10, b1 = acc[ai][1][m][1] * ri + bv11;
            if (rot) { const f32x4 x0 = a0 * tc[0] - b0 * tc[2], y0 = b0 * tc[0] + a0 * tc[2], x1 = a1 * tc[1] - b1 * tc[3], y1 = b1 * tc[1] + a1 * tc[3]; a0 = x0; b0 = y0; a1 = x1; b1 = y1; }
            a0 *= ksc; a1 *= ksc; b0 *= ksc; b1 *= ksc;
            u32x4 w; w.x = cvt_pk_bf16(a0[0], a0[1]); w.y = cvt_pk_bf16(a0[2], a0[3]); w.z = cvt_pk_bf16(a1[0], a1[1]); w.w = cvt_pk_bf16(a1[2], a1[3]);
            *(u32x4*)rowp = w;
            w.x = cvt_pk_bf16(b0[0], b0[1]); w.y = cvt_pk_bf16(b0[2], b0[3]); w.z = cvt_pk_bf16(b1[0], b1[1]); w.w = cvt_pk_bf16(b1[2], b1[3]);
            *(u32x4*)(rowp + HALF) = w;
#pragma unroll
            for (int q = 0; q < 4; ++q) tc[q] = tn[q];
        }
#undef PG8_LOADT
    }
};

struct EpiSwiglu {
    static constexpr bool PERM = true, AFTER_DRAIN = false;
    bf16_t* O; int ldc; RowNorm rn;
    __device__ __forceinline__ void operator()(const f32x4 (&acc)[2][2][4][2], const Unit& u, int wr, int wc, int fr, int fq) const {
        const int row0 = u.pm * BM + wr * 64 + fr; const int col0 = u.pn * HALF + wc * 32 + 8 * fq;
        const int mrow = (u.pm * BM < rn.nlat) ? rn.b0 + ((u.pm * BM) >> 13) : 8;
        const float* bp = rn.bias + (size_t)mrow * rn.ldb + u.pn * BM + wc * 32 + 8 * fq;
        f32x4 bv[2][2];
#pragma unroll
        for (int bj = 0; bj < 2; ++bj)
#pragma unroll
            for (int n = 0; n < 2; ++n) bv[bj][n] = *(const f32x4*)(bp + bj * HALF + 4 * n);
        float rinv[8];
#pragma unroll
        for (int ii = 0; ii < 8; ii += 2) { const f32x4 qa = *(const f32x4*)(rn.rowss + (size_t)(row0 + (ii >> 2) * HALF + (ii & 3) * 16) * 16 + 4 * fq), qb = *(const f32x4*)(rn.rowss + (size_t)(row0 + ((ii + 1) >> 2) * HALF + ((ii + 1) & 3) * 16) * 16 + 4 * fq);
            float sa = (qa[0] + qa[1]) + (qa[2] + qa[3]), sb = (qb[0] + qb[1]) + (qb[2] + qb[3]);
            sa += __shfl_xor(sa, 16); sb += __shfl_xor(sb, 16); sa += __shfl_xor(sa, 32); sb += __shfl_xor(sb, 32);
            rinv[ii] = rsqrtf(sa * (1.0f / 1024.0f) + 1e-6f); rinv[ii + 1] = rsqrtf(sb * (1.0f / 1024.0f) + 1e-6f); }
#pragma unroll
        for (int ai = 0; ai < 2; ++ai) {
#pragma unroll
            for (int m = 0; m < 4; ++m) { const int row = row0 + ai * HALF + m * 16; bf16_t* rowp = O + (size_t)row * ldc + col0;
                const float ri = rinv[4 * ai + m];
                float h[8];
#pragma unroll
                for (int n = 0; n < 2; ++n)
#pragma unroll
                    for (int j = 0; j < 4; ++j) { const float g = acc[ai][0][m][n][j] * ri + bv[0][n][j], up = acc[ai][1][m][n][j] * ri + bv[1][n][j]; h[4 * n + j] = g * __builtin_amdgcn_rcpf(1.0f + __builtin_amdgcn_exp2f(g * -1.4426950408889634f)) * up; }
                u32x4 w; w.x = cvt_pk_bf16(h[0], h[1]); w.y = cvt_pk_bf16(h[2], h[3]); w.z = cvt_pk_bf16(h[4], h[5]); w.w = cvt_pk_bf16(h[6], h[7]);
                *(u32x4*)rowp = w; } }
    }
};
template <bool EMIT> struct EpiResid {
    static constexpr bool PERM = false, AFTER_DRAIN = false;
    const float* resL; float* outL; const float* resC; float* outC; const float* gate; int b0, nlat;
    bf16_t* an; float* rss; const float* gsv; int remap;
    __device__ __forceinline__ void operator()(const f32x4 (&acc)[2][2][4][2], const Unit& u, int wr, int wc, int fr, int fq) const {
        const int lr0 = u.pm * BM; const bool is_ctx = lr0 >= nlat;
        const int col0 = u.pn * BM + wc * 32 + 4 * fq;
        size_t grow0; int mrow; const float* rp0; float* op0;
        if (!is_ctx) { grow0 = (size_t)b0 * 8192 + lr0; mrow = (int)(grow0 >> 13); rp0 = resL; op0 = outL; }
        else { grow0 = (size_t)b0 * 256 + (lr0 - nlat); mrow = 8; rp0 = resC; op0 = outC; }
        size_t nrow0 = (size_t)lr0;
        if (EMIT && remap) nrow0 = is_ctx ? (grow0 >> 10) * 33792 + 32768 + (grow0 & 1023) : (grow0 >> 15) * 33792 + (grow0 & 32767);
        const float* gp = gate + (size_t)mrow * 6144 + col0;
        f32x4 gv[2][2], sv[2][2];
#pragma unroll
        for (int bj = 0; bj < 2; ++bj)
#pragma unroll
            for (int n = 0; n < 2; ++n) { gv[bj][n] = *(const f32x4*)(gp + bj * HALF + n * 16); if (EMIT) sv[bj][n] = *(const f32x4*)(gsv + (size_t)mrow * 1024 + col0 + bj * HALF + n * 16); }
        f32x4 rcur[2][2], rnxt[2][2];
#define PG8_LOADR(dst, idx) do { const int rin_ = wr * 64 + fr + ((idx) >> 2) * HALF + ((idx) & 3) * 16; const size_t off_ = (grow0 + rin_) * 1024 + col0; \
            _Pragma("unroll") for (int bj = 0; bj < 2; ++bj) _Pragma("unroll") for (int n = 0; n < 2; ++n) dst[bj][n] = *(const f32x4*)(rp0 + off_ + bj * HALF + n * 16); } while (0)
        PG8_LOADR(rcur, 0);
#pragma unroll
        for (int idx = 0; idx < 8; ++idx) { const int ai = idx >> 2, m = idx & 3;
            const int rin = wr * 64 + fr + ai * HALF + m * 16; const size_t off = (grow0 + rin) * 1024 + col0; float ss = 0.f;
            if (idx + 1 < 8) PG8_LOADR(rnxt, idx + 1);
#pragma unroll
            for (int bj = 0; bj < 2; ++bj)
#pragma unroll
                for (int n = 0; n < 2; ++n) { const f32x4 o = rcur[bj][n] + gv[bj][n] * acc[ai][bj][m][n];
                    *(f32x4*)(op0 + off + bj * HALF + n * 16) = o;
                    if (EMIT) { ss += (o[0] * o[0] + o[1] * o[1]) + (o[2] * o[2] + o[3] * o[3]); const f32x4 y = o * sv[bj][n];
                        u32x2 w; w.x = cvt_pk_bf16(y[0], y[1]); w.y = cvt_pk_bf16(y[2], y[3]);
                        *(u32x2*)(an + (nrow0 + rin) * 1024 + col0 + bj * HALF + n * 16) = w; } }
            if (EMIT) { ss += __shfl_xor(ss, 16); ss += __shfl_xor(ss, 32);
                if (fq == 0) rss[(nrow0 + rin) * 16 + u.pn * 4 + wc] = ss; }
#pragma unroll
            for (int bj = 0; bj < 2; ++bj)
#pragma unroll
                for (int n = 0; n < 2; ++n) rcur[bj][n] = rnxt[bj][n];
        }
#undef PG8_LOADR
    }
};

template <class Epi, class Sched, bool STAMP = false>
__device__ __forceinline__ void gemm_phase(PG8_LAS unsigned char* lds, const Gemm g, const Sched& S, const Epi& E, unsigned long long* stamps, int wv) {
    const int tid = pg8_opaque_tid(wv), wid = __builtin_amdgcn_readfirstlane(tid >> 6), lane = tid & 63, wr = wid >> 2, wc = wid & 3, fr = lane & 15, fq = lane >> 4;
    const int K = g.K, nt = K / BK;
    int ts_lo = 0, ts_hi = 0, nts = 0; const unsigned long long rt_entry = STAMP ? (unsigned long long)wall_clock64() : 0ull;
#define PG8_STAMP() do { if (STAMP && wid == 0 && nts < 64) { const unsigned long long _c = (unsigned long long)clock64(); \
        ts_lo = (lane == nts) ? (int)(unsigned)_c : ts_lo; ts_hi = (lane == nts) ? (int)(unsigned)(_c >> 32) : ts_hi; ++nts; } } while (0)
    PG8_STAMP();
    unsigned voffA[2], voffB[2];
#pragma unroll
    for (int i = 0; i < 2; ++i) { int R, C; stage_rc(tid * 16 + i * 8192, R, C); const int Rb = Epi::PERM ? ((R & ~31) + perm32(R & 31)) : R;
        voffA[i] = (unsigned)(R * K + C) * 2u; voffB[i] = (unsigned)(Rb * K + C) * 2u; }
    const size_t kstep = (size_t)(BK * 2);
    const size_t hstep = (size_t)HALF * K * 2;
    const size_t tstep = 2 * hstep;
    const unsigned ldsw = (unsigned)wid * 1024u;
    const int aoff = lds_byte(wr * 64 + fr, fq * 8), boff = lds_byte(wc * 32 + fr, fq * 8);
#define PG8_SA(b, h) (((b) * 2 + (h)) * HTB)
#define PG8_SB(b, h) ((4 + (b) * 2 + (h)) * HTB)
#define PG8_STAGE(bufoff, gbase, voff) do { _Pragma("unroll") for (int _i = 0; _i < 2; ++_i) \
        __builtin_amdgcn_global_load_lds((const unsigned*)((const char*)(gbase) + (voff)[_i]), (PG8_LAS unsigned*)(lds + (bufoff) + ldsw + _i * 8192), 16, 0, 0); } while (0)
#define PG8_LDA(dst, b, h) do { _Pragma("unroll") for (int m = 0; m < 4; ++m) _Pragma("unroll") for (int k = 0; k < 2; ++k) dst[m][k] = *(const PG8_LAS bf16x8*)(lds + PG8_SA(b, h) + aoff + m * 2048 + k * 1024); } while (0)
#define PG8_LDB(dst, b, h) do { _Pragma("unroll") for (int n = 0; n < 2; ++n) _Pragma("unroll") for (int k = 0; k < 2; ++k) dst[n][k] = *(const PG8_LAS bf16x8*)(lds + PG8_SB(b, h) + boff + n * 2048 + k * 1024); } while (0)
#define PG8_MMA(ai, bj, At, Bt) do { __builtin_amdgcn_s_setprio(1); _Pragma("unroll") for (int m = 0; m < 4; ++m) _Pragma("unroll") for (int n = 0; n < 2; ++n) _Pragma("unroll") for (int k = 0; k < 2; ++k) \
        acc[ai][bj][m][n] = __builtin_amdgcn_mfma_f32_16x16x32_bf16(Bt[n][k], At[m][k], acc[ai][bj][m][n], 0, 0, 0); __builtin_amdgcn_s_setprio(0); } while (0)
#define PG8_WAIT_V(n) asm volatile("s_waitcnt vmcnt(" #n ")" ::: "memory")
#define PG8_WAIT_L(n) asm volatile("s_waitcnt lgkmcnt(" #n ")" ::: "memory")
#define PG8_BAR __builtin_amdgcn_s_barrier()
#define PG8_SCHED __builtin_amdgcn_sched_barrier(0)
    Unit cur, nxt; int ui = 0;
    if (!S.next(0, cur)) return;
    f32x4 acc[2][2][4][2];
#pragma unroll
    for (int a = 0; a < 2; ++a)
#pragma unroll
        for (int b = 0; b < 2; ++b)
#pragma unroll
            for (int m = 0; m < 4; ++m)
#pragma unroll
                for (int n = 0; n < 2; ++n) acc[a][b][m][n] = (f32x4){0.f, 0.f, 0.f, 0.f};
    bf16x8 At[4][2], B0[2][2], B1[2][2];
    const char* cA = (const char*)g.A + (size_t)cur.pm * tstep; const char* cB = (const char*)g.Bt + (size_t)cur.pn * tstep;
    S.a_ready(cur);
    PG8_STAGE(PG8_SB(0, 0), cB, voffB); PG8_STAGE(PG8_SA(0, 0), cA, voffA); PG8_STAGE(PG8_SB(0, 1), cB + hstep, voffB); PG8_STAGE(PG8_SA(0, 1), cA + hstep, voffA);
    if (wr == 1) PG8_BAR;
    PG8_WAIT_V(4); PG8_BAR;
    PG8_STAGE(PG8_SB(1, 0), cB + kstep, voffB); PG8_STAGE(PG8_SA(1, 0), cA + kstep, voffA); PG8_STAGE(PG8_SB(1, 1), cB + hstep + kstep, voffB);
    PG8_WAIT_V(6); PG8_BAR;
    PG8_STAMP();
    for (;;) {
        const bool has_next = S.next(ui + 1, nxt);
        const char* nA = has_next ? (const char*)g.A + (size_t)nxt.pm * tstep : cA; const char* nB = has_next ? (const char*)g.Bt + (size_t)nxt.pn * tstep : cB;
        for (int t = 0; t < nt; t += 2) {
            const bool last = (t == nt - 2);
            const char* a1 = cA + (size_t)(t + 1) * kstep;
            const char* a2 = last ? nA : cA + (size_t)(t + 2) * kstep; const char* b2 = last ? nB : cB + (size_t)(t + 2) * kstep;
            const char* a3 = a2 + kstep; const char* b3 = b2 + kstep;
            if (last && has_next) S.a_ready(nxt);
            PG8_LDB(B0, 0, 0); PG8_SCHED; PG8_LDA(At, 0, 0); PG8_STAGE(PG8_SA(1, 1), a1 + hstep, voffA);
            PG8_WAIT_L(8); PG8_BAR; PG8_WAIT_L(0); PG8_MMA(0, 0, At, B0); PG8_BAR; PG8_SCHED;
            PG8_LDB(B1, 0, 1); PG8_STAGE(PG8_SB(0, 0), b2, voffB);
            PG8_BAR; PG8_WAIT_L(0); PG8_MMA(0, 1, At, B1); PG8_BAR;
            PG8_LDA(At, 0, 1); PG8_STAGE(PG8_SA(0, 0), a2, voffA);
            PG8_BAR; PG8_WAIT_L(0); PG8_MMA(1, 0, At, B0); PG8_BAR; PG8_SCHED;
            PG8_STAGE(PG8_SB(0, 1), b2 + hstep, voffB);
            PG8_WAIT_V(6); PG8_BAR; PG8_MMA(1, 1, At, B1); PG8_BAR;
            PG8_LDB(B0, 1, 0); PG8_SCHED; PG8_LDA(At, 1, 0); PG8_STAGE(PG8_SA(0, 1), a2 + hstep, voffA);
            PG8_WAIT_L(8); PG8_BAR; PG8_WAIT_L(0); PG8_MMA(0, 0, At, B0); PG8_BAR; PG8_SCHED;
            PG8_LDB(B1, 1, 1); PG8_STAGE(PG8_SB(1, 0), b3, voffB);
            PG8_BAR; PG8_WAIT_L(0); PG8_MMA(0, 1, At, B1); PG8_BAR;
            PG8_LDA(At, 1, 1); PG8_STAGE(PG8_SA(1, 0), a3, voffA);
            PG8_BAR; PG8_WAIT_L(0); PG8_MMA(1, 0, At, B0); PG8_BAR; PG8_SCHED;
            PG8_STAGE(PG8_SB(1, 1), b3 + hstep, voffB);
            PG8_WAIT_V(6); PG8_BAR; PG8_MMA(1, 1, At, B1); PG8_BAR;
        }
        PG8_STAMP();
        if constexpr (!Epi::AFTER_DRAIN) { E(acc, cur, wr, wc, fr, fq); S.done(cur); }
        PG8_STAMP();
        if (!has_next) break;
#pragma unroll
        for (int a = 0; a < 2; ++a)
#pragma unroll
            for (int b = 0; b < 2; ++b)
#pragma unroll
                for (int m = 0; m < 4; ++m)
#pragma unroll
                    for (int n = 0; n < 2; ++n) acc[a][b][m][n] = (f32x4){0.f, 0.f, 0.f, 0.f};
        cur = nxt; cA = nA; cB = nB; ++ui;
    }
    PG8_WAIT_V(0);
    if (wr == 0) PG8_BAR;
    PG8_BAR;
    if constexpr (Epi::AFTER_DRAIN) { E.fused(acc, cur, wr, wc, fr, fq, lds, wid, lane); S.done(cur); }
    PG8_STAMP();
    if (STAMP && wid == 0) { stamps[lane] = lane < nts ? (((unsigned long long)(unsigned)ts_hi << 32) | (unsigned)ts_lo) : 0ull;
        if (lane == 62) stamps[62] = rt_entry; if (lane == 63) stamps[63] = (unsigned long long)wall_clock64(); }
#undef PG8_STAMP
#undef PG8_SA
#undef PG8_SB
#undef PG8_STAGE
#undef PG8_LDA
#undef PG8_LDB
#undef PG8_MMA
#undef PG8_WAIT_V
#undef PG8_WAIT_L
#undef PG8_BAR
#undef PG8_SCHED
}
}

using pg8::bf16_t; using pg8::bf16x8; using pg8::f32x4; using pg8::u32x4;
typedef unsigned u32x2 __attribute__((ext_vector_type(2)));
typedef float f32x2 __attribute__((ext_vector_type(2)));

constexpr int NT_LAT = 65536, NT_CTX = 2048, NT_ALL = NT_LAT + NT_CTX, DM = 1024, FF = 2816, EIN = 3328, OIN = 6144;
constexpr int NTHREADS = 512, NWAVES = 8;
constexpr int LDS_BYTES = 157696;
constexpr float EPS = 1e-6f;
constexpr int C_AQ = 0, C_AK = 512, C_AV = 640, C_BQ = 768, C_BFF = 1280, C_BFB = 1792, C_BI = 2304, C_BG = 2816;
constexpr int C_RQ = 0, C_RK = 1024, C_RV = 2048, C_RG = 4096;

constexpr size_t al256(size_t x) { return (x + 255) & ~(size_t)255; }
constexpr size_t WS_WT_EIN = 0;
constexpr size_t WS_WT_EOUT = WS_WT_EIN + al256((size_t)EIN * DM * 2);
constexpr size_t WS_WT_OIN = WS_WT_EOUT + al256((size_t)DM * DM * 2);
constexpr size_t WS_WT_OOUT = WS_WT_OIN + al256((size_t)OIN * DM * 2);
constexpr size_t WS_WT_FIN = WS_WT_OOUT + al256((size_t)DM * 2048 * 2);
constexpr size_t WS_WT_FOUT = WS_WT_FIN + al256((size_t)2 * 2 * FF * DM * 2);
constexpr size_t WS_MODS = WS_WT_FOUT + al256((size_t)2 * DM * FF * 2);
constexpr size_t WS_ROPE_AX = WS_MODS + al256((size_t)2 * 9 * 6144 * 4);
constexpr size_t WS_ROPE_RT = WS_ROPE_AX + al256((size_t)8192 * 32 * 2 * 4);
constexpr size_t WS_LB = WS_ROPE_RT + al256((size_t)8192 * 128 * 2 * 4);
constexpr size_t WS_CTXR = WS_LB + al256(512 * 4);
constexpr size_t WS_GS = WS_CTXR + al256((size_t)NT_CTX * DM * 4);
constexpr size_t WS_BIAS3 = WS_GS + al256((size_t)3 * 9 * 1024 * 4);
constexpr size_t WS_BIAS5 = WS_BIAS3 + al256((size_t)9 * 5632 * 4);
constexpr size_t WS_BIAS7 = WS_BIAS5 + al256((size_t)9 * 6144 * 4);
constexpr size_t WS_RSS_A = WS_BIAS7 + al256((size_t)9 * 5632 * 4);
constexpr size_t WS_RSS_B = WS_RSS_A + al256((size_t)NT_ALL * 64);
constexpr size_t WS_RSS_C = WS_RSS_B + al256((size_t)NT_ALL * 64);
constexpr size_t WS_BAR = WS_RSS_C + al256((size_t)NT_LAT * 64);
constexpr size_t WS_HA = WS_BAR + al256((size_t)4096 * 4);
constexpr size_t WS_OB = WS_HA + al256((size_t)NT_ALL * DM * 2);
constexpr size_t WS_BIG = WS_OB + al256((size_t)NT_ALL * 512 * 2);
constexpr size_t BIG_P1_BYTES = (size_t)33792 * OIN * 2;
constexpr size_t BIG_O_BYTES = (size_t)32768 * 2048 * 2;
constexpr size_t WS_OFW = WS_BIG + BIG_P1_BYTES;
constexpr size_t WS_OBW = WS_OFW + BIG_O_BYTES;
constexpr size_t WS_END1 = WS_OBW + BIG_O_BYTES;
constexpr size_t WS_END0 = WS_BIG + (size_t)NT_ALL * EIN * 2 + (size_t)8448 * (2 * 8192 * 2 + 128 * 4);
constexpr size_t WS_END = WS_END1 > WS_END0 ? WS_END1 : WS_END0;

DI float bf2f(unsigned short b) { return __uint_as_float(((unsigned)b) << 16); }
typedef __bf16 bfx2_t __attribute__((ext_vector_type(2)));
typedef short s16x4 __attribute__((ext_vector_type(4)));
DI unsigned short f2bf(float f) { const __bf16 h = (__bf16)f; return __builtin_bit_cast(unsigned short, h); }
DI unsigned pk2(float lo, float hi) { const f32x2 p = {lo, hi}; const bfx2_t q = __builtin_convertvector(p, bfx2_t); return __builtin_bit_cast(unsigned, q); }
DI bf16x8 tr_frag(const LAS bf16_t* X, int pitch, int t0, int c0, int lane) {
    const int i = lane & 15, g = lane >> 4;
    const LAS bf16_t* p = X + (t0 + 8 * g + (i >> 2)) * pitch + c0 + 4 * (i & 3);
    const s16x4 lo = __builtin_amdgcn_ds_read_tr16_b64_v4i16((LAS s16x4*)p);
    const s16x4 hi = __builtin_amdgcn_ds_read_tr16_b64_v4i16((LAS s16x4*)(p + 4 * pitch));
    return __builtin_shufflevector(lo, hi, 0, 1, 2, 3, 4, 5, 6, 7);
}
DI void unpack8(const bf16x8 v, float* f) {
#pragma unroll
    for (int i = 0; i < 8; ++i) f[i] = bf2f((unsigned short)v[i]);
}
DI bf16x8 pack8(const float* f) { u32x4 p; p.x = pk2(f[0], f[1]); p.y = pk2(f[2], f[3]); p.z = pk2(f[4], f[5]); p.w = pk2(f[6], f[7]); return __builtin_bit_cast(bf16x8, p); }
DI float wave_sum(float v) {
#pragma unroll
    for (int o = 1; o < 64; o <<= 1) v += __shfl_xor(v, o);
    return v;
}
DI float fexp(float x) { return __builtin_amdgcn_exp2f(x * 1.4426950408889634f); }
DI float flog(float x) { return __builtin_amdgcn_logf(x) * 0.6931471805599453f; }
DI float sigmf(float x) { return __builtin_amdgcn_rcpf(1.0f + fexp(-x)); }
DI float siluf(float x) { return x * sigmf(x); }
#define LDS_WAIT() asm volatile("s_waitcnt lgkmcnt(0)" ::: "memory")
#define MFMA16(a, b, c) __builtin_amdgcn_mfma_f32_16x16x32_bf16((a), (b), (c), 0, 0, 0)

#define XB_TMO      128
#define XB_XCNT(j)  (256  + 64 * (j))
#define XB_XSUB(j)  (1280 + 64 * (j))
#define XB_XGEN(j)  (2304 + 64 * (j))
#define XB_TOP      3328
#define XB_TOPGEN   3392
#define XCD_BAR_WORDS 3456
#define XB_SPIN_CAP (1u << 18)

__device__ __forceinline__ unsigned xb_ld(unsigned* p)              { return __hip_atomic_load(p, __ATOMIC_RELAXED, __HIP_MEMORY_SCOPE_AGENT); }
__device__ __forceinline__ unsigned xb_add(unsigned* p, unsigned v) { return __hip_atomic_fetch_add(p, v, __ATOMIC_RELAXED, __HIP_MEMORY_SCOPE_AGENT); }
__device__ __forceinline__ unsigned xb_xcc_id() { return (unsigned)__builtin_amdgcn_s_getreg((3 << 11) | 20) & 0xFu; }
#define XB_SPIN(cond, bar) do { unsigned _sp = 0; while (cond) { __builtin_amdgcn_s_sleep(1); \
    if ((++_sp & 255u) == 0u) { if (xb_ld(&(bar)[XB_TMO])) break; if (_sp > XB_SPIN_CAP) { atomicAdd(&(bar)[XB_TMO], 1u); break; } } } } while (0)

struct XcdBarrier {
    unsigned* bar; unsigned x; int wv;
    volatile LAS unsigned* st;
};

__device__ __forceinline__ XcdBarrier xcd_barrier_post(unsigned* bar, volatile LAS unsigned* st) {
    XcdBarrier b; b.bar = bar; b.x = xb_xcc_id(); b.st = st;
    if (threadIdx.x == 0) (void)xb_add(&bar[XB_XCNT(b.x)], 1u);
    return b;
}
__device__ __forceinline__ void xcd_barrier_complete(unsigned* bar, unsigned x, unsigned& nloc, unsigned& nx) {
    const unsigned G = gridDim.x * gridDim.y * gridDim.z;
    unsigned sum, cnt, mine, sp = 0u;
    for (;;) {
        sum = 0u; cnt = 0u; mine = 0u;
#pragma unroll
        for (unsigned j = 0; j < 16; ++j) { const unsigned c = xb_ld(&bar[XB_XCNT(j)]); sum += c; cnt += (c > 0u) ? 1u : 0u; mine = (j == x) ? c : mine; }
        if (sum == G) break;
        __builtin_amdgcn_s_sleep(1);
        if ((++sp & 255u) == 0u) { if (xb_ld(&bar[XB_TMO])) break; if (sp > XB_SPIN_CAP) { atomicAdd(&bar[XB_TMO], 1u); break; } }
    }
    nloc = mine > 0u ? mine : 1u; nx = cnt > 0u ? cnt : 1u;
}

__device__ __forceinline__ void xcd_barrier(const XcdBarrier& b) {
    asm volatile("s_waitcnt vmcnt(0)" ::: "memory");
    __syncthreads();
    if (b.wv == 0 && __builtin_amdgcn_mbcnt_hi(~0u, __builtin_amdgcn_mbcnt_lo(~0u, 0u)) == 0u) {
        unsigned* bar = b.bar;
        __builtin_amdgcn_s_waitcnt(0);
        unsigned nloc = b.st[0], nx = b.st[1];
        if (nloc == 0u) { xcd_barrier_complete(bar, b.x, nloc, nx); b.st[0] = nloc; b.st[1] = nx; }
        const unsigned old = xb_add(&bar[XB_XSUB(b.x)], 1u);
        const unsigned gen = old / nloc;
        if (old + 1u == (gen + 1u) * nloc) {
            __builtin_amdgcn_fence(__ATOMIC_RELEASE, "agent");
            asm volatile("s_waitcnt vmcnt(0)" ::: "memory");
            const unsigned og = xb_add(&bar[XB_TOP], 1u);
            const unsigned tg = og / nx;
            if (og + 1u == (tg + 1u) * nx) xb_add(&bar[XB_TOPGEN], 1u);
            else XB_SPIN(xb_ld(&bar[XB_TOPGEN]) == tg, bar);
            __builtin_amdgcn_fence(__ATOMIC_ACQUIRE, "agent");
            xb_add(&bar[XB_XGEN(b.x)], 1u);
            asm volatile("s_waitcnt vmcnt(0)" ::: "memory");
        } else {
            XB_SPIN(xb_ld(&bar[XB_XGEN(b.x)]) == gen, bar);
            __builtin_amdgcn_fence(__ATOMIC_ACQUIRE, "agent");
            asm volatile("s_waitcnt vmcnt(0)" ::: "memory");
        }
    }
    __syncthreads();
}

struct Args { const float* in[17]; float* out; unsigned char* ws; };

DI void transpose_item(const float* W, int K, int N, bf16_t* WT, int k0, int n0, int drow0, LAS float* scr, int lane) {
#pragma unroll 8
    for (int i = 0; i < 32; ++i) { const int kk = 2 * i + (lane >> 5); scr[kk * 33 + (lane & 31)] = W[(size_t)(k0 + kk) * N + n0 + (lane & 31)]; }
    LDS_WAIT();
    const int c = lane & 7;
#pragma unroll
    for (int j = 0; j < 4; ++j) { const int n = (lane >> 3) + 8 * j; const LAS float* s = scr + (8 * c) * 33 + n;
        u32x4 o; o.x = pk2(s[0 * 33], s[1 * 33]); o.y = pk2(s[2 * 33], s[3 * 33]); o.z = pk2(s[4 * 33], s[5 * 33]); o.w = pk2(s[6 * 33], s[7 * 33]);
        *(u32x4*)(WT + (size_t)(drow0 + n) * K + k0 + 8 * c) = o; }
    LDS_WAIT();
}
DI void transpose_matrix(const float* W, int K, int N, bf16_t* WT, bool ffn_in, int& it0, int gw, int ngw, LAS float* scr, int lane) {
    const int nblk = N / 32, nitems = (K / 64) * nblk;
    int first = (gw - it0 % ngw + ngw) % ngw;
    for (int it = first; it < nitems; it += ngw) {
        const int kb = it / nblk, nb = it % nblk, n0 = nb * 32;
        int drow0 = n0;
        if (ffn_in) { const int s = n0 / FF, j = n0 % FF, p = j / 128, jj = j % 128; drow0 = 256 * p + 128 * s + jj; }
        transpose_item(W, K, N, WT, kb * 64, n0, drow0, scr, lane);
    }
    it0 += nitems;
}

DI void mods_phase(int wv, const Args& a, float* mods, LAS unsigned char* lds) {
    const int tid = pg8::pg8_opaque_tid(wv);
    LAS float* sc = (LAS float*)lds;
    LAS float* red = (LAS float*)(lds + 9 * 1024 * 4);
    if ((int)blockIdx.x >= 192) return;
    for (int i = tid; i < 9 * 1024; i += NTHREADS) { const int r = i >> 10, k = i & 1023; const float v = r < 8 ? a.in[1][r * 1024 + k] : a.in[3][k]; sc[i] = siluf(v); }
    __syncthreads();
    for (int it = blockIdx.x; it < 192; it += gridDim.x) {
        const int l = it / 96, n0 = (it % 96) * 64, nl = tid & 63, kp = tid >> 6;
        const float* w = a.in[4] + (size_t)l * 1024 * 6144 + n0 + nl;
        float acc[9];
#pragma unroll
        for (int r = 0; r < 9; ++r) acc[r] = 0.f;
        for (int k = kp * 128; k < kp * 128 + 128; ++k) { const float wv = w[(size_t)k * 6144];
#pragma unroll
            for (int r = 0; r < 9; ++r) acc[r] += sc[r * 1024 + k] * wv; }
#pragma unroll
        for (int r = 0; r < 9; ++r) red[(kp * 9 + r) * 64 + nl] = acc[r];
        __syncthreads();
        for (int i = tid; i < 576; i += NTHREADS) { const int r = i >> 6, n = i & 63; float s = 0.f;
#pragma unroll
            for (int p = 0; p < 8; ++p) s += red[(p * 9 + r) * 64 + n];
            mods[(size_t)(l * 9 + r) * 6144 + n0 + n] = s + a.in[5][l * 6144 + n0 + n]; }
        __syncthreads();
    }
}

DI void tables_phase(int wv, const Args& a, float* ax, float* rt, float* lb, float* rss, int nrss) {
    const int gt = blockIdx.x * NTHREADS + pg8::pg8_opaque_tid(wv), ngt = gridDim.x * NTHREADS;

    for (int i = gt; i < 8192 * 32; i += ngt) { const int t = i >> 5, j = i & 31; const double p = (j < 16) ? (double)(t >> 6) : (double)(t & 63);
        const double inv = pow(10000.0, -(double)(j & 15) / 16.0); const double ang = p * inv;
        ax[i] = (float)cos(ang); ax[8192 * 32 + i] = (float)sin(ang); }
    for (int i = gt; i < 8192 * 128; i += ngt) { const int t = i >> 7, j = i & 127; const double th = pow(10000.0, -(double)j / 127.0); const double ang = (double)t * th;
        rt[i] = (float)cos(ang); rt[8192 * 128 + i] = (float)sin(ang); }
    for (int i = gt; i < 512; i += ngt) { const float a0 = a.in[14][i], a1 = a.in[14][512 + i]; lb[i] = 1.0f / (1.0f + expf(a1 - a0)); }
}


DI void aux_phase(int wv, const float* normg, const float* mods, const bf16_t* wt_fin, const bf16_t* wt_oin, float* gs, float* bias3, float* bias5, float* bias7) {
    const int tid = pg8::pg8_opaque_tid(wv), lane = tid & 63, wave = __builtin_amdgcn_readfirstlane(tid >> 6);
    const int gt = blockIdx.x * NTHREADS + tid, ngt = gridDim.x * NTHREADS;
    for (int i = gt; i < 3 * 9 * 1024; i += ngt) { const int tb = i / 9216, r = (i / 1024) % 9, c = i & 1023;
        const float g = normg[(tb == 0 ? 1024 : (tb == 1 ? 2048 : 3072)) + c];
        const float sc = mods[(size_t)((tb == 0 ? 0 : 9) + r) * 6144 + (tb == 1 ? 1 : 4) * 1024 + c];
        gs[i] = g * (1.0f + sc); }
    const int gw = blockIdx.x * NWAVES + wave, ngw = gridDim.x * NWAVES;
    for (int it = gw; it < 5632 + 6144 + 5632; it += ngw) {
        const bf16_t* wrow; const float* sh; float* dst; int ldb, n;
        if (it < 5632) { n = it; wrow = wt_fin + (size_t)n * 1024; sh = mods + 3 * 1024; dst = bias3; ldb = 5632; }
        else if (it < 5632 + 6144) { n = it - 5632; wrow = wt_oin + (size_t)n * 1024; sh = mods + 9 * 6144; dst = bias5; ldb = 6144; }
        else { n = it - 5632 - 6144; wrow = wt_fin + (size_t)2 * FF * DM + (size_t)n * 1024; sh = mods + 9 * 6144 + 3 * 1024; dst = bias7; ldb = 5632; }
        float w[16]; unpack8(*(const bf16x8*)(wrow + 16 * lane), w); unpack8(*(const bf16x8*)(wrow + 16 * lane + 8), w + 8);
        float keep = 0.f;
#pragma unroll
        for (int r = 0; r < 9; ++r) { const float* sp = sh + (size_t)r * 6144 + 16 * lane; float s = 0.f;
#pragma unroll
            for (int q = 0; q < 4; ++q) { const f32x4 v = *(const f32x4*)(sp + 4 * q); s += (v.x * w[4 * q] + v.y * w[4 * q + 1]) + (v.z * w[4 * q + 2] + v.w * w[4 * q + 3]); }
            s = wave_sum(s); if (lane == r) keep = s; }
        if (lane < 9) dst[(size_t)lane * ldb + n] = keep;
    }
}

DI void normmod_phase(int wv, const float* xlat, const float* xctx, int b0, int nlat, int nrows, const float* g, const float* mods, int sidx, bf16_t* out) {
    const int tid = pg8::pg8_opaque_tid(wv), lane = tid & 63, wave = __builtin_amdgcn_readfirstlane(tid >> 6);
    const int gw = blockIdx.x * NWAVES + wave, ngw = gridDim.x * NWAVES;
    f32x4 gv[4];
#pragma unroll
    for (int j = 0; j < 4; ++j) gv[j] = *(const f32x4*)(g + 4 * lane + 256 * j);
    for (int lr0 = gw * 2; lr0 < nrows; lr0 += ngw * 2) {
        f32x4 v[2][4]; int mrow[2];
#pragma unroll
        for (int u = 0; u < 2; ++u) { const int lr = lr0 + u; const float* src;
            if (lr < nlat) { const size_t grow = (size_t)b0 * 8192 + lr; src = xlat + grow * 1024; mrow[u] = (int)(grow >> 13); }
            else { const size_t crow = (size_t)b0 * 256 + (lr - nlat); src = xctx + crow * 1024; mrow[u] = 8; }
#pragma unroll
            for (int j = 0; j < 4; ++j) v[u][j] = *(const f32x4*)(src + 4 * lane + 256 * j); }
#pragma unroll
        for (int u = 0; u < 2; ++u) { const int lr = lr0 + u; float ss = 0.f;
#pragma unroll
            for (int j = 0; j < 4; ++j) ss += (v[u][j].x * v[u][j].x + v[u][j].y * v[u][j].y) + (v[u][j].z * v[u][j].z + v[u][j].w * v[u][j].w);
            const float r = rsqrtf(wave_sum(ss) * (1.0f / 1024.0f) + EPS);
            const float* sh = mods + (size_t)mrow[u] * 6144 + sidx * 1024; const float* scl = sh + 1024;
#pragma unroll
            for (int j = 0; j < 4; ++j) { const f32x4 s4 = *(const f32x4*)(sh + 4 * lane + 256 * j), c4 = *(const f32x4*)(scl + 4 * lane + 256 * j);
                const f32x4 y = v[u][j] * r * gv[j] * (c4 + 1.0f) + s4;
                u32x2 w; w.x = pk2(y.x, y.y); w.y = pk2(y.z, y.w);
                *(u32x2*)(out + (size_t)lr * 1024 + 4 * lane + 256 * j) = w; } }
    }
}

DI void attn_phase(int wv, const bf16_t* P, bf16_t* mix, const float* qkg, const float* sink, const float* axc, const float* axs, LAS unsigned char* lds) {
    const int tid = pg8::pg8_opaque_tid(wv), lane = tid & 63, wave = __builtin_amdgcn_readfirstlane(tid >> 6);
    const int fr = lane & 15, fq = lane >> 4, g = wave & 3, half = wave >> 2;
    LAS bf16_t* Ks = (LAS bf16_t*)lds; LAS bf16_t* Vl = (LAS bf16_t*)(lds + 46080); LAS bf16_t* Pw = (LAS bf16_t*)(lds + 92160 + wave * 4608);
    for (int it = blockIdx.x; it < 2112; it += gridDim.x) {
        const int qt = it % 132; const int r = it / 132; const int kvh = r & 1, b = r >> 1; const int hq = kvh * 4 + g;
        const bool cq = qt >= 128;
        const int q0 = cq ? (qt - 128) * 64 : qt * 64;
        const size_t qrow0 = cq ? (size_t)NT_LAT + b * 256 + q0 : (size_t)b * 8192 + q0;
        bf16x8 aq[2][2];
#pragma unroll
        for (int mi = 0; mi < 2; ++mi) {
            const int rloc = 32 * half + 16 * mi + fr; const bf16_t* qp = P + (qrow0 + rloc) * EIN + C_AQ + hq * 64;
            float x1[8], x2[8]; unpack8(*(const bf16x8*)(qp + 8 * fq), x1); unpack8(*(const bf16x8*)(qp + 32 + 8 * fq), x2);
            float ss = 0.f;
#pragma unroll
            for (int i = 0; i < 8; ++i) ss += x1[i] * x1[i] + x2[i] * x2[i];
            ss += __shfl_xor(ss, 16); ss += __shfl_xor(ss, 32);
            const float rn = rsqrtf(ss * (1.0f / 64.0f) + EPS);
#pragma unroll
            for (int i = 0; i < 8; ++i) { x1[i] *= rn * qkg[8 * fq + i]; x2[i] *= rn * qkg[32 + 8 * fq + i]; }
            if (!cq) { const int pos = q0 + rloc; const float* cp = axc + pos * 32 + 8 * fq; const float* sp = axs + pos * 32 + 8 * fq;
#pragma unroll
                for (int i = 0; i < 8; ++i) { const float c = cp[i], s = sp[i]; const float o1 = x1[i] * c - x2[i] * s, o2 = x2[i] * c + x1[i] * s; x1[i] = o1; x2[i] = o2; } }
            aq[mi][0] = pack8(x1); aq[mi][1] = pack8(x2); }
        float m_[2], l_[2]; f32x4 oacc[2][4];
        const float sk = sink[hq] * 1.4426950408889634f;
#pragma unroll
        for (int mi = 0; mi < 2; ++mi) { m_[mi] = sk; l_[mi] = 1.0f;
#pragma unroll
            for (int i = 0; i < 4; ++i) oacc[mi][i] = (f32x4){0.f, 0.f, 0.f, 0.f}; }
        for (int round = cq ? 1 : 0; round < 2; ++round) {
            const bool kc = round == 1;
            int kstart, nkeys; size_t krow0;
            if (!kc) { kstart = q0 - 128 < 0 ? 0 : q0 - 128; const int kend = q0 + 192 > 8192 ? 8192 : q0 + 192; nkeys = kend - kstart; krow0 = (size_t)b * 8192 + kstart; }
            else { kstart = 0; nkeys = 256; krow0 = (size_t)NT_LAT + b * 256; }
            __syncthreads();
            for (int task = tid; task < nkeys * 4; task += NTHREADS) {
                const int key = task >> 2, c = task & 3; const bf16_t* kp = P + (krow0 + key) * EIN + C_AK + kvh * 64;
                float x1[8], x2[8]; unpack8(*(const bf16x8*)(kp + 8 * c), x1); unpack8(*(const bf16x8*)(kp + 32 + 8 * c), x2);
                float ss = 0.f;
#pragma unroll
                for (int i = 0; i < 8; ++i) ss += x1[i] * x1[i] + x2[i] * x2[i];
                ss += __shfl_xor(ss, 1); ss += __shfl_xor(ss, 2);
                const float rn = rsqrtf(ss * (1.0f / 64.0f) + EPS);
#pragma unroll
                for (int i = 0; i < 8; ++i) { x1[i] *= rn * qkg[64 + 8 * c + i]; x2[i] *= rn * qkg[64 + 32 + 8 * c + i]; }
                if (!kc) { const int pos = kstart + key; const float* cp = axc + pos * 32 + 8 * c; const float* sp = axs + pos * 32 + 8 * c;
#pragma unroll
                    for (int i = 0; i < 8; ++i) { const float cs = cp[i], sn = sp[i]; const float o1 = x1[i] * cs - x2[i] * sn, o2 = x2[i] * cs + x1[i] * sn; x1[i] = o1; x2[i] = o2; } }
                *(LAS bf16x8*)(Ks + key * 72 + 8 * c) = pack8(x1); *(LAS bf16x8*)(Ks + key * 72 + 32 + 8 * c) = pack8(x2);
            }
            for (int task = tid; task < nkeys * 8; task += NTHREADS) { const int key = task >> 3, c = task & 7;
                *(LAS bf16x8*)(Vl + key * 72 + 8 * c) = *(const bf16x8*)(P + (krow0 + key) * EIN + C_AV + kvh * 64 + 8 * c); }
            __syncthreads();
            for (int kb = 0; kb < (nkeys >> 6); ++kb) {
                const int kpos0 = kstart + 64 * kb;
                if (!kc) { const int rlo = q0 + 32 * half; if (kpos0 + 64 <= rlo - 128 || kpos0 > rlo + 31 + 128) continue; }
                f32x4 sacc[2][4];
#pragma unroll
                for (int n = 0; n < 4; ++n) { sacc[0][n] = (f32x4){0.f, 0.f, 0.f, 0.f}; sacc[1][n] = sacc[0][n];
#pragma unroll
                    for (int ks = 0; ks < 2; ++ks) { const bf16x8 bk = *(const LAS bf16x8*)(Ks + (64 * kb + 16 * n + fr) * 72 + ks * 32 + 8 * fq);
                        sacc[0][n] = MFMA16(bk, aq[0][ks], sacc[0][n]); sacc[1][n] = MFMA16(bk, aq[1][ks], sacc[1][n]); } }
                bf16x8 pf[2][2];
#pragma unroll
                for (int mi = 0; mi < 2; ++mi) {
                    const int qpos = q0 + 32 * half + 16 * mi + fr;
                    float mx = -INFINITY;
#pragma unroll
                    for (int n = 0; n < 4; ++n)
#pragma unroll
                        for (int i = 0; i < 4; ++i) { float s = sacc[mi][n][i] * 0.18033688011112042f;
                            if (!kc) { const int dlt = (kpos0 + 16 * n + 4 * fq + i) - qpos; if (dlt > 128 || dlt < -128) s = -INFINITY; }
                            sacc[mi][n][i] = s; mx = fmaxf(mx, s); }
                    mx = fmaxf(mx, __shfl_xor(mx, 16)); mx = fmaxf(mx, __shfl_xor(mx, 32));
                    const float mn = fmaxf(m_[mi], mx); const float alpha = __builtin_amdgcn_exp2f(m_[mi] - mn); m_[mi] = mn; float rs = 0.f;
#pragma unroll
                    for (int n = 0; n < 4; ++n)
#pragma unroll
                        for (int i = 0; i < 4; ++i) { const float p = __builtin_amdgcn_exp2f(sacc[mi][n][i] - mn); sacc[mi][n][i] = p; rs += p; }
                    rs += __shfl_xor(rs, 16); rs += __shfl_xor(rs, 32);
                    l_[mi] = l_[mi] * alpha + rs;
#pragma unroll
                    for (int nd = 0; nd < 4; ++nd) oacc[mi][nd] *= alpha;
#pragma unroll
                    for (int k2 = 0; k2 < 2; ++k2) { u32x4 w; w.x = pk2(sacc[mi][2 * k2][0], sacc[mi][2 * k2][1]); w.y = pk2(sacc[mi][2 * k2][2], sacc[mi][2 * k2][3]);
                        w.z = pk2(sacc[mi][2 * k2 + 1][0], sacc[mi][2 * k2 + 1][1]); w.w = pk2(sacc[mi][2 * k2 + 1][2], sacc[mi][2 * k2 + 1][3]); pf[mi][k2] = __builtin_bit_cast(bf16x8, w); }
                }
#pragma unroll
                for (int k2 = 0; k2 < 2; ++k2)
#pragma unroll
                    for (int nd = 0; nd < 4; ++nd) {
                        const LAS bf16_t* vp = Vl + (64 * kb + 32 * k2 + 4 * fq + (fr >> 2)) * 72 + 16 * nd + 4 * (fr & 3);
                        const s16x4 lo = __builtin_amdgcn_ds_read_tr16_b64_v4i16((LAS s16x4*)vp), hi = __builtin_amdgcn_ds_read_tr16_b64_v4i16((LAS s16x4*)(vp + 16 * 72));
                        const bf16x8 vf = __builtin_shufflevector(lo, hi, 0, 1, 2, 3, 4, 5, 6, 7);
                        oacc[0][nd] = MFMA16(vf, pf[0][k2], oacc[0][nd]); oacc[1][nd] = MFMA16(vf, pf[1][k2], oacc[1][nd]); }
            }
        }
#pragma unroll
        for (int mi = 0; mi < 2; ++mi) { const float inv = 1.0f / l_[mi]; bf16_t* op = mix + (qrow0 + 32 * half + 16 * mi + fr) * 1024 + hq * 64 + 4 * fq;
#pragma unroll
            for (int nd = 0; nd < 4; ++nd) { const f32x4 r = oacc[mi][nd] * inv; u32x2 w; w.x = pk2(r[0], r[1]); w.y = pk2(r[2], r[3]); *(u32x2*)(op + 16 * nd) = w; } }
    }
}

#define HG_ROW0(n_) ((n_) < 4 ? (size_t)NT_LAT + b * 256 + (dir ? 3 - (n_) : (n_)) * 64 : (size_t)b * 8192 + (dir ? 127 - ((n_) - 4) : (n_) - 4) * 64)
constexpr int HP_QI = 0, HP_QO = 17408, HP_KI = 34816, HP_KP = 52224, HP_V = 69632, HP_PM = 87040, HP_RED = 96256;
DI void hgrn_prep_phase(int wv, const bf16_t* P, bf16_t* mix, bf16_t* ob, const float* lb, bf16_t* sq, bf16_t* sk, float* sd, LAS unsigned char* lds) {
    const int tid = pg8::pg8_opaque_tid(wv), lane = tid & 63, wave = __builtin_amdgcn_readfirstlane(tid >> 6);
    const int fr = lane & 15, fq = lane >> 4;
    LAS bf16_t* Qi = (LAS bf16_t*)(lds + HP_QI); LAS bf16_t* Qo = (LAS bf16_t*)(lds + HP_QO); LAS bf16_t* Ki = (LAS bf16_t*)(lds + HP_KI); LAS bf16_t* Kp = (LAS bf16_t*)(lds + HP_KP);
    LAS bf16_t* Vl = (LAS bf16_t*)(lds + HP_V); LAS bf16_t* Pm = (LAS bf16_t*)(lds + HP_PM); LAS float* red = (LAS float*)(lds + HP_RED);
    const int d = tid & 127, part = tid >> 7, vt = tid >> 3, vc = tid & 7;
    unsigned short fraw[16], qraw[16]; bf16x8 vr0, vr1;
#define HP_LOAD(it_) do { const int n_ = (it_) % 132; const int u_ = (it_) / 132; const int dir = u_ & 1, h = (u_ >> 1) & 3, b = u_ >> 3; const size_t r0_ = HG_ROW0(n_); \
        const int cf_ = (dir ? C_BFB : C_BFF) + h * 128 + d, cq_ = C_BQ + h * 128 + d; \
        _Pragma("unroll") for (int i = 0; i < 16; ++i) { const int t = 16 * part + i; const int tok = dir ? 63 - t : t; const bf16_t* rp = P + (r0_ + tok) * EIN; fraw[i] = rp[cf_]; qraw[i] = rp[cq_]; } \
        { const int tok = dir ? 63 - vt : vt; const bf16_t* vp = P + (r0_ + tok) * EIN + C_BI + h * 128 + 8 * vc; vr0 = *(const bf16x8*)vp; vr1 = *(const bf16x8*)(vp + 64); } } while (0)
    if ((int)blockIdx.x < 8448) HP_LOAD(8447 - (int)blockIdx.x);
    for (int itf = blockIdx.x; itf < 8448; itf += gridDim.x) { const int it = 8447 - itf;
        const int n = it % 132; const int u3 = it / 132; const int dir = u3 & 1, h = (u3 >> 1) & 3, b = u3 >> 3;
        const size_t row0 = HG_ROW0(n);
        const float lbv = lb[h * 128 + d];
        float lf[16], kk[16], qs[16];
#pragma unroll
        for (int i = 0; i < 16; ++i) { const float fr_ = bf2f(fraw[i]), qr = bf2f(qraw[i]); const float f = lbv + (1.0f - lbv) * sigmf(fr_);
            lf[i] = flog(f); kk[i] = 1.0f - f; qs[i] = siluf(qr); }
#pragma unroll
        for (int i = 1; i < 16; ++i) lf[i] += lf[i - 1];
        const bf16x8 vc0 = vr0, vc1 = vr1;
        if (itf + (int)gridDim.x < 8448) HP_LOAD(8447 - (itf + (int)gridDim.x));
        __syncthreads();
        red[part * 128 + d] = lf[15]; if (part == 2) red[512 + d] = lf[0];
        *(LAS bf16x8*)(Vl + vt * 136 + 8 * vc) = vc0; *(LAS bf16x8*)(Vl + vt * 136 + 8 * vc + 64) = vc1;
        __syncthreads();
        {   const float r0 = red[d], r1 = red[128 + d], r2 = red[256 + d], r3 = red[384 + d], l32 = red[512 + d];
            const float pre = part == 0 ? 0.f : (part == 1 ? r0 : (part == 2 ? r0 + r1 : r0 + r1 + r2));
            const float total = (r0 + r1) + (r2 + r3), ref = r0 + r1 + l32;
            const float eref = fexp(ref), etr = fexp(total - ref);
            if (part == 0) sd[(size_t)it * 128 + d] = fexp(total);
            float kp[16];
#pragma unroll
            for (int i = 0; i < 16; ++i) { const float cum = pre + lf[i]; const int t = 16 * part + i;
                const float e1 = fexp(cum - ref), e2 = __builtin_amdgcn_rcpf(e1); const float qe = qs[i] * e1, ke = kk[i] * e2;
                Qi[t * 136 + d] = f2bf(qe); Qo[t * 136 + d] = f2bf(qe * eref); Ki[t * 136 + d] = f2bf(ke); kp[i] = ke * etr; }
            bf16_t* gk = sk + (size_t)it * 8192 + d * 64 + 16 * part;
            *(bf16x8*)gk = pack8(kp); *(bf16x8*)(gk + 8) = pack8(kp + 8); }
        __syncthreads();
        {   bf16_t* gq = sq + (size_t)it * 8192 + vt * 128 + 8 * vc;
            *(bf16x8*)gq = *(const LAS bf16x8*)(Qo + vt * 136 + 8 * vc); *(bf16x8*)(gq + 64) = *(const LAS bf16x8*)(Qo + vt * 136 + 8 * vc + 64); }
        {   const int mt = wave >> 1, nt0 = 2 * (wave & 1); f32x4 sc[2]; sc[0] = (f32x4){0.f, 0.f, 0.f, 0.f}; sc[1] = sc[0];
#pragma unroll
            for (int ks = 0; ks < 4; ++ks) { const bf16x8 a = *(const LAS bf16x8*)(Qi + (16 * mt + fr) * 136 + ks * 32 + 8 * fq);
#pragma unroll
                for (int n2 = 0; n2 < 2; ++n2) { const bf16x8 bb = *(const LAS bf16x8*)(Ki + (16 * (nt0 + n2) + fr) * 136 + ks * 32 + 8 * fq); sc[n2] = MFMA16(a, bb, sc[n2]); } }
#pragma unroll
            for (int n2 = 0; n2 < 2; ++n2)
#pragma unroll
                for (int i = 0; i < 4; ++i) { const int t = 16 * mt + 4 * fq + i, s = 16 * (nt0 + n2) + fr; Pm[t * 72 + s] = f2bf(s <= t ? sc[n2][i] : 0.f); } }
        __syncthreads();
        {   const int mt = wave >> 1, nq = 4 * (wave & 1); f32x4 o[4];
#pragma unroll
            for (int j = 0; j < 4; ++j) o[j] = (f32x4){0.f, 0.f, 0.f, 0.f};
#pragma unroll
            for (int ks = 0; ks < 2; ++ks) { const bf16x8 a = *(const LAS bf16x8*)(Pm + (16 * mt + fr) * 72 + ks * 32 + 8 * fq);
#pragma unroll
                for (int j = 0; j < 4; ++j) { const bf16x8 bb = tr_frag(Vl, 136, 32 * ks, 16 * (nq + j), lane); o[j] = MFMA16(bb, a, o[j]); } }
            {   const int t = 16 * mt + fr; const int tok = dir ? 63 - t : t;
                bf16_t* op = dir ? ob + (row0 + tok) * 512 + h * 128 + 16 * nq + 4 * fq : mix + (row0 + tok) * 1024 + 512 + h * 128 + 16 * nq + 4 * fq;
#pragma unroll
                for (int j = 0; j < 4; ++j) { u32x2 w; w.x = pk2(o[j][0], o[j][1]); w.y = pk2(o[j][2], o[j][3]); *(u32x2*)(op + 16 * j) = w; } } }
    }
}
constexpr int HS_V = 0, HS_ST = 5120;
DI void hgrn_scan_phase(int wv, const bf16_t* P, bf16_t* mix, bf16_t* ob, const bf16_t* sq, const bf16_t* sk, const float* sd, LAS unsigned char* lds) {
    const int tid = pg8::pg8_opaque_tid(wv), lane = tid & 63, wave = __builtin_amdgcn_readfirstlane(tid >> 6);
    const int fr = lane & 15, fq = lane >> 4;
    LAS bf16_t* Vl = (LAS bf16_t*)(lds + HS_V); LAS bf16_t* St = (LAS bf16_t*)(lds + HS_ST);
    const int vt = tid >> 2, vc = tid & 3, mt = wave >> 1, nt = wave & 1;
    for (int unit = blockIdx.x; unit < 256; unit += gridDim.x) {
        const int gx = (unit & 7) * 8 + (unit >> 5), sl = (unit >> 3) & 3, dir = gx & 1, h = (gx >> 1) & 3, b = gx >> 3;
        const size_t item0 = (size_t)(((b * 4 + h) * 2 + dir) * 132);
        __syncthreads();
        for (int i = tid; i < 8704 / 4; i += NTHREADS) ((LAS unsigned*)(lds + HS_ST))[i] = 0u;
        f32x4 sacc[2]; sacc[0] = (f32x4){0.f, 0.f, 0.f, 0.f}; sacc[1] = sacc[0];
        bf16x8 aq[2][4], ak[2][2], vv[2]; f32x4 dv[2]; u32x2 oold[2];
        vv[0] = (bf16x8){0, 0, 0, 0, 0, 0, 0, 0}; vv[1] = vv[0];
        const int otok = dir ? 63 - (16 * mt + fr) : 16 * mt + fr;
        bf16_t* obase = dir ? ob + (size_t)otok * 512 + h * 128 + sl * 32 + 16 * nt + 4 * fq : mix + (size_t)otok * 1024 + 512 + h * 128 + sl * 32 + 16 * nt + 4 * fq;
        const int ostr = dir ? 512 : 1024;
#define HS_LOAD(s_, n_) do { const size_t it_ = item0 + (n_); const size_t r0_ = HG_ROW0(n_); \
            const bf16_t* gq = sq + it_ * 8192 + (16 * mt + fr) * 128 + 8 * fq; const bf16_t* gk = sk + it_ * 8192 + (16 * wave + fr) * 64 + 8 * fq; \
            _Pragma("unroll") for (int ks = 0; ks < 4; ++ks) aq[s_][ks] = *(const bf16x8*)(gq + 32 * ks); \
            ak[s_][0] = *(const bf16x8*)gk; ak[s_][1] = *(const bf16x8*)(gk + 32); \
            if (tid < 256) { const int tok = dir ? 63 - vt : vt; vv[s_] = *(const bf16x8*)(P + (r0_ + tok) * EIN + C_BI + h * 128 + sl * 32 + 8 * vc); } \
            dv[s_] = *(const f32x4*)(sd + it_ * 128 + 16 * wave + 4 * fq); \
            oold[s_] = *(const u32x2*)(obase + r0_ * ostr); } while (0)
        HS_LOAD(0, 0); HS_LOAD(1, 1);
        for (int n0 = 0; n0 < 132; n0 += 2) {
#pragma unroll
          for (int s = 0; s < 2; ++s) {
            const int n = n0 + s;
            const size_t row0 = HG_ROW0(n);
            if (tid < 256) *(LAS bf16x8*)(Vl + vt * 40 + 8 * vc) = vv[s];
            bf16x8 a4[4], k2[2]; f32x4 o, d4 = dv[s];
#pragma unroll
            for (int ks = 0; ks < 4; ++ks) a4[ks] = aq[s][ks];
            k2[0] = ak[s][0]; k2[1] = ak[s][1];
            o[0] = __uint_as_float(oold[s].x << 16); o[1] = __uint_as_float(oold[s].x & 0xffff0000u); o[2] = __uint_as_float(oold[s].y << 16); o[3] = __uint_as_float(oold[s].y & 0xffff0000u);
            if (n + 2 < 132) HS_LOAD(s, n + 2);
            __syncthreads();
            {
#pragma unroll
                for (int ks = 0; ks < 4; ++ks) { const bf16x8 bb = *(const LAS bf16x8*)(St + (16 * nt + fr) * 136 + ks * 32 + 8 * fq); o = MFMA16(bb, a4[ks], o); }
                u32x2 w; w.x = pk2(o[0], o[1]); w.y = pk2(o[2], o[3]); *(u32x2*)(obase + row0 * ostr) = w; }
            {   sacc[0] *= d4; sacc[1] *= d4;
#pragma unroll
                for (int ks = 0; ks < 2; ++ks) {
#pragma unroll
                    for (int et = 0; et < 2; ++et) { const bf16x8 bb = tr_frag(Vl, 40, 32 * ks, 16 * et, lane); sacc[et] = MFMA16(k2[ks], bb, sacc[et]); } } }
            __syncthreads();
#pragma unroll
            for (int et = 0; et < 2; ++et) { u32x2 w; w.x = pk2(sacc[et][0], sacc[et][1]); w.y = pk2(sacc[et][2], sacc[et][3]);
                *(LAS u32x2*)(St + (16 * et + fr) * 136 + 16 * wave + 4 * fq) = w; }
          }
        }
#undef HS_LOAD
    }
}
#undef HP_LOAD
#undef HG_ROW0
DI void hgrn_norm_phase(int wv, const bf16_t* P, bf16_t* mix, const bf16_t* ob, const float* outg) {
    const int tid = pg8::pg8_opaque_tid(wv), lane = tid & 63, wave = __builtin_amdgcn_readfirstlane(tid >> 6);
    const int gw = blockIdx.x * NWAVES + wave, ngw = gridDim.x * NWAVES;
    float gv[8];
#pragma unroll
    for (int i = 0; i < 8; ++i) gv[i] = outg[8 * (lane & 15) + i];
    for (int row0 = gw * 4; row0 < NT_ALL; row0 += ngw * 4) {
        bf16x8 a[4], b[4], g[4];
#pragma unroll
        for (int u = 0; u < 4; ++u) { const size_t row = (size_t)row0 + u;
            a[u] = *(const bf16x8*)(mix + row * 1024 + 512 + 8 * lane); b[u] = *(const bf16x8*)(ob + row * 512 + 8 * lane); g[u] = *(const bf16x8*)(P + row * EIN + C_BG + 8 * lane); }
#pragma unroll
        for (int u = 0; u < 4; ++u) { const size_t row = (size_t)row0 + u;
            float of[8], o2[8], gg[8]; unpack8(a[u], of); unpack8(b[u], o2); unpack8(g[u], gg);
            float ss = 0.f;
#pragma unroll
            for (int i = 0; i < 8; ++i) { of[i] += o2[i]; ss += of[i] * of[i]; }
            ss += __shfl_xor(ss, 1); ss += __shfl_xor(ss, 2); ss += __shfl_xor(ss, 4); ss += __shfl_xor(ss, 8);
            const float rn = rsqrtf(ss * (1.0f / 128.0f) + EPS);
#pragma unroll
            for (int i = 0; i < 8; ++i) of[i] = of[i] * rn * gv[i] * siluf(gg[i]);
            *(bf16x8*)(mix + row * 1024 + 512 + 8 * lane) = pack8(of); }
    }
}

constexpr int RI_Q = 0, RI_K = 33792, RI_V = 67584, RI_PM = 134144;
DI void ret_intra_norm_phase(int wv, const bf16_t* P1, bf16_t* ofw, const bf16_t* obw, LAS unsigned char* lds) {
    const int tid = pg8::pg8_opaque_tid(wv), lane = tid & 63, wave = __builtin_amdgcn_readfirstlane(tid >> 6);
    const int fr = lane & 15, fq = lane >> 4;
    LAS bf16_t* Q = (LAS bf16_t*)(lds + RI_Q); LAS bf16_t* K = (LAS bf16_t*)(lds + RI_K); LAS bf16_t* Vl = (LAS bf16_t*)(lds + RI_V); LAS bf16_t* Pm = (LAS bf16_t*)(lds + RI_PM);
    const int pt = tid >> 3, pc = tid & 7;
    bf16x8 qv[4], kv[4], vv[8];
#define RI_LOAD(it_) do { const int h_ = ((it_) >> 7) & 3; const bf16_t* rp_ = P1 + ((size_t)((it_) >> 9) * 8192 + ((it_) & 127) * 64 + pt) * OIN; \
        _Pragma("unroll") for (int j = 0; j < 4; ++j) { qv[j] = *(const bf16x8*)(rp_ + C_RQ + h_ * 256 + 64 * j + 8 * pc); kv[j] = *(const bf16x8*)(rp_ + C_RK + h_ * 256 + 64 * j + 8 * pc); } \
        _Pragma("unroll") for (int j = 0; j < 8; ++j) vv[j] = *(const bf16x8*)(rp_ + C_RV + h_ * 512 + 8 * pc + 64 * j); } while (0)
    if ((int)blockIdx.x < 2048) RI_LOAD(2047 - (int)blockIdx.x);
    for (int itf = blockIdx.x; itf < 2048; itf += gridDim.x) { const int it = 2047 - itf;
        const int cc = it & 127, h = (it >> 7) & 3, bl = it >> 9;
        const float lgf = log2f(1.0f - exp2f(-5.0f - (float)h)), lgb = log2f(1.0f - exp2f(-5.0f - (float)(3 - h)));
        const size_t row0 = (size_t)bl * 8192 + cc * 64;
        __syncthreads();
#pragma unroll
        for (int j = 0; j < 4; ++j) { *(LAS bf16x8*)(Q + pt * 264 + 64 * j + 8 * pc) = qv[j]; *(LAS bf16x8*)(K + pt * 264 + 64 * j + 8 * pc) = kv[j]; }
#pragma unroll
        for (int j = 0; j < 8; ++j) *(LAS bf16x8*)(Vl + pt * 520 + 8 * pc + 64 * j) = vv[j];
        if (itf + (int)gridDim.x < 2048) RI_LOAD(2047 - (itf + (int)gridDim.x));
        __syncthreads();
        {   const int mt = wave >> 1, nt0 = 2 * (wave & 1); f32x4 sc[2]; sc[0] = (f32x4){0.f, 0.f, 0.f, 0.f}; sc[1] = sc[0];
#pragma unroll
            for (int ks = 0; ks < 8; ++ks) { const bf16x8 a = *(const LAS bf16x8*)(Q + (16 * mt + fr) * 264 + ks * 32 + 8 * fq);
#pragma unroll
                for (int n2 = 0; n2 < 2; ++n2) { const bf16x8 bb = *(const LAS bf16x8*)(K + (16 * (nt0 + n2) + fr) * 264 + ks * 32 + 8 * fq); sc[n2] = MFMA16(a, bb, sc[n2]); } }
#pragma unroll
            for (int n2 = 0; n2 < 2; ++n2)
#pragma unroll
                for (int i = 0; i < 4; ++i) { const int t = 16 * mt + 4 * fq + i, s = 16 * (nt0 + n2) + fr; const int dl = t - s;
                    const float w = dl > 0 ? exp2f((float)dl * lgf) : (dl < 0 ? exp2f((float)(-dl) * lgb) : 2.0f);
                    Pm[t * 72 + s] = f2bf(sc[n2][i] * w); } }
        __syncthreads();
        {   f32x4 o[4][4];
#pragma unroll
            for (int mt = 0; mt < 4; ++mt)
#pragma unroll
                for (int j = 0; j < 4; ++j) o[mt][j] = (f32x4){0.f, 0.f, 0.f, 0.f};
#pragma unroll
            for (int ks = 0; ks < 2; ++ks) { bf16x8 bb[4];
#pragma unroll
                for (int j = 0; j < 4; ++j) bb[j] = tr_frag(Vl, 520, 32 * ks, 16 * (4 * wave + j), lane);
#pragma unroll
                for (int mt = 0; mt < 4; ++mt) { const bf16x8 a = *(const LAS bf16x8*)(Pm + (16 * mt + fr) * 72 + ks * 32 + 8 * fq);
#pragma unroll
                    for (int j = 0; j < 4; ++j) o[mt][j] = MFMA16(bb[j], a, o[mt][j]); } }
            LAS float* red = (LAS float*)(lds + RI_PM + 9216);
            u32x2 gq[4][4];
#pragma unroll
            for (int mt = 0; mt < 4; ++mt) { const size_t grow = row0 + 16 * mt + fr; const int col = h * 512 + 64 * wave + 4 * fq; float ss = 0.f;
                u32x2 a[4], b[4];
#pragma unroll
                for (int j = 0; j < 4; ++j) { a[j] = *(const u32x2*)(ofw + grow * 2048 + col + 16 * j); b[j] = *(const u32x2*)(obw + grow * 2048 + col + 16 * j); gq[mt][j] = *(const u32x2*)(P1 + grow * OIN + C_RG + col + 16 * j); }
#pragma unroll
                for (int j = 0; j < 4; ++j) { f32x4 v = o[mt][j];
                    v[0] += __uint_as_float(a[j].x << 16) + __uint_as_float(b[j].x << 16); v[1] += __uint_as_float(a[j].x & 0xffff0000u) + __uint_as_float(b[j].x & 0xffff0000u);
                    v[2] += __uint_as_float(a[j].y << 16) + __uint_as_float(b[j].y << 16); v[3] += __uint_as_float(a[j].y & 0xffff0000u) + __uint_as_float(b[j].y & 0xffff0000u);
                    o[mt][j] = v; ss += (v[0] * v[0] + v[1] * v[1]) + (v[2] * v[2] + v[3] * v[3]); }
                ss += __shfl_xor(ss, 16); ss += __shfl_xor(ss, 32);
                if (fq == 0) red[(16 * mt + fr) * 8 + wave] = ss; }
            __syncthreads();
#pragma unroll
            for (int mt = 0; mt < 4; ++mt) { const size_t grow = row0 + 16 * mt + fr; const int col = h * 512 + 64 * wave + 4 * fq;
                const f32x4 r0 = *(const LAS f32x4*)(red + (16 * mt + fr) * 8), r1 = *(const LAS f32x4*)(red + (16 * mt + fr) * 8 + 4);
                const float rn = rsqrtf((((r0[0] + r0[1]) + (r0[2] + r0[3])) + ((r1[0] + r1[1]) + (r1[2] + r1[3]))) * (1.0f / 512.0f) + EPS);
#pragma unroll
                for (int j = 0; j < 4; ++j) { const f32x4 v = o[mt][j];
                    const float g0 = __uint_as_float(gq[mt][j].x << 16), g1 = __uint_as_float(gq[mt][j].x & 0xffff0000u), g2 = __uint_as_float(gq[mt][j].y << 16), g3 = __uint_as_float(gq[mt][j].y & 0xffff0000u);
                    u32x2 w; w.x = pk2(v[0] * rn * siluf(g0), v[1] * rn * siluf(g1)); w.y = pk2(v[2] * rn * siluf(g2), v[3] * rn * siluf(g3));
                    *(u32x2*)(ofw + grow * 2048 + col + 16 * j) = w; } } }
    }
}
#undef RI_LOAD
constexpr int RT_Q = 0, RT_K = 33792, RT_VS = 67584, RT_ST = 76800;
DI void ret_scan_phase(int wv, const bf16_t* P1, bf16_t* ofw, bf16_t* obw, LAS unsigned char* lds) {
    const int tid = pg8::pg8_opaque_tid(wv), lane = tid & 63, wave = __builtin_amdgcn_readfirstlane(tid >> 6);
    const int fr = lane & 15, fq = lane >> 4;
    LAS bf16_t* Q = (LAS bf16_t*)(lds + RT_Q); LAS bf16_t* K = (LAS bf16_t*)(lds + RT_K); LAS bf16_t* Vs = (LAS bf16_t*)(lds + RT_VS); LAS bf16_t* St = (LAS bf16_t*)(lds + RT_ST);
    const int mt = wave >> 1, et0 = 2 * (wave & 1);
    for (int unit = blockIdx.x; unit < 256; unit += gridDim.x) {
        const int gx = (unit & 7) * 4 + (unit >> 6), sl = (unit >> 3) & 7, dir = gx & 1, h = (gx >> 1) & 3, bl = gx >> 3;
        const int hh = dir ? 3 - h : h;
        const float lg2 = log2f(1.0f - exp2f(-5.0f - (float)hh));
        const float g64 = exp2f(64.0f * lg2);
        __syncthreads();
        for (int i = tid; i < 33792 / 4; i += NTHREADS) ((LAS unsigned*)(lds + RT_ST))[i] = 0u;
        f32x4 sacc[2][4];
#pragma unroll
        for (int a = 0; a < 2; ++a)
#pragma unroll
            for (int e = 0; e < 4; ++e) sacc[a][e] = (f32x4){0.f, 0.f, 0.f, 0.f};
        const int pt = tid >> 3, pc = tid & 7;
        const int ptok = dir ? 63 - pt : pt;
        const float vscl = exp2f((float)(63 - pt) * lg2);
        const float rsc = exp2f((float)(16 * mt + fr + 1) * lg2);
        bf16x8 qv[2][4], kv[2][4], vv[2];
        const int otok = dir ? 63 - (16 * mt + fr) : 16 * mt + fr;
        bf16_t* obase = (dir ? obw : ofw) + (size_t)otok * 2048 + h * 512 + sl * 64 + 16 * et0 + 4 * fq;
#define RT_ROW0(n_) ((n_) < 4 ? (size_t)32768 + bl * 256 + (dir ? 3 - (n_) : (n_)) * 64 : (size_t)bl * 8192 + (dir ? 127 - ((n_) - 4) : (n_) - 4) * 64)
#define RT_LOAD(s_, n_) do { const size_t r0_ = RT_ROW0(n_); const bf16_t* rp_ = P1 + (r0_ + ptok) * OIN; \
            _Pragma("unroll") for (int j = 0; j < 4; ++j) { qv[s_][j] = *(const bf16x8*)(rp_ + C_RQ + h * 256 + 64 * j + 8 * pc); kv[s_][j] = *(const bf16x8*)(rp_ + C_RK + h * 256 + 64 * j + 8 * pc); } \
            vv[s_] = *(const bf16x8*)(rp_ + C_RV + h * 512 + sl * 64 + 8 * pc); } while (0)
        RT_LOAD(0, 0); RT_LOAD(1, 1);
        for (int n0 = 0; n0 < 132; n0 += 2) {
#pragma unroll
          for (int s = 0; s < 2; ++s) {
            const int n = n0 + s;
            const bool is_ctx = n < 4; const size_t row0 = RT_ROW0(n);
#pragma unroll
            for (int j = 0; j < 4; ++j) { *(LAS bf16x8*)(Q + pt * 264 + 64 * j + 8 * pc) = qv[s][j]; *(LAS bf16x8*)(K + pt * 264 + 64 * j + 8 * pc) = kv[s][j]; }
            {   float vf[8]; unpack8(vv[s], vf);
#pragma unroll
                for (int i = 0; i < 8; ++i) vf[i] *= vscl;
                *(LAS bf16x8*)(Vs + pt * 72 + 8 * pc) = pack8(vf); }
            if (n + 2 < 132) RT_LOAD(s, n + 2);
            __syncthreads();
            if (!is_ctx) { f32x4 oi[2]; oi[0] = (f32x4){0.f, 0.f, 0.f, 0.f}; oi[1] = oi[0];
#pragma unroll
                for (int ks = 0; ks < 8; ++ks) { const bf16x8 a = *(const LAS bf16x8*)(Q + (16 * mt + fr) * 264 + ks * 32 + 8 * fq);
#pragma unroll
                    for (int e2 = 0; e2 < 2; ++e2) { const bf16x8 bb = *(const LAS bf16x8*)(St + (16 * (et0 + e2) + fr) * 264 + ks * 32 + 8 * fq); oi[e2] = MFMA16(bb, a, oi[e2]); } }
#pragma unroll
                for (int e2 = 0; e2 < 2; ++e2) { const f32x4 r = oi[e2] * rsc; u32x2 w; w.x = pk2(r[0], r[1]); w.y = pk2(r[2], r[3]); *(u32x2*)(obase + row0 * 2048 + 16 * e2) = w; } }
            {
#pragma unroll
                for (int dt = 0; dt < 2; ++dt)
#pragma unroll
                    for (int et = 0; et < 4; ++et) sacc[dt][et] *= g64;
#pragma unroll
                for (int ks = 0; ks < 2; ++ks) { bf16x8 bb[4];
#pragma unroll
                    for (int et = 0; et < 4; ++et) bb[et] = tr_frag(Vs, 72, 32 * ks, 16 * et, lane);
#pragma unroll
                    for (int dt = 0; dt < 2; ++dt) { const bf16x8 a = tr_frag(K, 264, 32 * ks, 16 * (2 * wave + dt), lane);
#pragma unroll
                        for (int et = 0; et < 4; ++et) sacc[dt][et] = MFMA16(a, bb[et], sacc[dt][et]); } } }
            __syncthreads();
#pragma unroll
            for (int dt = 0; dt < 2; ++dt)
#pragma unroll
                for (int et = 0; et < 4; ++et) { u32x2 w; w.x = pk2(sacc[dt][et][0], sacc[dt][et][1]); w.y = pk2(sacc[dt][et][2], sacc[dt][et][3]);
                    *(LAS u32x2*)(St + (16 * et + fr) * 264 + 16 * (2 * wave + dt) + 4 * fq) = w; }
          }
        }
#undef RT_LOAD
#undef RT_ROW0
    }
}
DI void ret_norm_phase(int wv, const bf16_t* P1, bf16_t* ofw, const bf16_t* obw) {
    const int tid = pg8::pg8_opaque_tid(wv), lane = tid & 63, wave = __builtin_amdgcn_readfirstlane(tid >> 6);
    const int gw = blockIdx.x * NWAVES + wave, ngw = gridDim.x * NWAVES;
    for (int idx0 = gw * 4; idx0 < 32768 * 4; idx0 += ngw * 4) {
        bf16x8 a[4], b[4], g[4];
#pragma unroll
        for (int u = 0; u < 4; ++u) { const int idx = idx0 + u; const int row = idx >> 2, h = idx & 3;
            a[u] = *(const bf16x8*)(ofw + (size_t)row * 2048 + h * 512 + 8 * lane); b[u] = *(const bf16x8*)(obw + (size_t)row * 2048 + h * 512 + 8 * lane);
            g[u] = *(const bf16x8*)(P1 + (size_t)row * OIN + C_RG + h * 512 + 8 * lane); }
#pragma unroll
        for (int u = 0; u < 4; ++u) { const int idx = idx0 + u; const int row = idx >> 2, h = idx & 3;
            float of[8], o2[8], gg[8]; unpack8(a[u], of); unpack8(b[u], o2); unpack8(g[u], gg);
            float ss = 0.f;
#pragma unroll
            for (int i = 0; i < 8; ++i) { of[i] += o2[i]; ss += of[i] * of[i]; }
            const float rn = rsqrtf(wave_sum(ss) * (1.0f / 512.0f) + EPS);
#pragma unroll
            for (int i = 0; i < 8; ++i) of[i] = of[i] * rn * siluf(gg[i]);
            *(bf16x8*)(ofw + (size_t)row * 2048 + h * 512 + 8 * lane) = pack8(of); }
    }
}

template <class Epi>
DI void run_gemm(int wv, LAS unsigned char* lds, const bf16_t* A, const bf16_t* Bt, int M, int N, int K, const Epi& E, int rev = 0) {
    pg8::Gemm g{A, Bt, M, N, K}; pg8::StaticOrder S; S.init(M, N, (int)gridDim.x, (int)blockIdx.x, rev);
    pg8::gemm_phase<Epi, pg8::StaticOrder, false>(lds, g, S, E, nullptr, wv);
}

__global__ void __launch_bounds__(NTHREADS, 2) fwd_megakernel(Args a) {
    extern __shared__ __attribute__((aligned(16))) unsigned char lds_raw[];
    LAS unsigned char* lds = (LAS unsigned char*)lds_raw;
    cg::grid_group grid = cg::this_grid();
    const int wave_s = __builtin_amdgcn_readfirstlane((int)(threadIdx.x >> 6));
    volatile LAS unsigned* xbst = (volatile LAS unsigned*)(lds + 157680);
    if (threadIdx.x < 4) xbst[threadIdx.x] = 0u;
    __syncthreads();
    (void)xcd_barrier_post((unsigned*)(a.ws + WS_BAR), xbst);
#define GBAR() do { XcdBarrier xb_; xb_.bar = (unsigned*)(a.ws + WS_BAR); xb_.x = xb_xcc_id(); xb_.wv = wave_s; xb_.st = (volatile LAS unsigned*)(lds + 157680); xcd_barrier(xb_); } while (0)
    unsigned char* ws = a.ws;
    bf16_t* wt_ein = (bf16_t*)(ws + WS_WT_EIN); bf16_t* wt_eout = (bf16_t*)(ws + WS_WT_EOUT); bf16_t* wt_oin = (bf16_t*)(ws + WS_WT_OIN); bf16_t* wt_oout = (bf16_t*)(ws + WS_WT_OOUT);
    bf16_t* wt_fin = (bf16_t*)(ws + WS_WT_FIN); bf16_t* wt_fout = (bf16_t*)(ws + WS_WT_FOUT);
    float* mods = (float*)(ws + WS_MODS); float* axt = (float*)(ws + WS_ROPE_AX); float* rtt = (float*)(ws + WS_ROPE_RT); float* lb = (float*)(ws + WS_LB);
    float* gs = (float*)(ws + WS_GS); float* bias3 = (float*)(ws + WS_BIAS3); float* bias5 = (float*)(ws + WS_BIAS5); float* bias7 = (float*)(ws + WS_BIAS7);
    float* rss_a = (float*)(ws + WS_RSS_A); float* rss_b = (float*)(ws + WS_RSS_B); float* rss_c = (float*)(ws + WS_RSS_C);
    float* ctxr = (float*)(ws + WS_CTXR); bf16_t* ha = (bf16_t*)(ws + WS_HA); bf16_t* obuf = (bf16_t*)(ws + WS_OB); bf16_t* big = (bf16_t*)(ws + WS_BIG);
    bf16_t* ofw = (bf16_t*)(ws + WS_OFW); bf16_t* obw = (bf16_t*)(ws + WS_OBW);
    const float* x = a.in[0]; const float* ctx = a.in[2]; const float* normg = a.in[6]; float* out = a.out;

    mods_phase(wave_s, a, mods, lds);
    __syncthreads();
    tables_phase(wave_s, a, axt, rtt, lb, rss_a, (int)((WS_HA - WS_RSS_A) / 4));
    {   const int tid = pg8::pg8_opaque_tid(wave_s), lane = tid & 63, wave = __builtin_amdgcn_readfirstlane(tid >> 6);
        LAS float* scr = (LAS float*)(lds + wave * 16384);
        const int gw = blockIdx.x * NWAVES + wave, ngw = gridDim.x * NWAVES; int it0 = 0;
        transpose_matrix(a.in[9], DM, EIN, wt_ein, false, it0, gw, ngw, scr, lane);
        transpose_matrix(a.in[10], DM, DM, wt_eout, false, it0, gw, ngw, scr, lane);
        transpose_matrix(a.in[15], DM, OIN, wt_oin, false, it0, gw, ngw, scr, lane);
        transpose_matrix(a.in[16], 2048, DM, wt_oout, false, it0, gw, ngw, scr, lane);
        transpose_matrix(a.in[7], DM, 2 * FF, wt_fin, true, it0, gw, ngw, scr, lane);
        transpose_matrix(a.in[7] + (size_t)DM * 2 * FF, DM, 2 * FF, wt_fin + (size_t)2 * FF * DM, true, it0, gw, ngw, scr, lane);
        transpose_matrix(a.in[8], FF, DM, wt_fout, false, it0, gw, ngw, scr, lane);
        transpose_matrix(a.in[8] + (size_t)FF * DM, FF, DM, wt_fout + (size_t)DM * FF, false, it0, gw, ngw, scr, lane);
    }
    grid.sync();

    const float* mods0 = mods; const float* mods1 = mods + 9 * 6144;
    normmod_phase(wave_s, x, ctx, 0, NT_LAT, NT_ALL, normg + 0, mods0, 0, ha);
    aux_phase(wave_s, normg, mods, wt_fin, wt_oin, gs, bias3, bias5, bias7);
    GBAR();
    {   pg8::EpiStoreBf16 E{big, EIN}; run_gemm(wave_s, lds, ha, wt_ein, NT_ALL, EIN, DM, E); }
    GBAR();
    bf16_t* hsq = big + (size_t)NT_ALL * EIN; bf16_t* hsk = hsq + (size_t)8448 * 8192; float* hsd = (float*)(hsk + (size_t)8448 * 8192);
    hgrn_prep_phase(wave_s, big, ha, obuf, lb, hsq, hsk, hsd, lds);
    GBAR();
    hgrn_scan_phase(wave_s, big, ha, obuf, hsq, hsk, hsd, lds);
    __syncthreads();
    attn_phase(wave_s, big, ha, a.in[11], a.in[12], axt, axt + 8192 * 32, lds);
    GBAR();
    hgrn_norm_phase(wave_s, big, ha, obuf, a.in[13]);
    GBAR();
    bf16_t* a3 = big + (size_t)NT_ALL * FF;
    {   pg8::EpiResid<true> E{x, out, ctx, ctxr, mods0 + 2 * 1024, 0, NT_LAT, a3, rss_a, gs, 0}; run_gemm(wave_s, lds, ha, wt_eout, NT_ALL, DM, DM, E); }
    GBAR();
    {   pg8::EpiSwiglu E{big, FF, pg8::RowNorm{rss_a, bias3, 5632, 0, NT_LAT}}; run_gemm(wave_s, lds, a3, wt_fin, NT_ALL, 2 * FF, DM, E); }
    GBAR();
    {   pg8::EpiResid<true> E{out, out, ctxr, ctxr, mods0 + 5 * 1024, 0, NT_LAT, ha, rss_b, gs + 9 * 1024, 1}; run_gemm(wave_s, lds, big, wt_fout, NT_ALL, DM, FF, E, 1); }
    GBAR();

    bf16_t* a7 = obuf;
    for (int hb = 0; hb < 2; ++hb) {
        const int b0 = 4 * hb;
        {   pg8::EpiRopeStore E{big, OIN, rtt, rtt + 8192 * 128, 32768, pg8::RowNorm{rss_b + (size_t)hb * 33792 * 16, bias5, 6144, b0, 32768}}; run_gemm(wave_s, lds, ha + (size_t)hb * 33792 * DM, wt_oin, 33792, OIN, DM, E); }
        GBAR();
        ret_scan_phase(wave_s, big, ofw, obw, lds);
        GBAR();
        ret_intra_norm_phase(wave_s, big, ofw, obw, lds);
        GBAR();
        {   pg8::EpiResid<true> E{out, out, ctxr, ctxr, mods1 + 2 * 1024, b0, 32768, a7, rss_c + (size_t)hb * 32768 * 16, gs + 18 * 1024, 0}; run_gemm(wave_s, lds, ofw, wt_oout, 32768, DM, 2048, E); }
        GBAR();
        {   pg8::EpiSwiglu E{big, FF, pg8::RowNorm{rss_c + (size_t)hb * 32768 * 16, bias7, 5632, b0, 32768}}; run_gemm(wave_s, lds, a7, wt_fin + (size_t)2 * FF * DM, 32768, 2 * FF, DM, E); }
        GBAR();
        {   pg8::EpiResid<false> E{out, out, ctxr, ctxr, mods1 + 5 * 1024, b0, 32768, nullptr, nullptr, nullptr, 0}; run_gemm(wave_s, lds, big, wt_fout + (size_t)DM * FF, 32768, DM, FF, E, 1); }
        GBAR();
    }
}

extern "C" void kernel_launch(void* const* d_in, const int* in_sizes, int n_in, void* d_out, int out_size, void* d_ws, size_t ws_size, hipStream_t stream) {
    static int grid = 0;
    if (grid == 0) {
        if (n_in != 17 || ws_size < WS_END) { fprintf(stderr, "kernel_launch: need 17 inputs and >= %zu bytes of workspace (got %d, %zu)\n", (size_t)WS_END, n_in, ws_size); grid = -1; return; }
        int dev = 0, cus = 0, per_cu = 0;
        hipGetDevice(&dev); hipDeviceGetAttribute(&cus, hipDeviceAttributeMultiprocessorCount, dev);
        if (hipFuncSetAttribute((const void*)fwd_megakernel, hipFuncAttributeMaxDynamicSharedMemorySize, LDS_BYTES) != hipSuccess) { fprintf(stderr, "kernel_launch: hipFuncSetAttribute failed\n"); grid = -1; return; }
        if (hipOccupancyMaxActiveBlocksPerMultiprocessor(&per_cu, (const void*)fwd_megakernel, NTHREADS, LDS_BYTES) != hipSuccess || per_cu < 1) { fprintf(stderr, "kernel_launch: occupancy query says %d\n", per_cu); per_cu = 1; }
        (void)hipGetLastError();
        grid = cus * 1;
    }
    if (grid < 0) return;
    if (hipMemsetAsync((char*)d_ws + WS_BAR, 0, 4096 * 4, stream) != hipSuccess) { fprintf(stderr, "kernel_launch: memset of barrier words failed\n"); return; }
    Args a{};
    for (int i = 0; i < 17; ++i) a.in[i] = (const float*)d_in[i];
    a.out = (float*)d_out; a.ws = (unsigned char*)d_ws;
    void* args[] = {&a};
    hipError_t e = hipLaunchCooperativeKernel((const void*)fwd_megakernel, dim3(grid), dim3(NTHREADS), args, LDS_BYTES, stream);
    if (e != hipSuccess) fprintf(stderr, "cooperative launch failed: %s (grid %d)\n", hipGetErrorString(e), grid);
}
```

```cpp
#include <hip/hip_runtime.h>
#include <hip/hip_cooperative_groups.h>
#include <cstdio>
namespace cg = cooperative_groups;

#define DI __device__ __forceinline__
#define LAS __attribute__((address_space(3)))
namespace pg8 {
#define PG8_LAS __attribute__((address_space(3)))
typedef unsigned short bf16_t;
typedef short bf16x8 __attribute__((ext_vector_type(8)));
typedef float f32x4 __attribute__((ext_vector_type(4)));
typedef unsigned u32x4 __attribute__((ext_vector_type(4)));
constexpr int BM = 256, BK = 64, HALF = 128, HTB = HALF * BK * 2  , STAGE_BYTES = 8 * HTB, NXCD = 8, WGM = 4;

__host__ __device__ __forceinline__ int lds_byte(int r, int c) { const int st = (r >> 4) * 2 + (c >> 5), rr = r & 15, cc = c & 31, ob = rr * 64 + cc * 2; return st * 1024 + (ob ^ (((ob >> 9) & 1) << 5)); }
__host__ __device__ __forceinline__ void stage_rc(int b, int& R, int& C) { const int st = b / 1024, sb = b % 1024, swz = sb ^ (((sb >> 9) & 1) << 5); R = (st >> 1) * 16 + swz / 64; C = (st & 1) * 32 + (swz % 64) / 2; }
__host__ __device__ __forceinline__ int perm32(int rho) { const int n = rho >> 4, i = rho & 15; return 8 * (i >> 2) + 4 * n + (i & 3); }

struct Unit { int pm, pn; };
struct Gemm { const bf16_t* A; const bf16_t* Bt; int M, N, K; };

struct StaticOrder {
    int nM, nN, nwg, G, c, rev;
    __host__ __device__ void init(int M, int N, int G_, int c_, int rev_ = 0) { nM = M / BM; nN = N / BM; nwg = nM * nN; G = G_; c = c_; rev = rev_; }
    __host__ __device__ bool next(int i, Unit& u) const {
        const long L = (long)i * G + c; if (L >= nwg) return false;
        int wgid = (int)L; { const int q = nwg / NXCD, r = nwg % NXCD, xcd = wgid % NXCD, off = wgid / NXCD; wgid = (xcd < r ? xcd * (q + 1) : r * (q + 1) + (xcd - r) * q) + off; }
        const int nig = WGM * nN, gid = wgid / nig, fm = gid * WGM, gsz = (nM - fm) < WGM ? (nM - fm) : WGM;
        u.pm = fm + ((wgid % nig) % gsz); u.pn = (wgid % nig) / gsz; if (rev) u.pm = nM - 1 - u.pm; return true;
    }
    __device__ __forceinline__ void a_ready(const Unit&) const {}
    __device__ __forceinline__ void done(const Unit&) const {}
};

typedef unsigned u32x2 __attribute__((ext_vector_type(2)));
__device__ __forceinline__ int pg8_opaque_tid(int wv) { unsigned z = 0u; asm volatile("" : "+v"(z)); return (wv << 6) | (int)__builtin_amdgcn_mbcnt_hi(~0u, __builtin_amdgcn_mbcnt_lo(~0u, z)); }
__device__ __forceinline__ unsigned cvt_pk_bf16(float lo, float hi) { unsigned r; asm volatile("v_cvt_pk_bf16_f32 %0, %1, %2" : "=v"(r) : "v"(lo), "v"(hi)); return r; }

struct EpiStoreBf16 {
    static constexpr bool PERM = true, AFTER_DRAIN = false;
    bf16_t* O; int ldc;
    __device__ __forceinline__ void operator()(const f32x4 (&acc)[2][2][4][2], const Unit& u, int wr, int wc, int fr, int fq) const {
        const int row0 = u.pm * BM + wr * 64 + fr; const int col0 = u.pn * BM + wc * 32 + 8 * fq;
#pragma unroll
        for (int ai = 0; ai < 2; ++ai)
#pragma unroll
            for (int m = 0; m < 4; ++m) { bf16_t* rowp = O + (size_t)(row0 + ai * HALF + m * 16) * ldc + col0;
#pragma unroll
                for (int bj = 0; bj < 2; ++bj) { const f32x4 v0 = acc[ai][bj][m][0], v1 = acc[ai][bj][m][1];
                    u32x4 w; w.x = cvt_pk_bf16(v0[0], v0[1]); w.y = cvt_pk_bf16(v0[2], v0[3]); w.z = cvt_pk_bf16(v1[0], v1[1]); w.w = cvt_pk_bf16(v1[2], v1[3]);
                    *(u32x4*)(rowp + bj * HALF) = w; } }
    }
};
struct RowNorm { const float* rowss; const float* bias; int ldb, b0, nlat; };
struct EpiRopeStore {
    static constexpr bool PERM = true, AFTER_DRAIN = false;
    bf16_t* O; int ldc; const float* rtc; const float* rts; int nlat; RowNorm rn;
    __device__ __forceinline__ void operator()(const f32x4 (&acc)[2][2][4][2], const Unit& u, int wr, int wc, int fr, int fq) const {
        const int row0 = u.pm * BM + wr * 64 + fr; const int col0 = u.pn * BM + wc * 32 + 8 * fq;
        const bool rot = (u.pn < 8) && (u.pm * BM < nlat); const float ksc = (u.pn >= 4 && u.pn < 8) ? 0.0625f : 1.0f;
        const int mrow = (u.pm * BM < rn.nlat) ? rn.b0 + ((u.pm * BM) >> 13) : 8;
        const float* bp = rn.bias + (size_t)mrow * rn.ldb + col0;
        const f32x4 bv00 = *(const f32x4*)bp, bv01 = *(const f32x4*)(bp + 4), bv10 = *(const f32x4*)(bp + HALF), bv11 = *(const f32x4*)(bp + HALF + 4);
        float rinv[8];
#pragma unroll
        for (int ii = 0; ii < 8; ii += 2) { const f32x4 qa = *(const f32x4*)(rn.rowss + (size_t)(row0 + (ii >> 2) * HALF + (ii & 3) * 16) * 16 + 4 * fq), qb = *(const f32x4*)(rn.rowss + (size_t)(row0 + ((ii + 1) >> 2) * HALF + ((ii + 1) & 3) * 16) * 16 + 4 * fq);
            float sa = (qa[0] + qa[1]) + (qa[2] + qa[3]), sb = (qb[0] + qb[1]) + (qb[2] + qb[3]);
            sa += __shfl_xor(sa, 16); sb += __shfl_xor(sb, 16); sa += __shfl_xor(sa, 32); sb += __shfl_xor(sb, 32);
            rinv[ii] = rsqrtf(sa * (1.0f / 1024.0f) + 1e-6f); rinv[ii + 1] = rsqrtf(sb * (1.0f / 1024.0f) + 1e-6f); }
        f32x4 tc[4], tn[4];
#define PG8_LOADT(dst, idx) do { const size_t to_ = (size_t)((row0 + ((idx) >> 2) * HALF + ((idx) & 3) * 16) & 8191) * 128 + wc * 32 + 8 * fq; \
            dst[0] = *(const f32x4*)(rtc + to_); dst[1] = *(const f32x4*)(rtc + to_ + 4); dst[2] = *(const f32x4*)(rts + to_); dst[3] = *(const f32x4*)(rts + to_ + 4); } while (0)
        if (rot) PG8_LOADT(tc, 0);
#pragma unroll
        for (int idx = 0; idx < 8; ++idx) { const int ai = idx >> 2, m = idx & 3;
            const int row = row0 + ai * HALF + m * 16; bf16_t* rowp = O + (size_t)row * ldc + col0;
            if (rot && idx + 1 < 8) PG8_LOADT(tn, idx + 1);
            const float ri = rinv[idx];
            f32x4 a0 = acc[ai][0][m][0] * ri + bv00, a1 = acc[ai][0][m][1] * ri + bv01, b0 = acc[ai][1][m][0] * ri + bv10, b1 = acc[ai][1][m][1] * ri + bv11;
            if (rot) { const f32x4 x0 = a0 * tc[0] - b0 * tc[2], y0 = b0 * tc[0] + a0 * tc[2], x1 = a1 * tc[1] - b1 * tc[3], y1 = b1 * tc[1] + a1 * tc[3]; a0 = x0; b0 = y0; a1 = x1; b1 = y1; }
            a0 *= ksc; a1 *= ksc; b0 *= ksc; b1 *= ksc;
            u32x4 w; w.x = cvt_pk_bf16(a0[0], a0[1]); w.y = cvt_pk_bf16(a0[2], a0[3]); w.z = cvt_pk_bf16(a1[0], a1[1]); w.w = cvt_pk_bf16(a1[2], a1[3]);
            *(u32x4*)rowp = w;
            w.x = cvt_pk_bf16(b0[0], b0[1]); w.y = cvt_pk_bf16(b0[2], b0[3]); w.z = cvt_pk_bf16(b1[0], b1[1]); w.w = cvt_pk_bf16(b1[2], b1[3]);
            *(u32x4*)(rowp + HALF) = w;
#pragma unroll
            for (int q = 0; q < 4; ++q) tc[q] = tn[q];
        }
#undef PG8_LOADT
    }
};

struct EpiSwiglu {
    static constexpr bool PERM = true, AFTER_DRAIN = false;
    bf16_t* O; int ldc; RowNorm rn;
    __device__ __forceinline__ void operator()(const f32x4 (&acc)[2][2][4][2], const Unit& u, int wr, int wc, int fr, int fq) const {
        const int row0 = u.pm * BM + wr * 64 + fr; const int col0 = u.pn * HALF + wc * 32 + 8 * fq;
        const int mrow = (u.pm * BM < rn.nlat) ? rn.b0 + ((u.pm * BM) >> 13) : 8;
        const float* bp = rn.bias + (size_t)mrow * rn.ldb + u.pn * BM + wc * 32 + 8 * fq;
        f32x4 bv[2][2];
#pragma unroll
        for (int bj = 0; bj < 2; ++bj)
#pragma unroll
            for (int n = 0; n < 2; ++n) bv[bj][n] = *(const f32x4*)(bp + bj * HALF + 4 * n);
        float rinv[8];
#pragma unroll
        for (int ii = 0; ii < 8; ii += 2) { const f32x4 qa = *(const f32x4*)(rn.rowss + (size_t)(row0 + (ii >> 2) * HALF + (ii & 3) * 16) * 16 + 4 * fq), qb = *(const f32x4*)(rn.rowss + (size_t)(row0 + ((ii + 1) >> 2) * HALF + ((ii + 1) & 3) * 16) * 16 + 4 * fq);
            float sa = (qa[0] + qa[1]) + (qa[2] + qa[3]), sb = (qb[0] + qb[1]) + (qb[2] + qb[3]);
            sa += __shfl_xor(sa, 16); sb += __shfl_xor(sb, 16); sa += __shfl_xor(sa, 32); sb += __shfl_xor(sb, 32);
            rinv[ii] = rsqrtf(sa * (1.0f / 1024.0f) + 1e-6f); rinv[ii + 1] = rsqrtf(sb * (1.0f / 1024.0f) + 1e-6f); }
#pragma unroll
        for (int ai = 0; ai < 2; ++ai) {
#pragma unroll
            for (int m = 0; m < 4; ++m) { const int row = row0 + ai * HALF + m * 16; bf16_t* rowp = O + (size_t)row * ldc + col0;
                const float ri = rinv[4 * ai + m];
                float h[8];
#pragma unroll
                for (int n = 0; n < 2; ++n)
#pragma unroll
                    for (int j = 0; j < 4; ++j) { const float g = acc[ai][0][m][n][j] * ri + bv[0][n][j], up = acc[ai][1][m][n][j] * ri + bv[1][n][j]; h[4 * n + j] = g * __builtin_amdgcn_rcpf(1.0f + __builtin_amdgcn_exp2f(g * -1.4426950408889634f)) * up; }
                u32x4 w; w.x = cvt_pk_bf16(h[0], h[1]); w.y = cvt_pk_bf16(h[2], h[3]); w.z = cvt_pk_bf16(h[4], h[5]); w.w = cvt_pk_bf16(h[6], h[7]);
                *(u32x4*)rowp = w; } }
    }
};
template <bool EMIT> struct EpiResid {
    static constexpr bool PERM = false, AFTER_DRAIN = false;
    const float* resL; float* outL; const float* resC; float* outC; const float* gate; int b0, nlat;
    bf16_t* an; float* rss; const float* gsv; int remap;
    __device__ __forceinline__ void operator()(const f32x4 (&acc)[2][2][4][2], const Unit& u, int wr, int wc, int fr, int fq) const {
        const int lr0 = u.pm * BM; const bool is_ctx = lr0 >= nlat;
        const int col0 = u.pn * BM + wc * 32 + 4 * fq;
        size_t grow0; int mrow; const float* rp0; float* op0;
        if (!is_ctx) { grow0 = (size_t)b0 * 8192 + lr0; mrow = (int)(grow0 >> 13); rp0 = resL; op0 = outL; }
        else { grow0 = (size_t)b0 * 256 + (lr0 - nlat); mrow = 8; rp0 = resC; op0 = outC; }
        size_t nrow0 = (size_t)lr0;
        if (EMIT && remap) nrow0 = is_ctx ? (grow0 >> 10) * 33792 + 32768 + (grow0 & 1023) : (grow0 >> 15) * 33792 + (grow0 & 32767);
        const float* gp = gate + (size_t)mrow * 6144 + col0;
        f32x4 gv[2][2], sv[2][2];
#pragma unroll
        for (int bj = 0; bj < 2; ++bj)
#pragma unroll
            for (int n = 0; n < 2; ++n) { gv[bj][n] = *(const f32x4*)(gp + bj * HALF + n * 16); if (EMIT) sv[bj][n] = *(const f32x4*)(gsv + (size_t)mrow * 1024 + col0 + bj * HALF + n * 16); }
        f32x4 rcur[2][2], rnxt[2][2];
#define PG8_LOADR(dst, idx) do { const int rin_ = wr * 64 + fr + ((idx) >> 2) * HALF + ((idx) & 3) * 16; const size_t off_ = (grow0 + rin_) * 1024 + col0; \
            _Pragma("unroll") for (int bj = 0; bj < 2; ++bj) _Pragma("unroll") for (int n = 0; n < 2; ++n) dst[bj][n] = *(const f32x4*)(rp0 + off_ + bj * HALF + n * 16); } while (0)
        PG8_LOADR(rcur, 0);
#pragma unroll
        for (int idx = 0; idx < 8; ++idx) { const int ai = idx >> 2, m = idx & 3;
            const int rin = wr * 64 + fr + ai * HALF + m * 16; const size_t off = (grow0 + rin) * 1024 + col0; float ss = 0.f;
            if (idx + 1 < 8) PG8_LOADR(rnxt, idx + 1);
#pragma unroll
            for (int bj = 0; bj < 2; ++bj)
#pragma unroll
                for (int n = 0; n < 2; ++n) { const f32x4 o = rcur[bj][n] + gv[bj][n] * acc[ai][bj][m][n];
                    *(f32x4*)(op0 + off + bj * HALF + n * 16) = o;
                    if (EMIT) { ss += (o[0] * o[0] + o[1] * o[1]) + (o[2] * o[2] + o[3] * o[3]); const f32x4 y = o * sv[bj][n];
                        u32x2 w; w.x = cvt_pk_bf16(y[0], y[1]); w.y = cvt_pk_bf16(y[2], y[3]);
                        *(u32x2*)(an + (nrow0 + rin) * 1024 + col0 + bj * HALF + n * 16) = w; } }
            if (EMIT) { ss += __shfl_xor(ss, 16); ss += __shfl_xor(ss, 32);
                if (fq == 0) rss[(nrow0 + rin) * 16 + u.pn * 4 + wc] = ss; }
#pragma unroll
            for (int bj = 0; bj < 2; ++bj)
#pragma unroll
                for (int n = 0; n < 2; ++n) rcur[bj][n] = rnxt[bj][n];
        }
#undef PG8_LOADR
    }
};

template <class Epi, class Sched, bool STAMP = false>
__device__ __forceinline__ void gemm_phase(PG8_LAS unsigned char* lds, const Gemm g, const Sched& S, const Epi& E, unsigned long long* stamps, int wv) {
    const int tid = pg8_opaque_tid(wv), wid = __builtin_amdgcn_readfirstlane(tid >> 6), lane = tid & 63, wr = wid >> 2, wc = wid & 3, fr = lane & 15, fq = lane >> 4;
    const int K = g.K, nt = K / BK;
    int ts_lo = 0, ts_hi = 0, nts = 0; const unsigned long long rt_entry = STAMP ? (unsigned long long)wall_clock64() : 0ull;
#define PG8_STAMP() do { if (STAMP && wid == 0 && nts < 64) { const unsigned long long _c = (unsigned long long)clock64(); \
        ts_lo = (lane == nts) ? (int)(unsigned)_c : ts_lo; ts_hi = (lane == nts) ? (int)(unsigned)(_c >> 32) : ts_hi; ++nts; } } while (0)
    PG8_STAMP();
    unsigned voffA[2], voffB[2];
#pragma unroll
    for (int i = 0; i < 2; ++i) { int R, C; stage_rc(tid * 16 + i * 8192, R, C); const int Rb = Epi::PERM ? ((R & ~31) + perm32(R & 31)) : R;
        voffA[i] = (unsigned)(R * K + C) * 2u; voffB[i] = (unsigned)(Rb * K + C) * 2u; }
    const size_t kstep = (size_t)(BK * 2);
    const size_t hstep = (size_t)HALF * K * 2;
    const size_t tstep = 2 * hstep;
    const unsigned ldsw = (unsigned)wid * 1024u;
    const int aoff = lds_byte(wr * 64 + fr, fq * 8), boff = lds_byte(wc * 32 + fr, fq * 8);
#define PG8_SA(b, h) (((b) * 2 + (h)) * HTB)
#define PG8_SB(b, h) ((4 + (b) * 2 + (h)) * HTB)
#define PG8_STAGE(bufoff, gbase, voff) do { _Pragma("unroll") for (int _i = 0; _i < 2; ++_i) \
        __builtin_amdgcn_global_load_lds((const unsigned*)((const char*)(gbase) + (voff)[_i]), (PG8_LAS unsigned*)(lds + (bufoff) + ldsw + _i * 8192), 16, 0, 0); } while (0)
#define PG8_LDA(dst, b, h) do { _Pragma("unroll") for (int m = 0; m < 4; ++m) _Pragma("unroll") for (int k = 0; k < 2; ++k) dst[m][k] = *(const PG8_LAS bf16x8*)(lds + PG8_SA(b, h) + aoff + m * 2048 + k * 1024); } while (0)
#define PG8_LDB(dst, b, h) do { _Pragma("unroll") for (int n = 0; n < 2; ++n) _Pragma("unroll") for (int k = 0; k < 2; ++k) dst[n][k] = *(const PG8_LAS bf16x8*)(lds + PG8_SB(b, h) + boff + n * 2048 + k * 1024); } while (0)
#define PG8_MMA(ai, bj, At, Bt) do { __builtin_amdgcn_s_setprio(1); _Pragma("unroll") for (int m = 0; m < 4; ++m) _Pragma("unroll") for (int n = 0; n < 2; ++n) _Pragma("unroll") for (int k = 0; k < 2; ++k) \
        acc[ai][bj][m][n] = __builtin_amdgcn_mfma_f32_16x16x32_bf16(Bt[n][k], At[m][k], acc[ai][bj][m][n], 0, 0, 0); __builtin_amdgcn_s_setprio(0); } while (0)
#define PG8_WAIT_V(n) asm volatile("s_waitcnt vmcnt(" #n ")" ::: "memory")
#define PG8_WAIT_L(n) asm volatile("s_waitcnt lgkmcnt(" #n ")" ::: "memory")
#define PG8_BAR __builtin_amdgcn_s_barrier()
#define PG8_SCHED __builtin_amdgcn_sched_barrier(0)
    Unit cur, nxt; int ui = 0;
    if (!S.next(0, cur)) return;
    f32x4 acc[2][2][4][2];
#pragma unroll
    for (int a = 0; a < 2; ++a)
#pragma unroll
        for (int b = 0; b < 2; ++b)
#pragma unroll
            for (int m = 0; m < 4; ++m)
#pragma unroll
                for (int n = 0; n < 2; ++n) acc[a][b][m][n] = (f32x4){0.f, 0.f, 0.f, 0.f};
    bf16x8 At[4][2], B0[2][2], B1[2][2];
    const char* cA = (const char*)g.A + (size_t)cur.pm * tstep; const char* cB = (const char*)g.Bt + (size_t)cur.pn * tstep;
    S.a_ready(cur);
    PG8_STAGE(PG8_SB(0, 0), cB, voffB); PG8_STAGE(PG8_SA(0, 0), cA, voffA); PG8_STAGE(PG8_SB(0, 1), cB + hstep, voffB); PG8_STAGE(PG8_SA(0, 1), cA + hstep, voffA);
    if (wr == 1) PG8_BAR;
    PG8_WAIT_V(4); PG8_BAR;
    PG8_STAGE(PG8_SB(1, 0), cB + kstep, voffB); PG8_STAGE(PG8_SA(1, 0), cA + kstep, voffA); PG8_STAGE(PG8_SB(1, 1), cB + hstep + kstep, voffB);
    PG8_WAIT_V(6); PG8_BAR;
    PG8_STAMP();
    for (;;) {
        const bool has_next = S.next(ui + 1, nxt);
        const char* nA = has_next ? (const char*)g.A + (size_t)nxt.pm * tstep : cA; const char* nB = has_next ? (const char*)g.Bt + (size_t)nxt.pn * tstep : cB;
        for (int t = 0; t < nt; t += 2) {
            const bool last = (t == nt - 2);
            const char* a1 = cA + (size_t)(t + 1) * kstep;
            const char* a2 = last ? nA : cA + (size_t)(t + 2) * kstep; const char* b2 = last ? nB : cB + (size_t)(t + 2) * kstep;
            const char* a3 = a2 + kstep; const char* b3 = b2 + kstep;
            if (last && has_next) S.a_ready(nxt);
            PG8_LDB(B0, 0, 0); PG8_SCHED; PG8_LDA(At, 0, 0); PG8_STAGE(PG8_SA(1, 1), a1 + hstep, voffA);
            PG8_WAIT_L(8); PG8_BAR; PG8_WAIT_L(0); PG8_MMA(0, 0, At, B0); PG8_BAR; PG8_SCHED;
            PG8_LDB(B1, 0, 1); PG8_STAGE(PG8_SB(0, 0), b2, voffB);
            PG8_BAR; PG8_WAIT_L(0); PG8_MMA(0, 1, At, B1); PG8_BAR;
            PG8_LDA(At, 0, 1); PG8_STAGE(PG8_SA(0, 0), a2, voffA);
            PG8_BAR; PG8_WAIT_L(0); PG8_MMA(1, 0, At, B0); PG8_BAR; PG8_SCHED;
            PG8_STAGE(PG8_SB(0, 1), b2 + hstep, voffB);
            PG8_WAIT_V(6); PG8_BAR; PG8_MMA(1, 1, At, B1); PG8_BAR;
            PG8_LDB(B0, 1, 0); PG8_SCHED; PG8_LDA(At, 1, 0); PG8_STAGE(PG8_SA(0, 1), a2 + hstep, voffA);
            PG8_WAIT_L(8); PG8_BAR; PG8_WAIT_L(0); PG8_MMA(0, 0, At, B0); PG8_BAR; PG8_SCHED;
            PG8_LDB(B1, 1, 1); PG8_STAGE(PG8_SB(1, 0), b3, voffB);
            PG8_BAR; PG8_WAIT_L(0); PG8_MMA(0, 1, At, B1); PG8_BAR;
            PG8_LDA(At, 1, 1); PG8_STAGE(PG8_SA(1, 0), a3, voffA);
            PG8_BAR; PG8_WAIT_L(0); PG8_MMA(1, 0, At, B0); PG8_BAR; PG8_SCHED;
            PG8_STAGE(PG8_SB(1, 1), b3 + hstep, voffB);
            PG8_WAIT_V(6); PG8_BAR; PG8_MMA(1, 1, At, B1); PG8_BAR;
        }
        PG8_STAMP();
        if constexpr (!Epi::AFTER_DRAIN) { E(acc, cur, wr, wc, fr, fq); S.done(cur); }
        PG8_STAMP();
        if (!has_next) break;
#pragma unroll
        for (int a = 0; a < 2; ++a)
#pragma unroll
            for (int b = 0; b < 2; ++b)
#pragma unroll
                for (int m = 0; m < 4; ++m)
#pragma unroll
                    for (int n = 0; n < 2; ++n) acc[a][b][m][n] = (f32x4){0.f, 0.f, 0.f, 0.f};
        cur = nxt; cA = nA; cB = nB; ++ui;
    }
    PG8_WAIT_V(0);
    if (wr == 0) PG8_BAR;
    PG8_BAR;
    if constexpr (Epi::AFTER_DRAIN) { E.fused(acc, cur, wr, wc, fr, fq, lds, wid, lane); S.done(cur); }
    PG8_STAMP();
    if (STAMP && wid == 0) { stamps[lane] = lane < nts ? (((unsigned long long)(unsigned)ts_hi << 32) | (unsigned)ts_lo) : 0ull;
        if (lane == 62) stamps[62] = rt_entry; if (lane == 63) stamps[63] = (unsigned long long)wall_clock64(); }
#undef PG8_STAMP
#undef PG8_SA
#undef PG8_SB
#undef PG8_STAGE
#undef PG8_LDA
#undef PG8_LDB
#undef PG8_MMA
#undef PG8_WAIT_V
#undef PG8_WAIT_L
#undef PG8_BAR
#undef PG8_SCHED
}
}

using pg8::bf16_t; using pg8::bf16x8; using pg8::f32x4; using pg8::u32x4;
typedef unsigned u32x2 __attribute__((ext_vector_type(2)));
typedef float f32x2 __attribute__((ext_vector_type(2)));

constexpr int NT_LAT = 65536, NT_CTX = 2048, NT_ALL = NT_LAT + NT_CTX, DM = 1024, FF = 2816, EIN = 3328, OIN = 6144;
constexpr int NTHREADS = 512, NWAVES = 8;
constexpr int LDS_BYTES = 157696;
constexpr float EPS = 1e-6f;
constexpr int C_AQ = 0, C_AK = 512, C_AV = 640, C_BQ = 768, C_BFF = 1280, C_BFB = 1792, C_BI = 2304, C_BG = 2816;
constexpr int C_RQ = 0, C_RK = 1024, C_RV = 2048, C_RG = 4096;

constexpr size_t al256(size_t x) { return (x + 255) & ~(size_t)255; }
constexpr size_t WS_WT_EIN = 0;
constexpr size_t WS_WT_EOUT = WS_WT_EIN + al256((size_t)EIN * DM * 2);
constexpr size_t WS_WT_OIN = WS_WT_EOUT + al256((size_t)DM * DM * 2);
constexpr size_t WS_WT_OOUT = WS_WT_OIN + al256((size_t)OIN * DM * 2);
constexpr size_t WS_WT_FIN = WS_WT_OOUT + al256((size_t)DM * 2048 * 2);
constexpr size_t WS_WT_FOUT = WS_WT_FIN + al256((size_t)2 * 2 * FF * DM * 2);
constexpr size_t WS_MODS = WS_WT_FOUT + al256((size_t)2 * DM * FF * 2);
constexpr size_t WS_ROPE_AX = WS_MODS + al256((size_t)2 * 9 * 6144 * 4);
constexpr size_t WS_ROPE_RT = WS_ROPE_AX + al256((size_t)8192 * 32 * 2 * 4);
constexpr size_t WS_LB = WS_ROPE_RT + al256((size_t)8192 * 128 * 2 * 4);
constexpr size_t WS_CTXR = WS_LB + al256(512 * 4);
constexpr size_t WS_GS = WS_CTXR + al256((size_t)NT_CTX * DM * 4);
constexpr size_t WS_BIAS3 = WS_GS + al256((size_t)3 * 9 * 1024 * 4);
constexpr size_t WS_BIAS5 = WS_BIAS3 + al256((size_t)9 * 5632 * 4);
constexpr size_t WS_BIAS7 = WS_BIAS5 + al256((size_t)9 * 6144 * 4);
constexpr size_t WS_RSS_A = WS_BIAS7 + al256((size_t)9 * 5632 * 4);
constexpr size_t WS_RSS_B = WS_RSS_A + al256((size_t)NT_ALL * 64);
constexpr size_t WS_RSS_C = WS_RSS_B + al256((size_t)NT_ALL * 64);
constexpr size_t WS_BAR = WS_RSS_C + al256((size_t)NT_LAT * 64);
constexpr size_t WS_HA = WS_BAR + al256((size_t)4096 * 4);
constexpr size_t WS_OB = WS_HA + al256((size_t)NT_ALL * DM * 2);
constexpr size_t WS_BIG = WS_OB + al256((size_t)NT_ALL * 512 * 2);
constexpr size_t BIG_P1_BYTES = (size_t)33792 * OIN * 2;
constexpr size_t BIG_O_BYTES = (size_t)32768 * 2048 * 2;
constexpr size_t WS_OFW = WS_BIG + BIG_P1_BYTES;
constexpr size_t WS_OBW = WS_OFW + BIG_O_BYTES;
constexpr size_t WS_END1 = WS_OBW + BIG_O_BYTES;
constexpr size_t WS_END0 = WS_BIG + (size_t)NT_ALL * EIN * 2 + (size_t)8448 * (2 * 8192 * 2 + 128 * 4);
constexpr size_t WS_END = WS_END1 > WS_END0 ? WS_END1 : WS_END0;

DI float bf2f(unsigned short b) { return __uint_as_float(((unsigned)b) << 16); }
typedef __bf16 bfx2_t __attribute__((ext_vector_type(2)));
typedef short s16x4 __attribute__((ext_vector_type(4)));
DI unsigned short f2bf(float f) { const __bf16 h = (__bf16)f; return __builtin_bit_cast(unsigned short, h); }
DI unsigned pk2(float lo, float hi) { const f32x2 p = {lo, hi}; const bfx2_t q = __builtin_convertvector(p, bfx2_t); return __builtin_bit_cast(unsigned, q); }
DI bf16x8 tr_frag(const LAS bf16_t* X, int pitch, int t0, int c0, int lane) {
    const int i = lane & 15, g = lane >> 4;
    const LAS bf16_t* p = X + (t0 + 8 * g + (i >> 2)) * pitch + c0 + 4 * (i & 3);
    const s16x4 lo = __builtin_amdgcn_ds_read_tr16_b64_v4i16((LAS s16x4*)p);
    const s16x4 hi = __builtin_amdgcn_ds_read_tr16_b64_v4i16((LAS s16x4*)(p + 4 * pitch));
    return __builtin_shufflevector(lo, hi, 0, 1, 2, 3, 4, 5, 6, 7);
}
DI void unpack8(const bf16x8 v, float* f) {
#pragma unroll
    for (int i = 0; i < 8; ++i) f[i] = bf2f((unsigned short)v[i]);
}
DI bf16x8 pack8(const float* f) { u32x4 p; p.x = pk2(f[0], f[1]); p.y = pk2(f[2], f[3]); p.z = pk2(f[4], f[5]); p.w = pk2(f[6], f[7]); return __builtin_bit_cast(bf16x8, p); }
DI float wave_sum(float v) {
#pragma unroll
    for (int o = 1; o < 64; o <<= 1) v += __shfl_xor(v, o);
    return v;
}
DI float fexp(float x) { return __builtin_amdgcn_exp2f(x * 1.4426950408889634f); }
DI float flog(float x) { return __builtin_amdgcn_logf(x) * 0.6931471805599453f; }
DI float sigmf(float x) { return __builtin_amdgcn_rcpf(1.0f + fexp(-x)); }
DI float siluf(float x) { return x * sigmf(x); }
#define LDS_WAIT() asm volatile("s_waitcnt lgkmcnt(0)" ::: "memory")
#define MFMA16(a, b, c) __builtin_amdgcn_mfma_f32_16x16x32_bf16((a), (b), (c), 0, 0, 0)

#define XB_TMO      128
#define XB_XCNT(j)  (256  + 64 * (j))
#define XB_XSUB(j)  (1280 + 64 * (j))
#define XB_XGEN(j)  (2304 + 64 * (j))
#define XB_TOP      3328
#define XB_TOPGEN   3392
#define XCD_BAR_WORDS 3456
#define XB_SPIN_CAP (1u << 18)

__device__ __forceinline__ unsigned xb_ld(unsigned* p)              { return __hip_atomic_load(p, __ATOMIC_RELAXED, __HIP_MEMORY_SCOPE_AGENT); }
__device__ __forceinline__ unsigned xb_add(unsigned* p, unsigned v) { return __hip_atomic_fetch_add(p, v, __ATOMIC_RELAXED, __HIP_MEMORY_SCOPE_AGENT); }
__device__ __forceinline__ unsigned xb_xcc_id() { return (unsigned)__builtin_amdgcn_s_getreg((3 << 11) | 20) & 0xFu; }
#define XB_SPIN(cond, bar) do { unsigned _sp = 0; while (cond) { __builtin_amdgcn_s_sleep(1); \
    if ((++_sp & 255u) == 0u) { if (xb_ld(&(bar)[XB_TMO])) break; if (_sp > XB_SPIN_CAP) { atomicAdd(&(bar)[XB_TMO], 1u); break; } } } } while (0)

struct XcdBarrier {
    unsigned* bar; unsigned x; int wv;
    volatile LAS unsigned* st;
};

__device__ __forceinline__ XcdBarrier xcd_barrier_post(unsigned* bar, volatile LAS unsigned* st) {
    XcdBarrier b; b.bar = bar; b.x = xb_xcc_id(); b.st = st;
    if (threadIdx.x == 0) (void)xb_add(&bar[XB_XCNT(b.x)], 1u);
    return b;
}
__device__ __forceinline__ void xcd_barrier_complete(unsigned* bar, unsigned x, unsigned& nloc, unsigned& nx) {
    const unsigned G = gridDim.x * gridDim.y * gridDim.z;
    unsigned sum, cnt, mine, sp = 0u;
    for (;;) {
        sum = 0u; cnt = 0u; mine = 0u;
#pragma unroll
        for (unsigned j = 0; j < 16; ++j) { const unsigned c = xb_ld(&bar[XB_XCNT(j)]); sum += c; cnt += (c > 0u) ? 1u : 0u; mine = (j == x) ? c : mine; }
        if (sum == G) break;
        __builtin_amdgcn_s_sleep(1);
        if ((++sp & 255u) == 0u) { if (xb_ld(&bar[XB_TMO])) break; if (sp > XB_SPIN_CAP) { atomicAdd(&bar[XB_TMO], 1u); break; } }
    }
    nloc = mine > 0u ? mine : 1u; nx = cnt > 0u ? cnt : 1u;
}

__device__ __forceinline__ void xcd_barrier(const XcdBarrier& b) {
    asm volatile("s_waitcnt vmcnt(0)" ::: "memory");
    __syncthreads();
    if (b.wv == 0 && __builtin_amdgcn_mbcnt_hi(~0u, __builtin_amdgcn_mbcnt_lo(~0u, 0u)) == 0u) {
        unsigned* bar = b.bar;
        __builtin_amdgcn_s_waitcnt(0);
        unsigned nloc = b.st[0], nx = b.st[1];
        if (nloc == 0u) { xcd_barrier_complete(bar, b.x, nloc, nx); b.st[0] = nloc; b.st[1] = nx; }
        const unsigned old = xb_add(&bar[XB_XSUB(b.x)], 1u);
        const unsigned gen = old / nloc;
        if (old + 1u == (gen + 1u) * nloc) {
            __builtin_amdgcn_fence(__ATOMIC_RELEASE, "agent");
            asm volatile("s_waitcnt vmcnt(0)" ::: "memory");
            const unsigned og = xb_add(&bar[XB_TOP], 1u);
            const unsigned tg = og / nx;
            if (og + 1u == (tg + 1u) * nx) xb_add(&bar[XB_TOPGEN], 1u);
            else XB_SPIN(xb_ld(&bar[XB_TOPGEN]) == tg, bar);
            __builtin_amdgcn_fence(__ATOMIC_ACQUIRE, "agent");
            xb_add(&bar[XB_XGEN(b.x)], 1u);
            asm volatile("s_waitcnt vmcnt(0)" ::: "memory");
        } else {
            XB_SPIN(xb_ld(&bar[XB_XGEN(b.x)]) == gen, bar);
            __builtin_amdgcn_fence(__ATOMIC_ACQUIRE, "agent");
            asm volatile("s_waitcnt vmcnt(0)" ::: "memory");
        }
    }
    __syncthreads();
}

struct Args { const float* in[17]; float* out; unsigned char* ws; };

DI void transpose_item(const float* W, int K, int N, bf16_t* WT, int k0, int n0, int drow0, LAS float* scr, int lane) {
#pragma unroll 8
    for (int i = 0; i < 32; ++i) { const int kk = 2 * i + (lane >> 5); scr[kk * 33 + (lane & 31)] = W[(size_t)(k0 + kk) * N + n0 + (lane & 31)]; }
    LDS_WAIT();
    const int c = lane & 7;
#pragma unroll
    for (int j = 0; j < 4; ++j) { const int n = (lane >> 3) + 8 * j; const LAS float* s = scr + (8 * c) * 33 + n;
        u32x4 o; o.x = pk2(s[0 * 33], s[1 * 33]); o.y = pk2(s[2 * 33], s[3 * 33]); o.z = pk2(s[4 * 33], s[5 * 33]); o.w = pk2(s[6 * 33], s[7 * 33]);
        *(u32x4*)(WT + (size_t)(drow0 + n) * K + k0 + 8 * c) = o; }
    LDS_WAIT();
}
DI void transpose_matrix(const float* W, int K, int N, bf16_t* WT, bool ffn_in, int& it0, int gw, int ngw, LAS float* scr, int lane) {
    const int nblk = N / 32, nitems = (K / 64) * nblk;
    int first = (gw - it0 % ngw + ngw) % ngw;
    for (int it = first; it < nitems; it += ngw) {
        const int kb = it / nblk, nb = it % nblk, n0 = nb * 32;
        int drow0 = n0;
        if (ffn_in) { const int s = n0 / FF, j = n0 % FF, p = j / 128, jj = j % 128; drow0 = 256 * p + 128 * s + jj; }
        transpose_item(W, K, N, WT, kb * 64, n0, drow0, scr, lane);
    }
    it0 += nitems;
}

DI void mods_phase(int wv, const Args& a, float* mods, LAS unsigned char* lds) {
    const int tid = pg8::pg8_opaque_tid(wv);
    LAS float* sc = (LAS float*)lds;
    LAS float* red = (LAS float*)(lds + 9 * 1024 * 4);
    if ((int)blockIdx.x >= 192) return;
    for (int i = tid; i < 9 * 1024; i += NTHREADS) { const int r = i >> 10, k = i & 1023; const float v = r < 8 ? a.in[1][r * 1024 + k] : a.in[3][k]; sc[i] = siluf(v); }
    __syncthreads();
    for (int it = blockIdx.x; it < 192; it += gridDim.x) {
        const int l = it / 96, n0 = (it % 96) * 64, nl = tid & 63, kp = tid >> 6;
        const float* w = a.in[4] + (size_t)l * 1024 * 6144 + n0 + nl;
        float acc[9];
#pragma unroll
        for (int r = 0; r < 9; ++r) acc[r] = 0.f;
        for (int k = kp * 128; k < kp * 128 + 128; ++k) { const float wv = w[(size_t)k * 6144];
#pragma unroll
            for (int r = 0; r < 9; ++r) acc[r] += sc[r * 1024 + k] * wv; }
#pragma unroll
        for (int r = 0; r < 9; ++r) red[(kp * 9 + r) * 64 + nl] = acc[r];
        __syncthreads();
        for (int i = tid; i < 576; i += NTHREADS) { const int r = i >> 6, n = i & 63; float s = 0.f;
#pragma unroll
            for (int p = 0; p < 8; ++p) s += red[(p * 9 + r) * 64 + n];
            mods[(size_t)(l * 9 + r) * 6144 + n0 + n] = s + a.in[5][l * 6144 + n0 + n]; }
        __syncthreads();
    }
}

DI void tables_phase(int wv, const Args& a, float* ax, float* rt, float* lb, float* rss, int nrss) {
    const int gt = blockIdx.x * NTHREADS + pg8::pg8_opaque_tid(wv), ngt = gridDim.x * NTHREADS;

    for (int i = gt; i < 8192 * 32; i += ngt) { const int t = i >> 5, j = i & 31; const double p = (j < 16) ? (double)(t >> 6) : (double)(t & 63);
        const double inv = pow(10000.0, -(double)(j & 15) / 16.0); const double ang = p * inv;
        ax[i] = (float)cos(ang); ax[8192 * 32 + i] = (float)sin(ang); }
    for (int i = gt; i < 8192 * 128; i += ngt) { const int t = i >> 7, j = i & 127; const double th = pow(10000.0, -(double)j / 127.0); const double ang = (double)t * th;
        rt[i] = (float)cos(ang); rt[8192 * 128 + i] = (float)sin(ang); }
    for (int i = gt; i < 512; i += ngt) { const float a0 = a.in[14][i], a1 = a.in[14][512 + i]; lb[i] = 1.0f / (1.0f + expf(a1 - a0)); }
}


DI void aux_phase(int wv, const float* normg, const float* mods, const bf16_t* wt_fin, const bf16_t* wt_oin, float* gs, float* bias3, float* bias5, float* bias7) {
    const int tid = pg8::pg8_opaque_tid(wv), lane = tid & 63, wave = __builtin_amdgcn_readfirstlane(tid >> 6);
    const int gt = blockIdx.x * NTHREADS + tid, ngt = gridDim.x * NTHREADS;
    for (int i = gt; i < 3 * 9 * 1024; i += ngt) { const int tb = i / 9216, r = (i / 1024) % 9, c = i & 1023;
        const float g = normg[(tb == 0 ? 1024 : (tb == 1 ? 2048 : 3072)) + c];
        const float sc = mods[(size_t)((tb == 0 ? 0 : 9) + r) * 6144 + (tb == 1 ? 1 : 4) * 1024 + c];
        gs[i] = g * (1.0f + sc); }
    const int gw = blockIdx.x * NWAVES + wave, ngw = gridDim.x * NWAVES;
    for (int it = gw; it < 5632 + 6144 + 5632; it += ngw) {
        const bf16_t* wrow; const float* sh; float* dst; int ldb, n;
        if (it < 5632) { n = it; wrow = wt_fin + (size_t)n * 1024; sh = mods + 3 * 1024; dst = bias3; ldb = 5632; }
        else if (it < 5632 + 6144) { n = it - 5632; wrow = wt_oin + (size_t)n * 1024; sh = mods + 9 * 6144; dst = bias5; ldb = 6144; }
        else { n = it - 5632 - 6144; wrow = wt_fin + (size_t)2 * FF * DM + (size_t)n * 1024; sh = mods + 9 * 6144 + 3 * 1024; dst = bias7; ldb = 5632; }
        float w[16]; unpack8(*(const bf16x8*)(wrow + 16 * lane), w); unpack8(*(const bf16x8*)(wrow + 16 * lane + 8), w + 8);
        float keep = 0.f;
#pragma unroll
        for (int r = 0; r < 9; ++r) { const float* sp = sh + (size_t)r * 6144 + 16 * lane; float s = 0.f;
#pragma unroll
            for (int q = 0; q < 4; ++q) { const f32x4 v = *(const f32x4*)(sp + 4 * q); s += (v.x * w[4 * q] + v.y * w[4 * q + 1]) + (v.z * w[4 * q + 2] + v.w * w[4 * q + 3]); }
            s = wave_sum(s); if (lane == r) keep = s; }
        if (lane < 9) dst[(size_t)lane * ldb + n] = keep;
    }
}

DI void normmod_phase(int wv, const float* xlat, const float* xctx, int b0, int nlat, int nrows, const float* g, const float* mods, int sidx, bf16_t* out) {
    const int tid = pg8::pg8_opaque_tid(wv), lane = tid & 63, wave = __builtin_amdgcn_readfirstlane(tid >> 6);
    const int gw = blockIdx.x * NWAVES + wave, ngw = gridDim.x * NWAVES;
    f32x4 gv[4];
#pragma unroll
    for (int j = 0; j < 4; ++j) gv[j] = *(const f32x4*)(g + 4 * lane + 256 * j);
    for (int lr0 = gw * 2; lr0 < nrows; lr0 += ngw * 2) {
        f32x4 v[2][4]; int mrow[2];
#pragma unroll
        for (int u = 0; u < 2; ++u) { const int lr = lr0 + u; const float* src;
            if (lr < nlat) { const size_t grow = (size_t)b0 * 8192 + lr; src = xlat + grow * 1024; mrow[u] = (int)(grow >> 13); }
            else { const size_t crow = (size_t)b0 * 256 + (lr - nlat); src = xctx + crow * 1024; mrow[u] = 8; }
#pragma unroll
            for (int j = 0; j < 4; ++j) v[u][j] = *(const f32x4*)(src + 4 * lane + 256 * j); }
#pragma unroll
        for (int u = 0; u < 2; ++u) { const int lr = lr0 + u; float ss = 0.f;
#pragma unroll
            for (int j = 0; j < 4; ++j) ss += (v[u][j].x * v[u][j].x + v[u][j].y * v[u][j].y) + (v[u][j].z * v[u][j].z + v[u][j].w * v[u][j].w);
            const float r = rsqrtf(wave_sum(ss) * (1.0f / 1024.0f) + EPS);
            const float* sh = mods + (size_t)mrow[u] * 6144 + sidx * 1024; const float* scl = sh + 1024;
#pragma unroll
            for (int j = 0; j < 4; ++j) { const f32x4 s4 = *(const f32x4*)(sh + 4 * lane + 256 * j), c4 = *(const f32x4*)(scl + 4 * lane + 256 * j);
                const f32x4 y = v[u][j] * r * gv[j] * (c4 + 1.0f) + s4;
                u32x2 w; w.x = pk2(y.x, y.y); w.y = pk2(y.z, y.w);
                *(u32x2*)(out + (size_t)lr * 1024 + 4 * lane + 256 * j) = w; } }
    }
}

DI void attn_phase(int wv, const bf16_t* P, bf16_t* mix, const float* qkg, const float* sink, const float* axc, const float* axs, LAS unsigned char* lds) {
    const int tid = pg8::pg8_opaque_tid(wv), lane = tid & 63, wave = __builtin_amdgcn_readfirstlane(tid >> 6);
    const int fr = lane & 15, fq = lane >> 4, g = wave & 3, half = wave >> 2;
    LAS bf16_t* Ks = (LAS bf16_t*)lds; LAS bf16_t* Vl = (LAS bf16_t*)(lds + 46080); LAS bf16_t* Pw = (LAS bf16_t*)(lds + 92160 + wave * 4608);
    for (int it = blockIdx.x; it < 2112; it += gridDim.x) {
        const int qt = it % 132; const int r = it / 132; const int kvh = r & 1, b = r >> 1; const int hq = kvh * 4 + g;
        const bool cq = qt >= 128;
        const int q0 = cq ? (qt - 128) * 64 : qt * 64;
        const size_t qrow0 = cq ? (size_t)NT_LAT + b * 256 + q0 : (size_t)b * 8192 + q0;
        bf16x8 aq[2][2];
#pragma unroll
        for (int mi = 0; mi < 2; ++mi) {
            const int rloc = 32 * half + 16 * mi + fr; const bf16_t* qp = P + (qrow0 + rloc) * EIN + C_AQ + hq * 64;
            float x1[8], x2[8]; unpack8(*(const bf16x8*)(qp + 8 * fq), x1); unpack8(*(const bf16x8*)(qp + 32 + 8 * fq), x2);
            float ss = 0.f;
#pragma unroll
            for (int i = 0; i < 8; ++i) ss += x1[i] * x1[i] + x2[i] * x2[i];
            ss += __shfl_xor(ss, 16); ss += __shfl_xor(ss, 32);
            const float rn = rsqrtf(ss * (1.0f / 64.0f) + EPS);
#pragma unroll
            for (int i = 0; i < 8; ++i) { x1[i] *= rn * qkg[8 * fq + i]; x2[i] *= rn * qkg[32 + 8 * fq + i]; }
            if (!cq) { const int pos = q0 + rloc; const float* cp = axc + pos * 32 + 8 * fq; const float* sp = axs + pos * 32 + 8 * fq;
#pragma unroll
                for (int i = 0; i < 8; ++i) { const float c = cp[i], s = sp[i]; const float o1 = x1[i] * c - x2[i] * s, o2 = x2[i] * c + x1[i] * s; x1[i] = o1; x2[i] = o2; } }
            aq[mi][0] = pack8(x1); aq[mi][1] = pack8(x2); }
        float m_[2], l_[2]; f32x4 oacc[2][4];
        const float sk = sink[hq] * 1.4426950408889634f;
#pragma unroll
        for (int mi = 0; mi < 2; ++mi) { m_[mi] = sk; l_[mi] = 1.0f;
#pragma unroll
            for (int i = 0; i < 4; ++i) oacc[mi][i] = (f32x4){0.f, 0.f, 0.f, 0.f}; }
        for (int round = cq ? 1 : 0; round < 2; ++round) {
            const bool kc = round == 1;
            int kstart, nkeys; size_t krow0;
            if (!kc) { kstart = q0 - 128 < 0 ? 0 : q0 - 128; const int kend = q0 + 192 > 8192 ? 8192 : q0 + 192; nkeys = kend - kstart; krow0 = (size_t)b * 8192 + kstart; }
            else { kstart = 0; nkeys = 256; krow0 = (size_t)NT_LAT + b * 256; }
            __syncthreads();
            for (int task = tid; task < nkeys * 4; task += NTHREADS) {
                const int key = task >> 2, c = task & 3; const bf16_t* kp = P + (krow0 + key) * EIN + C_AK + kvh * 64;
                float x1[8], x2[8]; unpack8(*(const bf16x8*)(kp + 8 * c), x1); unpack8(*(const bf16x8*)(kp + 32 + 8 * c), x2);
                float ss = 0.f;
#pragma unroll
                for (int i = 0; i < 8; ++i) ss += x1[i] * x1[i] + x2[i] * x2[i];
                ss += __shfl_xor(ss, 1); ss += __shfl_xor(ss, 2);
                const float rn = rsqrtf(ss * (1.0f / 64.0f) + EPS);
#pragma unroll
                for (int i = 0; i < 8; ++i) { x1[i] *= rn * qkg[64 + 8 * c + i]; x2[i] *= rn * qkg[64 + 32 + 8 * c + i]; }
                if (!kc) { const int pos = kstart + key; const float* cp = axc + pos * 32 + 8 * c; const float* sp = axs + pos * 32 + 8 * c;
#pragma unroll
                    for (int i = 0; i < 8; ++i) { const float cs = cp[i], sn = sp[i]; const float o1 = x1[i] * cs - x2[i] * sn, o2 = x2[i] * cs + x1[i] * sn; x1[i] = o1; x2[i] = o2; } }
                *(LAS bf16x8*)(Ks + key * 72 + 8 * c) = pack8(x1); *(LAS bf16x8*)(Ks + key * 72 + 32 + 8 * c) = pack8(x2);
            }
            for (int task = tid; task < nkeys * 8; task += NTHREADS) { const int key = task >> 3, c = task & 7;
                *(LAS bf16x8*)(Vl + key * 72 + 8 * c) = *(const bf16x8*)(P + (krow0 + key) * EIN + C_AV + kvh * 64 + 8 * c); }
            __syncthreads();
            for (int kb = 0; kb < (nkeys >> 6); ++kb) {
                const int kpos0 = kstart + 64 * kb;
                if (!kc) { const int rlo = q0 + 32 * half; if (kpos0 + 64 <= rlo - 128 || kpos0 > rlo + 31 + 128) continue; }
                f32x4 sacc[2][4];
#pragma unroll
                for (int n = 0; n < 4; ++n) { sacc[0][n] = (f32x4){0.f, 0.f, 0.f, 0.f}; sacc[1][n] = sacc[0][n];
#pragma unroll
                    for (int ks = 0; ks < 2; ++ks) { const bf16x8 bk = *(const LAS bf16x8*)(Ks + (64 * kb + 16 * n + fr) * 72 + ks * 32 + 8 * fq);
                        sacc[0][n] = MFMA16(bk, aq[0][ks], sacc[0][n]); sacc[1][n] = MFMA16(bk, aq[1][ks], sacc[1][n]); } }
                bf16x8 pf[2][2];
#pragma unroll
                for (int mi = 0; mi < 2; ++mi) {
                    const int qpos = q0 + 32 * half + 16 * mi + fr;
                    float mx = -INFINITY;
#pragma unroll
                    for (int n = 0; n < 4; ++n)
#pragma unroll
                        for (int i = 0; i < 4; ++i) { float s = sacc[mi][n][i] * 0.18033688011112042f;
                            if (!kc) { const int dlt = (kpos0 + 16 * n + 4 * fq + i) - qpos; if (dlt > 128 || dlt < -128) s = -INFINITY; }
                            sacc[mi][n][i] = s; mx = fmaxf(mx, s); }
                    mx = fmaxf(mx, __shfl_xor(mx, 16)); mx = fmaxf(mx, __shfl_xor(mx, 32));
                    const float mn = fmaxf(m_[mi], mx); const float alpha = __builtin_amdgcn_exp2f(m_[mi] - mn); m_[mi] = mn; float rs = 0.f;
#pragma unroll
                    for (int n = 0; n < 4; ++n)
#pragma unroll
                        for (int i = 0; i < 4; ++i) { const float p = __builtin_amdgcn_exp2f(sacc[mi][n][i] - mn); sacc[mi][n][i] = p; rs += p; }
                    rs += __shfl_xor(rs, 16); rs += __shfl_xor(rs, 32);
                    l_[mi] = l_[mi] * alpha + rs;
#pragma unroll
                    for (int nd = 0; nd < 4; ++nd) oacc[mi][nd] *= alpha;
#pragma unroll
                    for (int k2 = 0; k2 < 2; ++k2) { u32x4 w; w.x = pk2(sacc[mi][2 * k2][0], sacc[mi][2 * k2][1]); w.y = pk2(sacc[mi][2 * k2][2], sacc[mi][2 * k2][3]);
                        w.z = pk2(sacc[mi][2 * k2 + 1][0], sacc[mi][2 * k2 + 1][1]); w.w = pk2(sacc[mi][2 * k2 + 1][2], sacc[mi][2 * k2 + 1][3]); pf[mi][k2] = __builtin_bit_cast(bf16x8, w); }
                }
#pragma unroll
                for (int k2 = 0; k2 < 2; ++k2)
#pragma unroll
                    for (int nd = 0; nd < 4; ++nd) {
                        const LAS bf16_t* vp = Vl + (64 * kb + 32 * k2 + 4 * fq + (fr >> 2)) * 72 + 16 * nd + 4 * (fr & 3);
                        const s16x4 lo = __builtin_amdgcn_ds_read_tr16_b64_v4i16((LAS s16x4*)vp), hi = __builtin_amdgcn_ds_read_tr16_b64_v4i16((LAS s16x4*)(vp + 16 * 72));
                        const bf16x8 vf = __builtin_shufflevector(lo, hi, 0, 1, 2, 3, 4, 5, 6, 7);
                        oacc[0][nd] = MFMA16(vf, pf[0][k2], oacc[0][nd]); oacc[1][nd] = MFMA16(vf, pf[1][k2], oacc[1][nd]); }
            }
        }
#pragma unroll
        for (int mi = 0; mi < 2; ++mi) { const float inv = 1.0f / l_[mi]; bf16_t* op = mix + (qrow0 + 32 * half + 16 * mi + fr) * 1024 + hq * 64 + 4 * fq;
#pragma unroll
            for (int nd = 0; nd < 4; ++nd) { const f32x4 r = oacc[mi][nd] * inv; u32x2 w; w.x = pk2(r[0], r[1]); w.y = pk2(r[2], r[3]); *(u32x2*)(op + 16 * nd) = w; } }
    }
}

#define HG_ROW0(n_) ((n_) < 4 ? (size_t)NT_LAT + b * 256 + (dir ? 3 - (n_) : (n_)) * 64 : (size_t)b * 8192 + (dir ? 127 - ((n_) - 4) : (n_) - 4) * 64)
constexpr int HP_QI = 0, HP_QO = 17408, HP_KI = 34816, HP_KP = 52224, HP_V = 69632, HP_PM = 87040, HP_RED = 96256;
DI void hgrn_prep_phase(int wv, const bf16_t* P, bf16_t* mix, bf16_t* ob, const float* lb, bf16_t* sq, bf16_t* sk, float* sd, LAS unsigned char* lds) {
    const int tid = pg8::pg8_opaque_tid(wv), lane = tid & 63, wave = __builtin_amdgcn_readfirstlane(tid >> 6);
    const int fr = lane & 15, fq = lane >> 4;
    LAS bf16_t* Qi = (LAS bf16_t*)(lds + HP_QI); LAS bf16_t* Qo = (LAS bf16_t*)(lds + HP_QO); LAS bf16_t* Ki = (LAS bf16_t*)(lds + HP_KI); LAS bf16_t* Kp = (LAS bf16_t*)(lds + HP_KP);
    LAS bf16_t* Vl = (LAS bf16_t*)(lds + HP_V); LAS bf16_t* Pm = (LAS bf16_t*)(lds + HP_PM); LAS float* red = (LAS float*)(lds + HP_RED);
    const int d = tid & 127, part = tid >> 7, vt = tid >> 3, vc = tid & 7;
    unsigned short fraw[16], qraw[16]; bf16x8 vr0, vr1;
#define HP_LOAD(it_) do { const int n_ = (it_) % 132; const int u_ = (it_) / 132; const int dir = u_ & 1, h = (u_ >> 1) & 3, b = u_ >> 3; const size_t r0_ = HG_ROW0(n_); \
        const int cf_ = (dir ? C_BFB : C_BFF) + h * 128 + d, cq_ = C_BQ + h * 128 + d; \
        _Pragma("unroll") for (int i = 0; i < 16; ++i) { const int t = 16 * part + i; const int tok = dir ? 63 - t : t; const bf16_t* rp = P + (r0_ + tok) * EIN; fraw[i] = rp[cf_]; qraw[i] = rp[cq_]; } \
        { const int tok = dir ? 63 - vt : vt; const bf16_t* vp = P + (r0_ + tok) * EIN + C_BI + h * 128 + 8 * vc; vr0 = *(const bf16x8*)vp; vr1 = *(const bf16x8*)(vp + 64); } } while (0)
    if ((int)blockIdx.x < 8448) HP_LOAD(8447 - (int)blockIdx.x);
    for (int itf = blockIdx.x; itf < 8448; itf += gridDim.x) { const int it = 8447 - itf;
        const int n = it % 132; const int u3 = it / 132; const int dir = u3 & 1, h = (u3 >> 1) & 3, b = u3 >> 3;
        const size_t row0 = HG_ROW0(n);
        const float lbv = lb[h * 128 + d];
        float lf[16], kk[16], qs[16];
#pragma unroll
        for (int i = 0; i < 16; ++i) { const float fr_ = bf2f(fraw[i]), qr = bf2f(qraw[i]); const float f = lbv + (1.0f - lbv) * sigmf(fr_);
            lf[i] = flog(f); kk[i] = 1.0f - f; qs[i] = siluf(qr); }
#pragma unroll
        for (int i = 1; i < 16; ++i) lf[i] += lf[i - 1];
        const bf16x8 vc0 = vr0, vc1 = vr1;
        if (itf + (int)gridDim.x < 8448) HP_LOAD(8447 - (itf + (int)gridDim.x));
        __syncthreads();
        red[part * 128 + d] = lf[15]; if (part == 2) red[512 + d] = lf[0];
        *(LAS bf16x8*)(Vl + vt * 136 + 8 * vc) = vc0; *(LAS bf16x8*)(Vl + vt * 136 + 8 * vc + 64) = vc1;
        __syncthreads();
        {   const float r0 = red[d], r1 = red[128 + d], r2 = red[256 + d], r3 = red[384 + d], l32 = red[512 + d];
            const float pre = part == 0 ? 0.f : (part == 1 ? r0 : (part == 2 ? r0 + r1 : r0 + r1 + r2));
            const float total = (r0 + r1) + (r2 + r3), ref = r0 + r1 + l32;
            const float eref = fexp(ref), etr = fexp(total - ref);
            if (part == 0) sd[(size_t)it * 128 + d] = fexp(total);
            float kp[16];
#pragma unroll
            for (int i = 0; i < 16; ++i) { const float cum = pre + lf[i]; const int t = 16 * part + i;
                const float e1 = fexp(cum - ref), e2 = __builtin_amdgcn_rcpf(e1); const float qe = qs[i] * e1, ke = kk[i] * e2;
                Qi[t * 136 + d] = f2bf(qe); Qo[t * 136 + d] = f2bf(qe * eref); Ki[t * 136 + d] = f2bf(ke); kp[i] = ke * etr; }
            bf16_t* gk = sk + (size_t)it * 8192 + d * 64 + 16 * part;
            *(bf16x8*)gk = pack8(kp); *(bf16x8*)(gk + 8) = pack8(kp + 8); }
        __syncthreads();
        {   bf16_t* gq = sq + (size_t)it * 8192 + vt * 128 + 8 * vc;
            *(bf16x8*)gq = *(const LAS bf16x8*)(Qo + vt * 136 + 8 * vc); *(bf16x8*)(gq + 64) = *(const LAS bf16x8*)(Qo + vt * 136 + 8 * vc + 64); }
        {   const int mt = wave >> 1, nt0 = 2 * (wave & 1); f32x4 sc[2]; sc[0] = (f32x4){0.f, 0.f, 0.f, 0.f}; sc[1] = sc[0];
#pragma unroll
            for (int ks = 0; ks < 4; ++ks) { const bf16x8 a = *(const LAS bf16x8*)(Qi + (16 * mt + fr) * 136 + ks * 32 + 8 * fq);
#pragma unroll
                for (int n2 = 0; n2 < 2; ++n2) { const bf16x8 bb = *(const LAS bf16x8*)(Ki + (16 * (nt0 + n2) + fr) * 136 + ks * 32 + 8 * fq); sc[n2] = MFMA16(a, bb, sc[n2]); } }
#pragma unroll
            for (int n2 = 0; n2 < 2; ++n2)
#pragma unroll
                for (int i = 0; i < 4; ++i) { const int t = 16 * mt + 4 * fq + i, s = 16 * (nt0 + n2) + fr; Pm[t * 72 + s] = f2bf(s <= t ? sc[n2][i] : 0.f); } }
        __syncthreads();
        {   const int mt = wave >> 1, nq = 4 * (wave & 1); f32x4 o[4];
#pragma unroll
            for (int j = 0; j < 4; ++j) o[j] = (f32x4){0.f, 0.f, 0.f, 0.f};
#pragma unroll
            for (int ks = 0; ks < 2; ++ks) { const bf16x8 a = *(const LAS bf16x8*)(Pm + (16 * mt + fr) * 72 + ks * 32 + 8 * fq);
#pragma unroll
                for (int j = 0; j < 4; ++j) { const bf16x8 bb = tr_frag(Vl, 136, 32 * ks, 16 * (nq + j), lane); o[j] = MFMA16(bb, a, o[j]); } }
            {   const int t = 16 * mt + fr; const int tok = dir ? 63 - t : t;
                bf16_t* op = dir ? ob + (row0 + tok) * 512 + h * 128 + 16 * nq + 4 * fq : mix + (row0 + tok) * 1024 + 512 + h * 128 + 16 * nq + 4 * fq;
#pragma unroll
                for (int j = 0; j < 4; ++j) { u32x2 w; w.x = pk2(o[j][0], o[j][1]); w.y = pk2(o[j][2], o[j][3]); *(u32x2*)(op + 16 * j) = w; } } }
    }
}
constexpr int HS_V = 0, HS_ST = 5120;
DI void hgrn_scan_phase(int wv, const bf16_t* P, bf16_t* mix, bf16_t* ob, const bf16_t* sq, const bf16_t* sk, const float* sd, LAS unsigned char* lds) {
    const int tid = pg8::pg8_opaque_tid(wv), lane = tid & 63, wave = __builtin_amdgcn_readfirstlane(tid >> 6);
    const int fr = lane & 15, fq = lane >> 4;
    LAS bf16_t* Vl = (LAS bf16_t*)(lds + HS_V); LAS bf16_t* St = (LAS bf16_t*)(lds + HS_ST);
    const int vt = tid >> 2, vc = tid & 3, mt = wave >> 1, nt = wave & 1;
    for (int unit = blockIdx.x; unit < 256; unit += gridDim.x) {
        const int gx = (unit & 7) * 8 + (unit >> 5), sl = (unit >> 3) & 3, dir = gx & 1, h = (gx >> 1) & 3, b = gx >> 3;
        const size_t item0 = (size_t)(((b * 4 + h) * 2 + dir) * 132);
        __syncthreads();
        for (int i = tid; i < 8704 / 4; i += NTHREADS) ((LAS unsigned*)(lds + HS_ST))[i] = 0u;
        f32x4 sacc[2]; sacc[0] = (f32x4){0.f, 0.f, 0.f, 0.f}; sacc[1] = sacc[0];
        bf16x8 aq[2][4], ak[2][2], vv[2]; f32x4 dv[2]; u32x2 oold[2];
        vv[0] = (bf16x8){0, 0, 0, 0, 0, 0, 0, 0}; vv[1] = vv[0];
        const int otok = dir ? 63 - (16 * mt + fr) : 16 * mt + fr;
        bf16_t* obase = dir ? ob + (size_t)otok * 512 + h * 128 + sl * 32 + 16 * nt + 4 * fq : mix + (size_t)otok * 1024 + 512 + h * 128 + sl * 32 + 16 * nt + 4 * fq;
        const int ostr = dir ? 512 : 1024;
#define HS_LOAD(s_, n_) do { const size_t it_ = item0 + (n_); const size_t r0_ = HG_ROW0(n_); \
            const bf16_t* gq = sq + it_ * 8192 + (16 * mt + fr) * 128 + 8 * fq; const bf16_t* gk = sk + it_ * 8192 + (16 * wave + fr) * 64 + 8 * fq; \
            _Pragma("unroll") for (int ks = 0; ks < 4; ++ks) aq[s_][ks] = *(const bf16x8*)(gq + 32 * ks); \
            ak[s_][0] = *(const bf16x8*)gk; ak[s_][1] = *(const bf16x8*)(gk + 32); \
            if (tid < 256) { const int tok = dir ? 63 - vt : vt; vv[s_] = *(const bf16x8*)(P + (r0_ + tok) * EIN + C_BI + h * 128 + sl * 32 + 8 * vc); } \
            dv[s_] = *(const f32x4*)(sd + it_ * 128 + 16 * wave + 4 * fq); \
            oold[s_] = *(const u32x2*)(obase + r0_ * ostr); } while (0)
        HS_LOAD(0, 0); HS_LOAD(1, 1);
        for (int n0 = 0; n0 < 132; n0 += 2) {
#pragma unroll
          for (int s = 0; s < 2; ++s) {
            const int n = n0 + s;
            const size_t row0 = HG_ROW0(n);
            if (tid < 256) *(LAS bf16x8*)(Vl + vt * 40 + 8 * vc) = vv[s];
            bf16x8 a4[4], k2[2]; f32x4 o, d4 = dv[s];
#pragma unroll
            for (int ks = 0; ks < 4; ++ks) a4[ks] = aq[s][ks];
            k2[0] = ak[s][0]; k2[1] = ak[s][1];
            o[0] = __uint_as_float(oold[s].x << 16); o[1] = __uint_as_float(oold[s].x & 0xffff0000u); o[2] = __uint_as_float(oold[s].y << 16); o[3] = __uint_as_float(oold[s].y & 0xffff0000u);
            if (n + 2 < 132) HS_LOAD(s, n + 2);
            __syncthreads();
            {
#pragma unroll
                for (int ks = 0; ks < 4; ++ks) { const bf16x8 bb = *(const LAS bf16x8*)(St + (16 * nt + fr) * 136 + ks * 32 + 8 * fq); o = MFMA16(bb, a4[ks], o); }
                u32x2 w; w.x = pk2(o[0], o[1]); w.y = pk2(o[2], o[3]); *(u32x2*)(obase + row0 * ostr) = w; }
            {   sacc[0] *= d4; sacc[1] *= d4;
#pragma unroll
                for (int ks = 0; ks < 2; ++ks) {
#pragma unroll
                    for (int et = 0; et < 2; ++et) { const bf16x8 bb = tr_frag(Vl, 40, 32 * ks, 16 * et, lane); sacc[et] = MFMA16(k2[ks], bb, sacc[et]); } } }
            __syncthreads();
#pragma unroll
            for (int et = 0; et < 2; ++et) { u32x2 w; w.x = pk2(sacc[et][0], sacc[et][1]); w.y = pk2(sacc[et][2], sacc[et][3]);
                *(LAS u32x2*)(St + (16 * et + fr) * 136 + 16 * wave + 4 * fq) = w; }
          }
        }
#undef HS_LOAD
    }
}
#undef HP_LOAD
#undef HG_ROW0
DI void hgrn_norm_phase(int wv, const bf16_t* P, bf16_t* mix, const bf16_t* ob, const float* outg) {
    const int tid = pg8::pg8_opaque_tid(wv), lane = tid & 63, wave = __builtin_amdgcn_readfirstlane(tid >> 6);
    const int gw = blockIdx.x * NWAVES + wave, ngw = gridDim.x * NWAVES;
    float gv[8];
#pragma unroll
    for (int i = 0; i < 8; ++i) gv[i] = outg[8 * (lane & 15) + i];
    for (int row0 = gw * 4; row0 < NT_ALL; row0 += ngw * 4) {
        bf16x8 a[4], b[4], g[4];
#pragma unroll
        for (int u = 0; u < 4; ++u) { const size_t row = (size_t)row0 + u;
            a[u] = *(const bf16x8*)(mix + row * 1024 + 512 + 8 * lane); b[u] = *(const bf16x8*)(ob + row * 512 + 8 * lane); g[u] = *(const bf16x8*)(P + row * EIN + C_BG + 8 * lane); }
#pragma unroll
        for (int u = 0; u < 4; ++u) { const size_t row = (size_t)row0 + u;
            float of[8], o2[8], gg[8]; unpack8(a[u], of); unpack8(b[u], o2); unpack8(g[u], gg);
            float ss = 0.f;
#pragma unroll
            for (int i = 0; i < 8; ++i) { of[i] += o2[i]; ss += of[i] * of[i]; }
            ss += __shfl_xor(ss, 1); ss += __shfl_xor(ss, 2); ss += __shfl_xor(ss, 4); ss += __shfl_xor(ss, 8);
            const float rn = rsqrtf(ss * (1.0f / 128.0f) + EPS);
#pragma unroll
            for (int i = 0; i < 8; ++i) of[i] = of[i] * rn * gv[i] * siluf(gg[i]);
            *(bf16x8*)(mix + row * 1024 + 512 + 8 * lane) = pack8(of); }
    }
}

constexpr int RI_Q = 0, RI_K = 33792, RI_V = 67584, RI_PM = 134144;
DI void ret_intra_norm_phase(int wv, const bf16_t* P1, bf16_t* ofw, const bf16_t* obw, LAS unsigned char* lds) {
    const int tid = pg8::pg8_opaque_tid(wv), lane = tid & 63, wave = __builtin_amdgcn_readfirstlane(tid >> 6);
    const int fr = lane & 15, fq = lane >> 4;
    LAS bf16_t* Q = (LAS bf16_t*)(lds + RI_Q); LAS bf16_t* K = (LAS bf16_t*)(lds + RI_K); LAS bf16_t* Vl = (LAS bf16_t*)(lds + RI_V); LAS bf16_t* Pm = (LAS bf16_t*)(lds + RI_PM);
    const int pt = tid >> 3, pc = tid & 7;
    bf16x8 qv[4], kv[4], vv[8];
#define RI_LOAD(it_) do { const int h_ = ((it_) >> 7) & 3; const bf16_t* rp_ = P1 + ((size_t)((it_) >> 9) * 8192 + ((it_) & 127) * 64 + pt) * OIN; \
        _Pragma("unroll") for (int j = 0; j < 4; ++j) { qv[j] = *(const bf16x8*)(rp_ + C_RQ + h_ * 256 + 64 * j + 8 * pc); kv[j] = *(const bf16x8*)(rp_ + C_RK + h_ * 256 + 64 * j + 8 * pc); } \
        _Pragma("unroll") for (int j = 0; j < 8; ++j) vv[j] = *(const bf16x8*)(rp_ + C_RV + h_ * 512 + 8 * pc + 64 * j); } while (0)
    if ((int)blockIdx.x < 2048) RI_LOAD(2047 - (int)blockIdx.x);
    for (int itf = blockIdx.x; itf < 2048; itf += gridDim.x) { const int it = 2047 - itf;
        const int cc = it & 127, h = (it >> 7) & 3, bl = it >> 9;
        const float lgf = log2f(1.0f - exp2f(-5.0f - (float)h)), lgb = log2f(1.0f - exp2f(-5.0f - (float)(3 - h)));
        const size_t row0 = (size_t)bl * 8192 + cc * 64;
        __syncthreads();
#pragma unroll
        for (int j = 0; j < 4; ++j) { *(LAS bf16x8*)(Q + pt * 264 + 64 * j + 8 * pc) = qv[j]; *(LAS bf16x8*)(K + pt * 264 + 64 * j + 8 * pc) = kv[j]; }
#pragma unroll
        for (int j = 0; j < 8; ++j) *(LAS bf16x8*)(Vl + pt * 520 + 8 * pc + 64 * j) = vv[j];
        if (itf + (int)gridDim.x < 2048) RI_LOAD(2047 - (itf + (int)gridDim.x));
        __syncthreads();
        {   const int mt = wave >> 1, nt0 = 2 * (wave & 1); f32x4 sc[2]; sc[0] = (f32x4){0.f, 0.f, 0.f, 0.f}; sc[1] = sc[0];
#pragma unroll
            for (int ks = 0; ks < 8; ++ks) { const bf16x8 a = *(const LAS bf16x8*)(Q + (16 * mt + fr) * 264 + ks * 32 + 8 * fq);
#pragma unroll
                for (int n2 = 0; n2 < 2; ++n2) { const bf16x8 bb = *(const LAS bf16x8*)(K + (16 * (nt0 + n2) + fr) * 264 + ks * 32 + 8 * fq); sc[n2] = MFMA16(a, bb, sc[n2]); } }
#pragma unroll
            for (int n2 = 0; n2 < 2; ++n2)
#pragma unroll
                for (int i = 0; i < 4; ++i) { const int t = 16 * mt + 4 * fq + i, s = 16 * (nt0 + n2) + fr; const int dl = t - s;
                    const float w = dl > 0 ? exp2f((float)dl * lgf) : (dl < 0 ? exp2f((float)(-dl) * lgb) : 2.0f);
                    Pm[t * 72 + s] = f2bf(sc[n2][i] * w); } }
        __syncthreads();
        {   f32x4 o[4][4];
#pragma unroll
            for (int mt = 0; mt < 4; ++mt)
#pragma unroll
                for (int j = 0; j < 4; ++j) o[mt][j] = (f32x4){0.f, 0.f, 0.f, 0.f};
#pragma unroll
            for (int ks = 0; ks < 2; ++ks) { bf16x8 bb[4];
#pragma unroll
                for (int j = 0; j < 4; ++j) bb[j] = tr_frag(Vl, 520, 32 * ks, 16 * (4 * wave + j), lane);
#pragma unroll
                for (int mt = 0; mt < 4; ++mt) { const bf16x8 a = *(const LAS bf16x8*)(Pm + (16 * mt + fr) * 72 + ks * 32 + 8 * fq);
#pragma unroll
                    for (int j = 0; j < 4; ++j) o[mt][j] = MFMA16(bb[j], a, o[mt][j]); } }
            LAS float* red = (LAS float*)(lds + RI_PM + 9216);
            u32x2 gq[4][4], av[4][4], bv[4][4];
#pragma unroll
            for (int mh = 0; mh < 2; ++mh) {
#pragma unroll
            for (int mt = 2 * mh; mt < 2 * mh + 2; ++mt) { const size_t grow = row0 + 16 * mt + fr; const int col = h * 512 + 64 * wave + 4 * fq;
#pragma unroll
                for (int j = 0; j < 4; ++j) { av[mt][j] = *(const u32x2*)(ofw + grow * 2048 + col + 16 * j); bv[mt][j] = *(const u32x2*)(obw + grow * 2048 + col + 16 * j); gq[mt][j] = *(const u32x2*)(P1 + grow * OIN + C_RG + col + 16 * j); } }
#pragma unroll
            for (int mt = 2 * mh; mt < 2 * mh + 2; ++mt) { float ss = 0.f;
#pragma unroll
                for (int j = 0; j < 4; ++j) { f32x4 v = o[mt][j];
                    v[0] += __uint_as_float(av[mt][j].x << 16) + __uint_as_float(bv[mt][j].x << 16); v[1] += __uint_as_float(av[mt][j].x & 0xffff0000u) + __uint_as_float(bv[mt][j].x & 0xffff0000u);
                    v[2] += __uint_as_float(av[mt][j].y << 16) + __uint_as_float(bv[mt][j].y << 16); v[3] += __uint_as_float(av[mt][j].y & 0xffff0000u) + __uint_as_float(bv[mt][j].y & 0xffff0000u);
                    o[mt][j] = v; ss += (v[0] * v[0] + v[1] * v[1]) + (v[2] * v[2] + v[3] * v[3]); }
                ss += __shfl_xor(ss, 16); ss += __shfl_xor(ss, 32);
                if (fq == 0) red[(16 * mt + fr) * 8 + wave] = ss; }
            asm volatile("" ::: "memory"); }
            __syncthreads();
#pragma unroll
            for (int mt = 0; mt < 4; ++mt) { const size_t grow = row0 + 16 * mt + fr; const int col = h * 512 + 64 * wave + 4 * fq;
                const f32x4 r0 = *(const LAS f32x4*)(red + (16 * mt + fr) * 8), r1 = *(const LAS f32x4*)(red + (16 * mt + fr) * 8 + 4);
                const float rn = rsqrtf((((r0[0] + r0[1]) + (r0[2] + r0[3])) + ((r1[0] + r1[1]) + (r1[2] + r1[3]))) * (1.0f / 512.0f) + EPS);
#pragma unroll
                for (int j = 0; j < 4; ++j) { const f32x4 v = o[mt][j];
                    const float g0 = __uint_as_float(gq[mt][j].x << 16), g1 = __uint_as_float(gq[mt][j].x & 0xffff0000u), g2 = __uint_as_float(gq[mt][j].y << 16), g3 = __uint_as_float(gq[mt][j].y & 0xffff0000u);
                    u32x2 w; w.x = pk2(v[0] * rn * siluf(g0), v[1] * rn * siluf(g1)); w.y = pk2(v[2] * rn * siluf(g2), v[3] * rn * siluf(g3));
                    *(u32x2*)(ofw + grow * 2048 + col + 16 * j) = w; } } }
    }
}
#undef RI_LOAD
constexpr int RT_Q = 0, RT_K = 33792, RT_VS = 67584, RT_ST = 76800;
DI void ret_scan_phase(int wv, const bf16_t* P1, bf16_t* ofw, bf16_t* obw, LAS unsigned char* lds) {
    const int tid = pg8::pg8_opaque_tid(wv), lane = tid & 63, wave = __builtin_amdgcn_readfirstlane(tid >> 6);
    const int fr = lane & 15, fq = lane >> 4;
    LAS bf16_t* Q = (LAS bf16_t*)(lds + RT_Q); LAS bf16_t* K = (LAS bf16_t*)(lds + RT_K); LAS bf16_t* Vs = (LAS bf16_t*)(lds + RT_VS); LAS bf16_t* St = (LAS bf16_t*)(lds + RT_ST);
    const int mt = wave >> 1, et0 = 2 * (wave & 1);
    for (int unit = blockIdx.x; unit < 256; unit += gridDim.x) {
        const int gx = (unit & 7) * 4 + (unit >> 6), sl = (unit >> 3) & 7, dir = gx & 1, h = (gx >> 1) & 3, bl = gx >> 3;
        const int hh = dir ? 3 - h : h;
        const float lg2 = log2f(1.0f - exp2f(-5.0f - (float)hh));
        const float g64 = exp2f(64.0f * lg2);
        __syncthreads();
        for (int i = tid; i < 33792 / 4; i += NTHREADS) ((LAS unsigned*)(lds + RT_ST))[i] = 0u;
        f32x4 sacc[2][4];
#pragma unroll
        for (int a = 0; a < 2; ++a)
#pragma unroll
            for (int e = 0; e < 4; ++e) sacc[a][e] = (f32x4){0.f, 0.f, 0.f, 0.f};
        const int pt = tid >> 3, pc = tid & 7;
        const int ptok = dir ? 63 - pt : pt;
        const float vscl = exp2f((float)(63 - pt) * lg2);
        const float rsc = exp2f((float)(16 * mt + fr + 1) * lg2);
        bf16x8 qv[2][4], kv[2][4], vv[2];
        const int otok = dir ? 63 - (16 * mt + fr) : 16 * mt + fr;
        bf16_t* obase = (dir ? obw : ofw) + (size_t)otok * 2048 + h * 512 + sl * 64 + 16 * et0 + 4 * fq;
#define RT_ROW0(n_) ((n_) < 4 ? (size_t)32768 + bl * 256 + (dir ? 3 - (n_) : (n_)) * 64 : (size_t)bl * 8192 + (dir ? 127 - ((n_) - 4) : (n_) - 4) * 64)
#define RT_LOAD(s_, n_) do { const size_t r0_ = RT_ROW0(n_); const bf16_t* rp_ = P1 + (r0_ + ptok) * OIN; \
            _Pragma("unroll") for (int j = 0; j < 4; ++j) { qv[s_][j] = *(const bf16x8*)(rp_ + C_RQ + h * 256 + 64 * j + 8 * pc); kv[s_][j] = *(const bf16x8*)(rp_ + C_RK + h * 256 + 64 * j + 8 * pc); } \
            vv[s_] = *(const bf16x8*)(rp_ + C_RV + h * 512 + sl * 64 + 8 * pc); } while (0)
        RT_LOAD(0, 0); RT_LOAD(1, 1);
        for (int n0 = 0; n0 < 132; n0 += 2) {
#pragma unroll
          for (int s = 0; s < 2; ++s) {
            const int n = n0 + s;
            const bool is_ctx = n < 4; const size_t row0 = RT_ROW0(n);
#pragma unroll
            for (int j = 0; j < 4; ++j) { *(LAS bf16x8*)(Q + pt * 264 + 64 * j + 8 * pc) = qv[s][j]; *(LAS bf16x8*)(K + pt * 264 + 64 * j + 8 * pc) = kv[s][j]; }
            {   float vf[8]; unpack8(vv[s], vf);
#pragma unroll
                for (int i = 0; i < 8; ++i) vf[i] *= vscl;
                *(LAS bf16x8*)(Vs + pt * 72 + 8 * pc) = pack8(vf); }
            if (n + 2 < 132) RT_LOAD(s, n + 2);
            __syncthreads();
            if (!is_ctx) { f32x4 oi[2]; oi[0] = (f32x4){0.f, 0.f, 0.f, 0.f}; oi[1] = oi[0];
#pragma unroll
                for (int ks = 0; ks < 8; ++ks) { const bf16x8 a = *(const LAS bf16x8*)(Q + (16 * mt + fr) * 264 + ks * 32 + 8 * fq);
#pragma unroll
                    for (int e2 = 0; e2 < 2; ++e2) { const bf16x8 bb = *(const LAS bf16x8*)(St + (16 * (et0 + e2) + fr) * 264 + ks * 32 + 8 * fq); oi[e2] = MFMA16(bb, a, oi[e2]); } }
#pragma unroll
                for (int e2 = 0; e2 < 2; ++e2) { const f32x4 r = oi[e2] * rsc; u32x2 w; w.x = pk2(r[0], r[1]); w.y = pk2(r[2], r[3]); *(u32x2*)(obase + row0 * 2048 + 16 * e2) = w; } }
            {
#pragma unroll
                for (int dt = 0; dt < 2; ++dt)
#pragma unroll
                    for (int et = 0; et < 4; ++et) sacc[dt][et] *= g64;
#pragma unroll
                for (int ks = 0; ks < 2; ++ks) { bf16x8 bb[4];
#pragma unroll
                    for (int et = 0; et < 4; ++et) bb[et] = tr_frag(Vs, 72, 32 * ks, 16 * et, lane);
#pragma unroll
                    for (int dt = 0; dt < 2; ++dt) { const bf16x8 a = tr_frag(K, 264, 32 * ks, 16 * (2 * wave + dt), lane);
#pragma unroll
                        for (int et = 0; et < 4; ++et) sacc[dt][et] = MFMA16(a, bb[et], sacc[dt][et]); } } }
            __syncthreads();
#pragma unroll
            for (int dt = 0; dt < 2; ++dt)
#pragma unroll
                for (int et = 0; et < 4; ++et) { u32x2 w; w.x = pk2(sacc[dt][et][0], sacc[dt][et][1]); w.y = pk2(sacc[dt][et][2], sacc[dt][et][3]);
                    *(LAS u32x2*)(St + (16 * et + fr) * 264 + 16 * (2 * wave + dt) + 4 * fq) = w; }
          }
        }
#undef RT_LOAD
#undef RT_ROW0
    }
}
DI void ret_norm_phase(int wv, const bf16_t* P1, bf16_t* ofw, const bf16_t* obw) {
    const int tid = pg8::pg8_opaque_tid(wv), lane = tid & 63, wave = __builtin_amdgcn_readfirstlane(tid >> 6);
    const int gw = blockIdx.x * NWAVES + wave, ngw = gridDim.x * NWAVES;
    for (int idx0 = gw * 4; idx0 < 32768 * 4; idx0 += ngw * 4) {
        bf16x8 a[4], b[4], g[4];
#pragma unroll
        for (int u = 0; u < 4; ++u) { const int idx = idx0 + u; const int row = idx >> 2, h = idx & 3;
            a[u] = *(const bf16x8*)(ofw + (size_t)row * 2048 + h * 512 + 8 * lane); b[u] = *(const bf16x8*)(obw + (size_t)row * 2048 + h * 512 + 8 * lane);
            g[u] = *(const bf16x8*)(P1 + (size_t)row * OIN + C_RG + h * 512 + 8 * lane); }
#pragma unroll
        for (int u = 0; u < 4; ++u) { const int idx = idx0 + u; const int row = idx >> 2, h = idx & 3;
            float of[8], o2[8], gg[8]; unpack8(a[u], of); unpack8(b[u], o2); unpack8(g[u], gg);
            float ss = 0.f;
#pragma unroll
            for (int i = 0; i < 8; ++i) { of[i] += o2[i]; ss += of[i] * of[i]; }
            const float rn = rsqrtf(wave_sum(ss) * (1.0f / 512.0f) + EPS);
#pragma unroll
            for (int i = 0; i < 8; ++i) of[i] = of[i] * rn * siluf(gg[i]);
            *(bf16x8*)(ofw + (size_t)row * 2048 + h * 512 + 8 * lane) = pack8(of); }
    }
}

template <class Epi>
DI void run_gemm(int wv, LAS unsigned char* lds, const bf16_t* A, const bf16_t* Bt, int M, int N, int K, const Epi& E, int rev = 0) {
    pg8::Gemm g{A, Bt, M, N, K}; pg8::StaticOrder S; S.init(M, N, (int)gridDim.x, (int)blockIdx.x, rev);
    pg8::gemm_phase<Epi, pg8::StaticOrder, false>(lds, g, S, E, nullptr, wv);
}

__global__ void __launch_bounds__(NTHREADS, 2) fwd_megakernel(Args a) {
    extern __shared__ __attribute__((aligned(16))) unsigned char lds_raw[];
    LAS unsigned char* lds = (LAS unsigned char*)lds_raw;
    cg::grid_group grid = cg::this_grid();
    const int wave_s = __builtin_amdgcn_readfirstlane((int)(threadIdx.x >> 6));
    volatile LAS unsigned* xbst = (volatile LAS unsigned*)(lds + 157680);
    if (threadIdx.x < 4) xbst[threadIdx.x] = 0u;
    __syncthreads();
    (void)xcd_barrier_post((unsigned*)(a.ws + WS_BAR), xbst);
#define GBAR() do { XcdBarrier xb_; xb_.bar = (unsigned*)(a.ws + WS_BAR); xb_.x = xb_xcc_id(); xb_.wv = wave_s; xb_.st = (volatile LAS unsigned*)(lds + 157680); xcd_barrier(xb_); } while (0)
    unsigned char* ws = a.ws;
    bf16_t* wt_ein = (bf16_t*)(ws + WS_WT_EIN); bf16_t* wt_eout = (bf16_t*)(ws + WS_WT_EOUT); bf16_t* wt_oin = (bf16_t*)(ws + WS_WT_OIN); bf16_t* wt_oout = (bf16_t*)(ws + WS_WT_OOUT);
    bf16_t* wt_fin = (bf16_t*)(ws + WS_WT_FIN); bf16_t* wt_fout = (bf16_t*)(ws + WS_WT_FOUT);
    float* mods = (float*)(ws + WS_MODS); float* axt = (float*)(ws + WS_ROPE_AX); float* rtt = (float*)(ws + WS_ROPE_RT); float* lb = (float*)(ws + WS_LB);
    float* gs = (float*)(ws + WS_GS); float* bias3 = (float*)(ws + WS_BIAS3); float* bias5 = (float*)(ws + WS_BIAS5); float* bias7 = (float*)(ws + WS_BIAS7);
    float* rss_a = (float*)(ws + WS_RSS_A); float* rss_b = (float*)(ws + WS_RSS_B); float* rss_c = (float*)(ws + WS_RSS_C);
    float* ctxr = (float*)(ws + WS_CTXR); bf16_t* ha = (bf16_t*)(ws + WS_HA); bf16_t* obuf = (bf16_t*)(ws + WS_OB); bf16_t* big = (bf16_t*)(ws + WS_BIG);
    bf16_t* ofw = (bf16_t*)(ws + WS_OFW); bf16_t* obw = (bf16_t*)(ws + WS_OBW);
    const float* x = a.in[0]; const float* ctx = a.in[2]; const float* normg = a.in[6]; float* out = a.out;

    mods_phase(wave_s, a, mods, lds);
    __syncthreads();
    tables_phase(wave_s, a, axt, rtt, lb, rss_a, (int)((WS_HA - WS_RSS_A) / 4));
    {   const int tid = pg8::pg8_opaque_tid(wave_s), lane = tid & 63, wave = __builtin_amdgcn_readfirstlane(tid >> 6);
        LAS float* scr = (LAS float*)(lds + wave * 16384);
        const int gw = blockIdx.x * NWAVES + wave, ngw = gridDim.x * NWAVES; int it0 = 0;
        transpose_matrix(a.in[9], DM, EIN, wt_ein, false, it0, gw, ngw, scr, lane);
        transpose_matrix(a.in[10], DM, DM, wt_eout, false, it0, gw, ngw, scr, lane);
        transpose_matrix(a.in[15], DM, OIN, wt_oin, false, it0, gw, ngw, scr, lane);
        transpose_matrix(a.in[16], 2048, DM, wt_oout, false, it0, gw, ngw, scr, lane);
        transpose_matrix(a.in[7], DM, 2 * FF, wt_fin, true, it0, gw, ngw, scr, lane);
        transpose_matrix(a.in[7] + (size_t)DM * 2 * FF, DM, 2 * FF, wt_fin + (size_t)2 * FF * DM, true, it0, gw, ngw, scr, lane);
        transpose_matrix(a.in[8], FF, DM, wt_fout, false, it0, gw, ngw, scr, lane);
        transpose_matrix(a.in[8] + (size_t)FF * DM, FF, DM, wt_fout + (size_t)DM * FF, false, it0, gw, ngw, scr, lane);
    }
    grid.sync();

    const float* mods0 = mods; const float* mods1 = mods + 9 * 6144;
    normmod_phase(wave_s, x, ctx, 0, NT_LAT, NT_ALL, normg + 0, mods0, 0, ha);
    aux_phase(wave_s, normg, mods, wt_fin, wt_oin, gs, bias3, bias5, bias7);
    GBAR();
    {   pg8::EpiStoreBf16 E{big, EIN}; run_gemm(wave_s, lds, ha, wt_ein, NT_ALL, EIN, DM, E); }
    GBAR();
    bf16_t* hsq = big + (size_t)NT_ALL * EIN; bf16_t* hsk = hsq + (size_t)8448 * 8192; float* hsd = (float*)(hsk + (size_t)8448 * 8192);
    hgrn_prep_phase(wave_s, big, ha, obuf, lb, hsq, hsk, hsd, lds);
    GBAR();
    hgrn_scan_phase(wave_s, big, ha, obuf, hsq, hsk, hsd, lds);
    __syncthreads();
    attn_phase(wave_s, big, ha, a.in[11], a.in[12], axt, axt + 8192 * 32, lds);
    GBAR();
    hgrn_norm_phase(wave_s, big, ha, obuf, a.in[13]);
    GBAR();
    bf16_t* a3 = big + (size_t)NT_ALL * FF;
    {   pg8::EpiResid<true> E{x, out, ctx, ctxr, mods0 + 2 * 1024, 0, NT_LAT, a3, rss_a, gs, 0}; run_gemm(wave_s, lds, ha, wt_eout, NT_ALL, DM, DM, E); }
    GBAR();
    {   pg8::EpiSwiglu E{big, FF, pg8::RowNorm{rss_a, bias3, 5632, 0, NT_LAT}}; run_gemm(wave_s, lds, a3, wt_fin, NT_ALL, 2 * FF, DM, E); }
    GBAR();
    {   pg8::EpiResid<true> E{out, out, ctxr, ctxr, mods0 + 5 * 1024, 0, NT_LAT, ha, rss_b, gs + 9 * 1024, 1}; run_gemm(wave_s, lds, big, wt_fout, NT_ALL, DM, FF, E, 1); }
    GBAR();

    bf16_t* a7 = obuf;
    for (int hb = 0; hb < 2; ++hb) {
        const int b0 = 4 * hb;
        {   pg8::EpiRopeStore E{big, OIN, rtt, rtt + 8192 * 128, 32768, pg8::RowNorm{rss_b + (size_t)hb * 33792 * 16, bias5, 6144, b0, 32768}}; run_gemm(wave_s, lds, ha + (size_t)hb * 33792 * DM, wt_oin, 33792, OIN, DM, E); }
        GBAR();
        ret_scan_phase(wave_s, big, ofw, obw, lds);
        GBAR();
        ret_intra_norm_phase(wave_s, big, ofw, obw, lds);
        GBAR();
        {   pg8::EpiResid<true> E{out, out, ctxr, ctxr, mods1 + 2 * 1024, b0, 32768, a7, rss_c + (size_t)hb * 32768 * 16, gs + 18 * 1024, 0}; run_gemm(wave_s, lds, ofw, wt_oout, 32768, DM, 2048, E); }
        GBAR();
        {   pg8::EpiSwiglu E{big, FF, pg8::RowNorm{rss_c + (size_t)hb * 32768 * 16, bias7, 5632, b0, 32768}}; run_gemm(wave_s, lds, a7, wt_fin + (size_t)2 * FF * DM, 32768, 2 * FF, DM, E); }
        GBAR();
        {   pg8::EpiResid<false> E{out, out, ctxr, ctxr, mods1 + 5 * 1024, b0, 32768, nullptr, nullptr, nullptr, 0}; run_gemm(wave_s, lds, big, wt_fout + (size_t)DM * FF, 32768, DM, FF, E, 1); }
        GBAR();
    }
}

extern "C" void kernel_launch(void* const* d_in, const int* in_sizes, int n_in, void* d_out, int out_size, void* d_ws, size_t ws_size, hipStream_t stream) {
    static int grid = 0;
    if (grid == 0) {
        if (n_in != 17 || ws_size < WS_END) { fprintf(stderr, "kernel_launch: need 17 inputs and >= %zu bytes of workspace (got %d, %zu)\n", (size_t)WS_END, n_in, ws_size); grid = -1; return; }
        int dev = 0, cus = 0, per_cu = 0;
        hipGetDevice(&dev); hipDeviceGetAttribute(&cus, hipDeviceAttributeMultiprocessorCount, dev);
        if (hipFuncSetAttribute((const void*)fwd_megakernel, hipFuncAttributeMaxDynamicSharedMemorySize, LDS_BYTES) != hipSuccess) { fprintf(stderr, "kernel_launch: hipFuncSetAttribute failed\n"); grid = -1; return; }
        if (hipOccupancyMaxActiveBlocksPerMultiprocessor(&per_cu, (const void*)fwd_megakernel, NTHREADS, LDS_BYTES) != hipSuccess || per_cu < 1) { fprintf(stderr, "kernel_launch: occupancy query says %d\n", per_cu); per_cu = 1; }
        (void)hipGetLastError();
        grid = cus * 1;
    }
    if (grid < 0) return;
    if (hipMemsetAsync((char*)d_ws + WS_BAR, 0, 4096 * 4, stream) != hipSuccess) { fprintf(stderr, "kernel_launch: memset of barrier words failed\n"); return; }
    Args a{};
    for (int i = 0; i < 17; ++i) a.in[i] = (const float*)d_in[i];
    a.out = (float*)d_out; a.ws = (unsigned char*)d_ws;
    void* args[] = {&a};
    hipError_t e = hipLaunchCooperativeKernel((const void*)fwd_megakernel, dim3(grid), dim3(NTHREADS), args, LDS_BYTES, stream);
    if (e != hipSuccess) fprintf(stderr, "cooperative launch failed: %s (grid %d)\n", hipGetErrorString(e), grid);
}
```
